# Optimizing an MI355X kernel written in HIP

```python
import math
import jax, jax.numpy as jnp
from jax import lax
import numpy as np

D_MODEL = 1024
BATCH = 16
SEQ = 2048
DEPTH = 2

DN_ALPHA = (2.0 * DEPTH) ** 0.25
DN_BETA = (8.0 * DEPTH) ** -0.25
LN_EPS = 1e-5

A_HEAD_DIM = 64
A_HEADS = (D_MODEL // 2) // A_HEAD_DIM
A_KV_HEADS = 2
IDX_HEADS = 4
IDX_DIM = 64
TOPK_MAX = 256
Q_BLOCK = 128

REL_BUCKETS = 32
REL_MAX_DIST = 128

B_HEADS = 4
B_VAL_DIM = (D_MODEL // 2) // B_HEADS
B_KEY_DIM = B_VAL_DIM // 2
GATE_RANK = 16
GATE_TAU = 16.0
GLA_CHUNK = 64

C_GROUP = 16
C_GROUPS = D_MODEL // C_GROUP
C_STATE = 64

MOE_GROUPS = 4
MOE_EXPERTS = 4
MOE_HIDDEN = 512
MOE_TOPK = 2

N_EVEN = (DEPTH + 1) // 2
N_ODD = DEPTH // 2

AB_SPLITS = (A_HEADS * A_HEAD_DIM, A_KV_HEADS * A_HEAD_DIM, A_KV_HEADS * A_HEAD_DIM,
             IDX_HEADS * IDX_DIM, IDX_DIM, IDX_HEADS,
             B_HEADS * B_KEY_DIM, B_HEADS * B_KEY_DIM, B_HEADS * B_VAL_DIM, GATE_RANK,
             B_HEADS * B_VAL_DIM)
AB_PROJ = 2644
AB_OUT = A_HEADS * A_HEAD_DIM + B_HEADS * B_VAL_DIM

kernel_name = "hybrid_dsa_gla_s5_hiermoe_deepnorm"


def layer_norm(x, g, b):
    xf = x.astype(jnp.float32)
    mu = jnp.mean(xf, -1, keepdims=True)
    var = jnp.mean(jnp.square(xf - mu), -1, keepdims=True)
    return ((xf - mu) * lax.rsqrt(var + LN_EPS) * g + b).astype(x.dtype)


def t5_bucket(rel):
    n = jnp.maximum(rel, 0)
    max_exact = REL_BUCKETS // 2
    nf = jnp.maximum(n, max_exact).astype(jnp.float32)
    large = max_exact + (jnp.log(nf / max_exact) / math.log(REL_MAX_DIST / max_exact)
                         * (REL_BUCKETS - max_exact)).astype(jnp.int32)
    large = jnp.minimum(large, REL_BUCKETS - 1)
    return jnp.where(n < max_exact, n, large)


def dsa_attention(q, k, v, iq, ik, iw, rel_bias):
    bsz, L = q.shape[0], q.shape[1]
    k_sel = min(TOPK_MAX, L // 4)
    nb = L // Q_BLOCK
    rep = A_HEADS // A_KV_HEADS
    s_pos = jnp.arange(L, dtype=jnp.int32)
    ikf = ik.astype(jnp.float32)

    def to_blocks(t):
        return jnp.swapaxes(t.reshape((bsz, nb, Q_BLOCK) + t.shape[2:]), 0, 1)

    def block(args):
        bi, qb, iqb, iwb = args
        t_pos = bi * Q_BLOCK + jnp.arange(Q_BLOCK, dtype=jnp.int32)
        dots = jax.nn.relu(jnp.einsum('bthd,bsd->bths', iqb.astype(jnp.float32), ikf) * IDX_DIM ** -0.5)
        score = jnp.einsum('bths,bth->bts', dots, iwb.astype(jnp.float32) * IDX_HEADS ** -0.5)
        causal = s_pos[None, None, :] <= t_pos[None, :, None]
        score = jnp.where(causal, score, -jnp.inf)
        _, idx = lax.top_k(score, k_sel)
        valid = idx <= t_pos[None, :, None]
        kg = jax.vmap(lambda kk, ii: kk[ii])(k, idx)
        vg = jax.vmap(lambda vv, ii: vv[ii])(v, idx)
        bias = rel_bias[t5_bucket(t_pos[None, :, None] - idx)]
        bias = jnp.moveaxis(bias.reshape(bsz, Q_BLOCK, k_sel, A_KV_HEADS, rep), 2, 4)
        qg = qb.reshape(bsz, Q_BLOCK, A_KV_HEADS, rep, A_HEAD_DIM)
        logits = jnp.einsum('btgrd,btkgd->btgrk', qg, kg).astype(jnp.float32) * A_HEAD_DIM ** -0.5
        logits = logits + bias.astype(jnp.float32)
        logits = jnp.where(valid[:, :, None, None, :], logits, -jnp.inf)
        p = jax.nn.softmax(logits, axis=-1).astype(vg.dtype)
        o = jnp.einsum('btgrk,btkgd->btgrd', p, vg)
        return o.reshape(bsz, Q_BLOCK, A_HEADS * A_HEAD_DIM).astype(jnp.float32)

    out = lax.map(block, (jnp.arange(nb, dtype=jnp.int32), to_blocks(q), to_blocks(iq), to_blocks(iw)))
    return jnp.swapaxes(out, 0, 1).reshape(bsz, L, A_HEADS * A_HEAD_DIM)


def gla_attention(q, k, v, log_a):
    bsz, L, H, dk = q.shape
    dv = v.shape[-1]
    nc = L // GLA_CHUNK

    def chunk(t):
        return t.reshape(bsz, nc, GLA_CHUNK, H, t.shape[-1])

    q, k, v, log_a = chunk(q), chunk(k), chunk(v), chunk(log_a)
    cum = lax.cumsum(log_a, axis=2)
    last = cum[:, :, -1:]
    q_dec = q * jnp.exp(cum)
    k_inv = k * jnp.exp(-cum)
    k_end = k * jnp.exp(last - cum)
    mask = jnp.tril(jnp.ones((GLA_CHUNK, GLA_CHUNK), dtype=bool))
    scores = jnp.where(mask, jnp.einsum('bnihd,bnjhd->bnhij', q_dec, k_inv), 0.0)
    o_intra = jnp.einsum('bnhij,bnjhe->bnihe', scores, v)
    upd = jnp.einsum('bnjhd,bnjhe->bnhde', k_end, v)
    decay = jnp.exp(last[:, :, 0])

    def step(S, inp):
        dec, u = inp
        return dec[..., None] * S + u, S

    S0 = jnp.zeros((bsz, H, dk, dv), dtype=q.dtype)
    _, S_prev = lax.scan(step, S0, (jnp.moveaxis(decay, 1, 0), jnp.moveaxis(upd, 1, 0)))
    S_prev = jnp.moveaxis(S_prev, 0, 1)
    o_inter = jnp.einsum('bnihd,bnhde->bnihe', q_dec, S_prev)
    return (o_intra + o_inter).reshape(bsz, L, H, dv)


def even_mixer(x, w_in, rel_bias, gate_w2, gate_b, norm_g, w_out):
    f32 = jnp.float32
    bsz, L, _ = x.shape
    h = x @ w_in
    offsets = np.cumsum(AB_SPLITS)[:-1].tolist()
    aq, ak, av, iq, ik, iw, bq, bk, bv, bg, br = jnp.split(h, offsets, axis=-1)
    o_a = dsa_attention(aq.reshape(bsz, L, A_HEADS, A_HEAD_DIM),
                        ak.reshape(bsz, L, A_KV_HEADS, A_HEAD_DIM),
                        av.reshape(bsz, L, A_KV_HEADS, A_HEAD_DIM),
                        iq.reshape(bsz, L, IDX_HEADS, IDX_DIM), ik, iw, rel_bias)
    log_a = jax.nn.log_sigmoid((bg @ gate_w2 + gate_b).astype(f32)) / GATE_TAU
    o_b = gla_attention(bq.astype(f32).reshape(bsz, L, B_HEADS, B_KEY_DIM) * B_KEY_DIM ** -0.5,
                        bk.astype(f32).reshape(bsz, L, B_HEADS, B_KEY_DIM),
                        bv.astype(f32).reshape(bsz, L, B_HEADS, B_VAL_DIM),
                        log_a.reshape(bsz, L, B_HEADS, B_KEY_DIM))
    mu = jnp.mean(o_b, -1, keepdims=True)
    var = jnp.mean(jnp.square(o_b - mu), -1, keepdims=True)
    o_b = ((o_b - mu) * lax.rsqrt(var + LN_EPS)).reshape(bsz, L, B_HEADS * B_VAL_DIM) * norm_g
    o_b = o_b * jax.nn.silu(br.astype(f32))
    o = jnp.concatenate([o_a, o_b.astype(f32)], axis=-1).astype(x.dtype)
    return o @ w_out


def s5_mixer(x, w_in, lam_re, lam_im, log_dt, b_re, b_im, c_re, c_im, d_skip, glu_w1, glu_w2, w_out):
    f32 = jnp.float32
    bsz, L, _ = x.shape
    u = (x @ w_in).astype(f32).reshape(bsz, L, C_GROUPS, C_GROUP)
    lr = jnp.minimum(lam_re.astype(f32), -1e-4)
    li = lam_im.astype(f32)
    dt = jnp.exp(log_dt.astype(f32))[:, None]
    mag = jnp.exp(lr * dt)
    ab_re = mag * jnp.cos(li * dt)
    ab_im = mag * jnp.sin(li * dt)
    den = lr * lr + li * li
    nr = ab_re - 1.0
    coef_re = (nr * lr + ab_im * li) / den
    coef_im = (ab_im * lr - nr * li) / den
    bb_re = coef_re[..., None] * b_re - coef_im[..., None] * b_im
    bb_im = coef_re[..., None] * b_im + coef_im[..., None] * b_re
    bu_re = jnp.einsum('blgc,gpc->blgp', u, bb_re).astype(f32)
    bu_im = jnp.einsum('blgc,gpc->blgp', u, bb_im).astype(f32)
    a_re = jnp.broadcast_to(ab_re, (1, L, C_GROUPS, C_STATE))
    a_im = jnp.broadcast_to(ab_im, (1, L, C_GROUPS, C_STATE))

    def combine(e1, e2):
        a1r, a1i, b1r, b1i = e1
        a2r, a2i, b2r, b2i = e2
        return (a2r * a1r - a2i * a1i, a2r * a1i + a2i * a1r,
                a2r * b1r - a2i * b1i + b2r, a2r * b1i + a2i * b1r + b2i)

    _, _, s_re, s_im = lax.associative_scan(combine, (a_re, a_im, bu_re, bu_im), axis=1)
    y = (jnp.einsum('blgp,gcp->blgc', s_re, c_re) - jnp.einsum('blgp,gcp->blgc', s_im, c_im)
         + d_skip.reshape(C_GROUPS, C_GROUP) * u)
    g = jax.nn.gelu(y.reshape(bsz, L, D_MODEL).astype(f32))
    z = (g @ glu_w1) * jax.nn.sigmoid(g @ glu_w2)
    return z.astype(x.dtype) @ w_out


def hier_moe(x, r_coarse, rb_coarse, r_fine, rb_fine, w_gate, w_up, w_down):
    f32 = jnp.float32
    bsz, L, d = x.shape
    xt = x.reshape(-1, d)
    gl = (xt @ r_coarse + rb_coarse).astype(f32)
    pg = jax.nn.softmax(gl, axis=-1)
    gsel = jnp.argmax(gl, axis=-1)
    g_onehot = jax.nn.one_hot(gsel, MOE_GROUPS, dtype=f32)
    g_w = jnp.sum(pg * g_onehot, axis=-1)
    fl = (jnp.einsum('nd,gde->nge', xt, r_fine) + rb_fine).astype(f32)
    fl_sel = jnp.take_along_axis(fl, gsel[:, None, None], axis=1)[:, 0]
    top_v, top_i = lax.top_k(fl_sel, MOE_TOPK)
    top_w = jax.nn.softmax(top_v, axis=-1) * g_w[:, None]
    e_gate = jnp.sum(jax.nn.one_hot(top_i, MOE_EXPERTS, dtype=f32) * top_w[..., None], axis=1)
    gate = g_onehot[:, :, None] * e_gate[:, None, :]
    y = jnp.zeros(xt.shape, dtype=f32)
    for g in range(MOE_GROUPS):
        hg = jax.nn.silu(jnp.einsum('nd,edf->nef', xt, w_gate[g])) * jnp.einsum('nd,edf->nef', xt, w_up[g])
        y = y + jnp.einsum('nef,efd->nd', hg * gate[:, g, :, None].astype(hg.dtype), w_down[g])
    return y.reshape(bsz, L, d).astype(x.dtype)


def setup_inputs(seed: int = 0) -> dict:
    key = jax.random.key(seed)
    ks = iter(jax.random.split(key, 40))
    nrm = lambda shape, s: jax.random.normal(next(ks), shape, jnp.float32) * s
    D = D_MODEL
    E, F, G = MOE_EXPERTS, MOE_HIDDEN, MOE_GROUPS
    n_idx = jnp.arange(C_STATE, dtype=jnp.float32)
    return {
        "x": nrm((BATCH, SEQ, D), 1.0),
        "rel_bias": nrm((REL_BUCKETS, A_HEADS), 0.3),
        "ab_w_in": nrm((N_EVEN, D, AB_PROJ), D ** -0.5),
        "gla_gate_w2": nrm((N_EVEN, GATE_RANK, B_HEADS * B_KEY_DIM), GATE_RANK ** -0.5),
        "gla_gate_b": nrm((N_EVEN, B_HEADS * B_KEY_DIM), 0.1),
        "gla_norm_g": 1.0 + nrm((N_EVEN, B_HEADS * B_VAL_DIM), 0.01),
        "ab_w_out": nrm((N_EVEN, AB_OUT, D), AB_OUT ** -0.5 * DN_BETA),
        "s5_w_in": nrm((N_ODD, D, D), D ** -0.5),
        "s5_lam_re": -0.5 + nrm((N_ODD, C_GROUPS, C_STATE), 0.01),
        "s5_lam_im": math.pi * n_idx + nrm((N_ODD, C_GROUPS, C_STATE), 0.01),
        "s5_log_dt": jax.random.uniform(next(ks), (N_ODD, C_GROUPS), jnp.float32,
                                        math.log(1e-3), math.log(1e-1)),
        "s5_b_re": nrm((N_ODD, C_GROUPS, C_STATE, C_GROUP), (2 * C_GROUP) ** -0.5),
        "s5_b_im": nrm((N_ODD, C_GROUPS, C_STATE, C_GROUP), (2 * C_GROUP) ** -0.5),
        "s5_c_re": nrm((N_ODD, C_GROUPS, C_GROUP, C_STATE), C_STATE ** -0.5),
        "s5_c_im": nrm((N_ODD, C_GROUPS, C_GROUP, C_STATE), C_STATE ** -0.5),
        "s5_d": nrm((N_ODD, D), 1.0),
        "s5_glu_w1": nrm((N_ODD, D, D), D ** -0.5),
        "s5_glu_w2": nrm((N_ODD, D, D), D ** -0.5),
        "s5_w_out": nrm((N_ODD, D, D), D ** -0.5 * DN_BETA),
        "ln_mix_g": 1.0 + nrm((DEPTH, D), 0.01),
        "ln_mix_b": nrm((DEPTH, D), 0.01),
        "ln_ffn_g": 1.0 + nrm((DEPTH, D), 0.01),
        "ln_ffn_b": nrm((DEPTH, D), 0.01),
        "moe_r_coarse": nrm((DEPTH, D, G), D ** -0.5),
        "moe_rb_coarse": nrm((DEPTH, G), 0.01),
        "moe_r_fine": nrm((DEPTH, G, D, E), D ** -0.5),
        "moe_rb_fine": nrm((DEPTH, G, E), 0.01),
        "moe_w_gate": nrm((DEPTH, G, E, D, F), D ** -0.5),
        "moe_w_up": nrm((DEPTH, G, E, D, F), D ** -0.5),
        "moe_w_down": nrm((DEPTH, G, E, F, D), F ** -0.5 * DN_BETA),
    }


def reference(x, rel_bias, ab_w_in, gla_gate_w2, gla_gate_b, gla_norm_g, ab_w_out,
              s5_w_in, s5_lam_re, s5_lam_im, s5_log_dt, s5_b_re, s5_b_im, s5_c_re, s5_c_im,
              s5_d, s5_glu_w1, s5_glu_w2, s5_w_out,
              ln_mix_g, ln_mix_b, ln_ffn_g, ln_ffn_b,
              moe_r_coarse, moe_rb_coarse, moe_r_fine, moe_rb_fine,
              moe_w_gate, moe_w_up, moe_w_down):
    h = x
    for layer in range(DEPTH):
        i = layer // 2
        if layer % 2 == 0:
            m = even_mixer(h, ab_w_in[i], rel_bias, gla_gate_w2[i], gla_gate_b[i],
                           gla_norm_g[i], ab_w_out[i])
        else:
            m = s5_mixer(h, s5_w_in[i], s5_lam_re[i], s5_lam_im[i], s5_log_dt[i],
                         s5_b_re[i], s5_b_im[i], s5_c_re[i], s5_c_im[i], s5_d[i],
                         s5_glu_w1[i], s5_glu_w2[i], s5_w_out[i])
        h = layer_norm(DN_ALPHA * h + m.astype(h.dtype), ln_mix_g[layer], ln_mix_b[layer])
        f = hier_moe(h, moe_r_coarse[layer], moe_rb_coarse[layer], moe_r_fine[layer],
                     moe_rb_fine[layer], moe_w_gate[layer], moe_w_up[layer], moe_w_down[layer])
        h = layer_norm(DN_ALPHA * h + f, ln_ffn_g[layer], ln_ffn_b[layer])
    return h.astype(x.dtype)
```

```cpp
#include <hip/hip_runtime.h>
#include <math.h>
#include <stdio.h>
#include <stdint.h>

#define GAS __attribute__((address_space(1)))
#define LAS __attribute__((address_space(3)))
typedef unsigned short bf16;
typedef unsigned v4u __attribute__((ext_vector_type(4)));
typedef unsigned v2u __attribute__((ext_vector_type(2)));
typedef float f32x4 __attribute__((ext_vector_type(4)));
typedef float f32x2 __attribute__((ext_vector_type(2)));
typedef float f32x16 __attribute__((ext_vector_type(16)));
typedef short bf16x8 __attribute__((ext_vector_type(8)));
typedef short bf16x4 __attribute__((ext_vector_type(4)));
typedef GAS unsigned gu32;
#define RLX_AGENT __ATOMIC_RELAXED, __HIP_MEMORY_SCOPE_AGENT
#define LDS_WAIT() asm volatile("s_waitcnt lgkmcnt(0)" ::: "memory")
#define VM_WAIT() asm volatile("s_waitcnt vmcnt(0)" ::: "memory")

constexpr int D = 1024, BATCH = 16, SEQ = 2048, NTOK = BATCH * SEQ;
constexpr int ABP = 2644;
constexpr int HP = 2816;
constexpr int HC_AQ = 0, HC_AK = 512, HC_AV = 640, HC_IQ = 768, HC_IK = 1024, HC_IW = 1088, HC_BG = 1096, HC_BQ = 1280, HC_BK = 1536, HC_BV = 1792, HC_BR = 2304;
constexpr float ALPHA = 1.4142135623730951f;
constexpr float LN_EPS = 1e-5f;
constexpr int NEXP = 16, MOE_F = 512;
constexpr int MAXSLOT = 65536 + NEXP * 256;

__device__ __forceinline__ float bf2f(bf16 v) { return __uint_as_float(((unsigned)v) << 16); }
__device__ __forceinline__ unsigned f2bf(float f) { unsigned u = __float_as_uint(f); return (u + 0x7fffu + ((u >> 16) & 1u)) >> 16; }
__device__ __forceinline__ unsigned pk2(float lo, float hi) { return f2bf(lo) | (f2bf(hi) << 16); }
__device__ __forceinline__ float wsum(float v) {
#define WS_DPP(ctrl, rm, bc) v += __int_as_float(__builtin_amdgcn_update_dpp(0, __float_as_int(v), ctrl, rm, 0xF, bc))
    WS_DPP(0xB1, 0xF, true); WS_DPP(0x4E, 0xF, true); WS_DPP(0x141, 0xF, true); WS_DPP(0x140, 0xF, true); WS_DPP(0x142, 0xA, false); WS_DPP(0x143, 0xC, false);
#undef WS_DPP
    return __int_as_float(__builtin_amdgcn_readlane(__float_as_int(v), 63));
}
__device__ const unsigned char T5B[128] = {0, 1, 2, 3, 4, 5, 6, 7, 8, 9, 10, 11, 12, 13, 14, 15, 16, 16, 16, 17, 17, 18, 18, 18, 19, 19, 19, 20, 20, 20, 20, 21, 21, 21, 21, 22, 22, 22, 22, 22, 23, 23, 23, 23, 23, 23, 24, 24, 24, 24, 24, 24, 25, 25, 25, 25, 25, 25, 25, 26, 26, 26, 26, 26, 26, 26, 26, 27, 27, 27, 27, 27, 27, 27, 27, 27, 27, 28, 28, 28, 28, 28, 28, 28, 28, 28, 28, 29, 29, 29, 29, 29, 29, 29, 29, 29, 29, 29, 29, 30, 30, 30, 30, 30, 30, 30, 30, 30, 30, 30, 30, 30, 30, 31, 31, 31, 31, 31, 31, 31, 31, 31, 31, 31, 31, 31, 31, 31};
namespace pg8 {
#define PG8_LAS __attribute__((address_space(3)))
constexpr int BM = 256, BK = 64, HALF = 128, HTB = HALF * BK * 2  , STAGE_BYTES = 8 * HTB, NXCD = 8, WGM = 8;
__host__ __device__ __forceinline__ int lds_byte(int r, int c) { const int st = (r >> 4) * 2 + (c >> 5), rr = r & 15, cc = c & 31, ob = rr * 64 + cc * 2; return st * 1024 + (ob ^ (((ob >> 9) & 1) << 5)); }
__host__ __device__ __forceinline__ void stage_rc(int b, int& R, int& C) { const int st = b / 1024, sb = b % 1024, swz = sb ^ (((sb >> 9) & 1) << 5); R = (st >> 1) * 16 + swz / 64; C = (st & 1) * 32 + (swz % 64) / 2; }
__host__ __device__ __forceinline__ int perm32(int rho) { const int n = rho >> 4, i = rho & 15; return 8 * (i >> 2) + 4 * n + (i & 3); }

struct Unit { int arow0, brow0, pm, pn, aux, cnt; const int* gather; };
struct Gemm { const bf16* A; const bf16* Bt; int lda, ldb, K; };

struct StaticOrder {
    int nM, nN, nwg, G, c;
    __device__ void init(int M, int N, int G_, int c_) { nM = M / BM; nN = N / BM; nwg = nM * nN; G = G_; c = c_; }
    __device__ bool next(int i, Unit& u) const {
        const long L = (long)i * G + c; if (L >= nwg) return false;
        int wgid = (int)L; { const int q = nwg / NXCD, r = nwg % NXCD, xcd = wgid % NXCD, off = wgid / NXCD; wgid = (xcd < r ? xcd * (q + 1) : r * (q + 1) + (xcd - r) * q) + off; }
        const int nig = WGM * nN, gid = wgid / nig, fm = gid * WGM, gsz = (nM - fm) < WGM ? (nM - fm) : WGM;
        u.pm = fm + ((wgid % nig) % gsz); u.pn = (wgid % nig) / gsz; u.arow0 = u.pm * BM; u.brow0 = u.pn * BM; u.aux = 0; u.cnt = BM; u.gather = nullptr; return true;
    }
};
__device__ __forceinline__ unsigned cvt_pk_bf16(float lo, float hi) { unsigned r; asm volatile("v_cvt_pk_bf16_f32 %0, %1, %2" : "=v"(r) : "v"(lo), "v"(hi)); return r; }

template <class Epi, class Sched, bool GATHER = false>
__device__ __forceinline__ void gemm_phase(PG8_LAS unsigned char* lds, const Gemm g, const Sched& S, const Epi& E) {
    const int tid = threadIdx.x, wid = __builtin_amdgcn_readfirstlane(tid >> 6), lane = tid & 63, wr = wid >> 2, wc = wid & 3, fr = lane & 15, fq = lane >> 4;
    const int K = g.K, nt = K / BK;
    unsigned voffA[2], voffB[2];
#pragma unroll
    for (int i = 0; i < 2; ++i) { int R, C; stage_rc(tid * 16 + i * 8192, R, C); const int Rb = Epi::PERM ? ((R & ~31) + perm32(R & 31)) : R;
        voffA[i] = GATHER ? (unsigned)(C * 2) : (unsigned)(R * g.lda + C) * 2u; voffB[i] = (unsigned)(Rb * g.ldb + C) * 2u; }
    const size_t kstep = (size_t)(BK * 2);
    const size_t hstepA = (size_t)HALF * g.lda * 2, hstepB = (size_t)HALF * g.ldb * 2;
    const unsigned ldsw = (unsigned)wid * 1024u;
    const int aoff = lds_byte(wr * 64 + fr, fq * 8), boff = lds_byte(wc * 32 + fr, fq * 8);
#define PG8_SA(b, h) (((b) * 2 + (h)) * HTB)
#define PG8_SB(b, h) ((4 + (b) * 2 + (h)) * HTB)
#define PG8_STAGE(bufoff, gbase, voff) do { _Pragma("unroll") for (int _i = 0; _i < 2; ++_i) \
        __builtin_amdgcn_global_load_lds((const unsigned*)((const char*)(gbase) + (voff)[_i]), (PG8_LAS unsigned*)(lds + (bufoff) + ldsw + _i * 8192), 16, 0, 0); } while (0)
#define PG8_STAGE_A(bufoff, P, O, h, ko) do { _Pragma("unroll") for (int _i = 0; _i < 2; ++_i) { \
        const char* _p; if constexpr (GATHER) { const unsigned _t = _i ? ((O)[h] >> 16) : ((O)[h] & 0xffffu); _p = (const char*)(P) + (ko) + (size_t)(_t * (unsigned)(g.lda * 2) + voffA[_i]); } \
        else _p = (const char*)(P) + (ko) + (size_t)(h) * hstepA + voffA[_i]; \
        __builtin_amdgcn_global_load_lds((const unsigned*)_p, (PG8_LAS unsigned*)(lds + (bufoff) + ldsw + _i * 8192), 16, 0, 0); } } while (0)
#define PG8_LDA(dst, b, h) do { _Pragma("unroll") for (int m = 0; m < 4; ++m) _Pragma("unroll") for (int k = 0; k < 2; ++k) dst[m][k] = *(const PG8_LAS bf16x8*)(lds + PG8_SA(b, h) + aoff + m * 2048 + k * 1024); } while (0)
#define PG8_LDB(dst, b, h) do { _Pragma("unroll") for (int n = 0; n < 2; ++n) _Pragma("unroll") for (int k = 0; k < 2; ++k) dst[n][k] = *(const PG8_LAS bf16x8*)(lds + PG8_SB(b, h) + boff + n * 2048 + k * 1024); } while (0)
#define PG8_MMA(ai, bj, At, Bt) do { __builtin_amdgcn_s_setprio(1); _Pragma("unroll") for (int m = 0; m < 4; ++m) _Pragma("unroll") for (int n = 0; n < 2; ++n) _Pragma("unroll") for (int k = 0; k < 2; ++k) \
        acc[ai][bj][m][n] = __builtin_amdgcn_mfma_f32_16x16x32_bf16(Bt[n][k], At[m][k], acc[ai][bj][m][n], 0, 0, 0); __builtin_amdgcn_s_setprio(0); } while (0)
#define PG8_WAIT_V(n) asm volatile("s_waitcnt vmcnt(" #n ")" ::: "memory")
#define PG8_WAIT_L(n) asm volatile("s_waitcnt lgkmcnt(" #n ")" ::: "memory")
#define PG8_BAR __builtin_amdgcn_s_barrier()
#define PG8_SCHED __builtin_amdgcn_sched_barrier(0)
    Unit cur, nxt; int ui = 0;
    if (!S.next(0, cur)) return;
    f32x4 acc[2][2][4][2];
#pragma unroll
    for (int a = 0; a < 2; ++a)
#pragma unroll
        for (int b = 0; b < 2; ++b)
#pragma unroll
            for (int m = 0; m < 4; ++m)
#pragma unroll
                for (int n = 0; n < 2; ++n) acc[a][b][m][n] = (f32x4){0.f, 0.f, 0.f, 0.f};
    bf16x8 At[4][2], B0[2][2], B1[2][2];
    unsigned OA[2], ON[2];
    const char* cA; const char* cB;
#define PG8_SETUP(u, P, O) do { \
        if constexpr (GATHER) { P = (const char*)g.A; _Pragma("unroll") for (int _h = 0; _h < 2; ++_h) { unsigned _pk = 0u; _Pragma("unroll") for (int _i = 0; _i < 2; ++_i) { \
            int _R, _C; stage_rc(tid * 16 + _i * 8192, _R, _C); const int _r = _h * HALF + _R; const unsigned _t = (_r < (u).cnt) ? (unsigned)((u).gather[_r] >> 1) : 0u; _pk |= _t << (16 * _i); } O[_h] = _pk; } } \
        else { P = (const char*)g.A + (size_t)(u).arow0 * g.lda * 2; } } while (0)
    PG8_SETUP(cur, cA, OA);
    cB = (const char*)g.Bt + (size_t)cur.brow0 * g.ldb * 2;
    PG8_STAGE(PG8_SB(0, 0), cB, voffB); PG8_STAGE(PG8_SB(0, 1), cB + hstepB, voffB); PG8_STAGE_A(PG8_SA(0, 0), cA, OA, 0, 0); PG8_STAGE_A(PG8_SA(0, 1), cA, OA, 1, 0);
    if (wr == 1) PG8_BAR;
    PG8_WAIT_V(2); PG8_BAR;
    PG8_STAGE(PG8_SB(1, 0), cB + kstep, voffB); PG8_STAGE_A(PG8_SA(1, 0), cA, OA, 0, kstep); PG8_STAGE(PG8_SB(1, 1), cB + hstepB + kstep, voffB);
    PG8_WAIT_V(6); PG8_BAR;
    for (;;) {
        const bool has_next = S.next(ui + 1, nxt);
        const char* nA = cA; const char* nB = cB;
        if constexpr (GATHER) { ON[0] = OA[0]; ON[1] = OA[1]; }
        if (has_next) { PG8_SETUP(nxt, nA, ON); nB = (const char*)g.Bt + (size_t)nxt.brow0 * g.ldb * 2; }
        for (int t = 0; t < nt; t += 2) {
            const bool last = (t == nt - 2);
            const size_t k1 = (size_t)(t + 1) * kstep;
            const char* a2 = last ? nA : cA; const char* b2 = last ? nB : cB + (size_t)(t + 2) * kstep;
            const size_t k2 = last ? 0 : (size_t)(t + 2) * kstep, k3 = k2 + kstep;
            const char* b3 = b2 + kstep;
            unsigned O2[2];
            if constexpr (GATHER) { O2[0] = last ? ON[0] : OA[0]; O2[1] = last ? ON[1] : OA[1]; }
            PG8_LDB(B0, 0, 0); PG8_LDB(B1, 0, 1); PG8_SCHED; PG8_LDA(At, 0, 0); PG8_STAGE_A(PG8_SA(1, 1), cA, OA, 1, k1);
            PG8_WAIT_V(8); PG8_WAIT_L(0); PG8_BAR; PG8_MMA(0, 0, At, B0); PG8_MMA(0, 1, At, B1); PG8_BAR; PG8_SCHED;
            PG8_LDA(At, 0, 1); PG8_STAGE(PG8_SB(0, 0), b2, voffB); PG8_STAGE(PG8_SB(0, 1), b2 + hstepB, voffB); PG8_STAGE_A(PG8_SA(0, 0), a2, O2, 0, k2);
            PG8_WAIT_V(8); PG8_WAIT_L(0); PG8_BAR; PG8_MMA(1, 0, At, B0); PG8_MMA(1, 1, At, B1); PG8_BAR; PG8_SCHED;
            PG8_LDB(B0, 1, 0); PG8_LDB(B1, 1, 1); PG8_SCHED; PG8_LDA(At, 1, 0); PG8_STAGE_A(PG8_SA(0, 1), a2, O2, 1, k2);
            PG8_WAIT_V(8); PG8_WAIT_L(0); PG8_BAR; PG8_MMA(0, 0, At, B0); PG8_MMA(0, 1, At, B1); PG8_BAR; PG8_SCHED;
            PG8_LDA(At, 1, 1); PG8_STAGE(PG8_SB(1, 0), b3, voffB); PG8_STAGE(PG8_SB(1, 1), b3 + hstepB, voffB); PG8_STAGE_A(PG8_SA(1, 0), a2, O2, 0, k3);
            PG8_WAIT_V(8); PG8_WAIT_L(0); PG8_BAR; PG8_MMA(1, 0, At, B0); PG8_MMA(1, 1, At, B1); PG8_BAR; PG8_SCHED;
        }
        if (wr == 0) PG8_BAR;
        E(acc, cur, wr, wc, fr, fq);
        if (!has_next) break;
#pragma unroll
        for (int a = 0; a < 2; ++a)
#pragma unroll
            for (int b = 0; b < 2; ++b)
#pragma unroll
                for (int m = 0; m < 4; ++m)
#pragma unroll
                    for (int n = 0; n < 2; ++n) acc[a][b][m][n] = (f32x4){0.f, 0.f, 0.f, 0.f};
        cur = nxt; cA = nA; cB = nB; ++ui;
        if constexpr (GATHER) { OA[0] = ON[0]; OA[1] = ON[1]; }
        if (wr == 1) PG8_BAR;
    }
    PG8_WAIT_V(0);
    PG8_BAR;
#undef PG8_SA
#undef PG8_SB
#undef PG8_STAGE
#undef PG8_STAGE_A
#undef PG8_LDA
#undef PG8_LDB
#undef PG8_MMA
#undef PG8_WAIT_V
#undef PG8_WAIT_L
#undef PG8_BAR
#undef PG8_SCHED
#undef PG8_SETUP
}

struct EpiStoreBf16 {
    static constexpr bool PERM = true;
    bf16* O; int ldc;
    __device__ __forceinline__ void operator()(const f32x4 (&acc)[2][2][4][2], const Unit& u, int wr, int wc, int fr, int fq) const {
        const int row0 = u.pm * BM + wr * 64 + fr, col0 = u.pn * BM + wc * 32 + 8 * fq;
#pragma unroll
        for (int ai = 0; ai < 2; ++ai)
#pragma unroll
            for (int m = 0; m < 4; ++m) { bf16* rowp = O + (size_t)(row0 + ai * HALF + m * 16) * ldc + col0;
#pragma unroll
                for (int bj = 0; bj < 2; ++bj) { const f32x4 v0 = acc[ai][bj][m][0], v1 = acc[ai][bj][m][1];
                    v4u w; w.x = cvt_pk_bf16(v0[0], v0[1]); w.y = cvt_pk_bf16(v0[2], v0[3]); w.z = cvt_pk_bf16(v1[0], v1[1]); w.w = cvt_pk_bf16(v1[2], v1[3]);
                    *(v4u*)(rowp + bj * HALF) = w; } }
    }
};

struct EpiPre {
    static constexpr bool PERM = true;
    const bf16* base; bf16* out; int ldc;
    __device__ __forceinline__ void operator()(const f32x4 (&acc)[2][2][4][2], const Unit& u, int wr, int wc, int fr, int fq) const {
        const int row0 = u.pm * BM + wr * 64 + fr, col0 = u.pn * BM + wc * 32 + 8 * fq;
#pragma unroll
        for (int ai = 0; ai < 2; ++ai)
#pragma unroll
            for (int m = 0; m < 4; ++m) { const size_t off = (size_t)(row0 + ai * HALF + m * 16) * ldc + col0;
#pragma unroll
                for (int bj = 0; bj < 2; ++bj) { const v4u bs = *(const v4u*)(base + off + bj * HALF); const f32x4 v0 = acc[ai][bj][m][0], v1 = acc[ai][bj][m][1]; v4u w;
                    w.x = cvt_pk_bf16(fmaf(__uint_as_float(bs.x << 16), ALPHA, v0[0]), fmaf(__uint_as_float(bs.x & 0xffff0000u), ALPHA, v0[1]));
                    w.y = cvt_pk_bf16(fmaf(__uint_as_float(bs.y << 16), ALPHA, v0[2]), fmaf(__uint_as_float(bs.y & 0xffff0000u), ALPHA, v0[3]));
                    w.z = cvt_pk_bf16(fmaf(__uint_as_float(bs.z << 16), ALPHA, v1[0]), fmaf(__uint_as_float(bs.z & 0xffff0000u), ALPHA, v1[1]));
                    w.w = cvt_pk_bf16(fmaf(__uint_as_float(bs.w << 16), ALPHA, v1[2]), fmaf(__uint_as_float(bs.w & 0xffff0000u), ALPHA, v1[3]));
                    *(v4u*)(out + off + bj * HALF) = w; } }
    }
};
struct EpiS5U {
    static constexpr bool PERM = true;
    bf16* UA;
    __device__ __forceinline__ void operator()(const f32x4 (&acc)[2][2][4][2], const Unit& u, int wr, int wc, int fr, int fq) const {
#pragma unroll
        for (int ai = 0; ai < 2; ++ai)
#pragma unroll
            for (int m = 0; m < 4; ++m) { const int tok = u.pm * BM + ai * HALF + wr * 64 + m * 16 + fr; const int b = tok >> 11, l = tok & 2047, ch = l >> 4, tl = l & 15;
#pragma unroll
                for (int bj = 0; bj < 2; ++bj) { const int c0 = u.pn * BM + bj * HALF + wc * 32 + 8 * fq; const int g = c0 >> 4, cc = c0 & 15;
                    const f32x4 v0 = acc[ai][bj][m][0], v1 = acc[ai][bj][m][1];
                    v4u w; w.x = cvt_pk_bf16(v0[0], v0[1]); w.y = cvt_pk_bf16(v0[2], v0[3]); w.z = cvt_pk_bf16(v1[0], v1[1]); w.w = cvt_pk_bf16(v1[2], v1[3]);
                    *(v4u*)(UA + ((size_t)(g * 2048 + b * 128 + ch)) * 384 + tl * 16 + cc) = w; } }
    }
};
struct EpiS5Z {
    static constexpr bool PERM = false;
    float* Z;
    __device__ __forceinline__ void operator()(const f32x4 (&acc)[2][2][4][2], const Unit& u, int wr, int wc, int fr, int fq) const {
#pragma unroll
        for (int ai = 0; ai < 2; ++ai)
#pragma unroll
            for (int m = 0; m < 4; ++m) { float* rowp = Z + (size_t)(u.arow0 + ai * HALF + wr * 64 + m * 16 + fr) * 128 + wc * 32 + 4 * fq;
#pragma unroll
                for (int n = 0; n < 2; ++n) *(f32x4*)(rowp + n * 16) = acc[ai][0][m][n]; }
    }
};
__device__ __forceinline__ float gelu_tanh(float y) { const float z = 0.7978845608028654f * (y + 0.044715f * y * y * y); return y / (1.f + __expf(-2.f * z)); }
struct EpiS5Y {
    static constexpr bool PERM = true;
    bf16* G;
    __device__ __forceinline__ void operator()(const f32x4 (&acc)[2][2][4][2], const Unit& u, int wr, int wc, int fr, int fq) const {
        const int g = u.aux;
#pragma unroll
        for (int ai = 0; ai < 2; ++ai)
#pragma unroll
            for (int m = 0; m < 4; ++m) { const int row = u.pm * BM + ai * HALF + wr * 64 + m * 16 + fr; const int b = row >> 7, ch = row & 127;
#pragma unroll
                for (int bj = 0; bj < 2; ++bj) { const int c0 = bj * HALF + wc * 32 + 8 * fq; const int tl = c0 >> 4, cc = c0 & 15;
                    const f32x4 v0 = acc[ai][bj][m][0], v1 = acc[ai][bj][m][1];
                    v4u w; w.x = cvt_pk_bf16(gelu_tanh(v0[0]), gelu_tanh(v0[1])); w.y = cvt_pk_bf16(gelu_tanh(v0[2]), gelu_tanh(v0[3]));
                    w.z = cvt_pk_bf16(gelu_tanh(v1[0]), gelu_tanh(v1[1])); w.w = cvt_pk_bf16(gelu_tanh(v1[2]), gelu_tanh(v1[3]));
                    *(v4u*)(G + ((size_t)(b * 2048 + ch * 16 + tl)) * D + g * 16 + cc) = w; } }
    }
};
template <int ACT> struct EpiGated {
    static constexpr bool PERM = true;
    bf16* O; int ldc;
    __device__ __forceinline__ void operator()(const f32x4 (&acc)[2][2][4][2], const Unit& u, int wr, int wc, int fr, int fq) const {
        const int col0 = u.pn * HALF + wc * 32 + 8 * fq;
#pragma unroll
        for (int ai = 0; ai < 2; ++ai)
#pragma unroll
            for (int m = 0; m < 4; ++m) { const int row = u.pm * BM + ai * HALF + wr * 64 + m * 16 + fr; float r[8];
#pragma unroll
                for (int n = 0; n < 2; ++n)
#pragma unroll
                    for (int j = 0; j < 4; ++j) { const float v = acc[ai][0][m][n][j], gt = acc[ai][1][m][n][j];
                        r[n * 4 + j] = ACT == 0 ? v / (1.f + __expf(-gt)) : v / (1.f + __expf(-v)) * gt; }
                v4u w; w.x = cvt_pk_bf16(r[0], r[1]); w.y = cvt_pk_bf16(r[2], r[3]); w.z = cvt_pk_bf16(r[4], r[5]); w.w = cvt_pk_bf16(r[6], r[7]);
                *(v4u*)(O + (size_t)row * ldc + col0) = w; }
    }
};
struct S5Order {
    int G, c;
    __device__ bool next(int i, Unit& u) const { const int L = i * G + c; if (L >= 512) return false; const int g = L >> 3, rt = L & 7;
        u.arow0 = g * 2048 + rt * BM; u.brow0 = g * BM; u.pm = rt; u.pn = 0; u.aux = g; u.cnt = BM; u.gather = nullptr; return true; }
};

struct MoeOrder {
    int cnt[NEXP]; const int* list; int G, c;
    __device__ bool next(int i, Unit& u) const { const int L = i * G + c, rt = L >> 2, pn = L & 3; int acc = 0, se = -1, loc = 0, sc = 0;
#pragma unroll
        for (int e = 0; e < NEXP; ++e) { const int ce = cnt[e], nt = (ce + 255) >> 8; if (rt >= acc && rt < acc + nt) { se = e; loc = rt - acc; sc = ce; } acc += nt; }
        if (se < 0) return false;
        u.arow0 = rt * BM; u.brow0 = se * 1024 + pn * BM; u.pm = rt; u.pn = pn; u.aux = se; const int rem = sc - loc * BM; u.cnt = rem < BM ? rem : BM; u.gather = list + se * NTOK + loc * BM; return true; }
};
struct EpiMoeDown {
    static constexpr bool PERM = true;
    const float* tokw; bf16* CB;
    __device__ __forceinline__ void operator()(const f32x4 (&acc)[2][2][4][2], const Unit& u, int wr, int wc, int fr, int fq) const {
        const int col0 = u.pn * BM + wc * 32 + 8 * fq;
#pragma unroll
        for (int ai = 0; ai < 2; ++ai)
#pragma unroll
            for (int m = 0; m < 4; ++m) { const int r = ai * HALF + wr * 64 + m * 16 + fr;
                if (r < u.cnt) { const int ent = u.gather[r]; const int tok = ent >> 1, k = ent & 1; const float w = tokw[ent];
                    bf16* rowp = CB + ((size_t)k * NTOK + tok) * D + col0;
#pragma unroll
                    for (int bj = 0; bj < 2; ++bj) { const f32x4 v0 = acc[ai][bj][m][0] * w, v1 = acc[ai][bj][m][1] * w;
                        v4u o; o.x = cvt_pk_bf16(v0[0], v0[1]); o.y = cvt_pk_bf16(v0[2], v0[3]); o.z = cvt_pk_bf16(v1[0], v1[1]); o.w = cvt_pk_bf16(v1[2], v1[3]);
                        *(v4u*)(rowp + bj * HALF) = o; } } }
    }
};
}
#define XB_TMO      128
#define XB_XCNT(j)  (256  + 64 * (j))
#define XB_XSUB(j)  (1280 + 64 * (j))
#define XB_XGEN(j)  (2304 + 64 * (j))
#define XB_TOP      3328
#define XB_TOPGEN   3392
#define XCD_BAR_WORDS 3456
#define XB_SPIN_CAP (1u << 18)
__device__ __forceinline__ unsigned xb_ld(unsigned* p)              { return __hip_atomic_load(p, __ATOMIC_RELAXED, __HIP_MEMORY_SCOPE_AGENT); }
__device__ __forceinline__ unsigned xb_add(unsigned* p, unsigned v) { return __hip_atomic_fetch_add(p, v, __ATOMIC_RELAXED, __HIP_MEMORY_SCOPE_AGENT); }
__device__ __forceinline__ unsigned xb_xcc_id() { return (unsigned)__builtin_amdgcn_s_getreg((3 << 11) | 20) & 0xFu; }
#define XB_SPIN(cond, bar) do { unsigned _sp = 0; while (cond) { __builtin_amdgcn_s_sleep(1); \
    if ((++_sp & 255u) == 0u) { if (xb_ld(&(bar)[XB_TMO])) break; if (_sp > XB_SPIN_CAP) { atomicAdd(&(bar)[XB_TMO], 1u); break; } } } } while (0)
struct XcdBarrier { unsigned* bar; unsigned x; volatile LAS unsigned* st; };
__device__ __forceinline__ XcdBarrier xcd_barrier_post(unsigned* bar, volatile LAS unsigned* st) {
    XcdBarrier b; b.bar = bar; b.x = xb_xcc_id(); b.st = st;
    if (threadIdx.x == 0) (void)xb_add(&bar[XB_XCNT(b.x)], 1u);
    return b;
}
__device__ __forceinline__ void xcd_barrier_complete(unsigned* bar, unsigned x, unsigned& nloc, unsigned& nx) {
    const unsigned G = gridDim.x * gridDim.y * gridDim.z;
    unsigned sum, cnt, mine, sp = 0u;
    for (;;) {
        sum = 0u; cnt = 0u; mine = 0u;
#pragma unroll
        for (unsigned j = 0; j < 16; ++j) { const unsigned c = xb_ld(&bar[XB_XCNT(j)]); sum += c; cnt += (c > 0u) ? 1u : 0u; mine = (j == x) ? c : mine; }
        if (sum == G) break;
        __builtin_amdgcn_s_sleep(1);
        if ((++sp & 255u) == 0u) { if (xb_ld(&bar[XB_TMO])) break; if (sp > XB_SPIN_CAP) { atomicAdd(&bar[XB_TMO], 1u); break; } }
    }
    nloc = mine > 0u ? mine : 1u; nx = cnt > 0u ? cnt : 1u;
}
__device__ __forceinline__ void xcd_barrier(const XcdBarrier& b) {
    asm volatile("s_waitcnt vmcnt(0)" ::: "memory");
    __syncthreads();
    if (threadIdx.x == 0) {
        unsigned* bar = b.bar;
        __builtin_amdgcn_s_waitcnt(0);
        unsigned nloc = b.st[0], nx = b.st[1];
        if (nloc == 0u) { xcd_barrier_complete(bar, b.x, nloc, nx); b.st[0] = nloc; b.st[1] = nx; }
        const unsigned old = xb_add(&bar[XB_XSUB(b.x)], 1u);
        const unsigned gen = old / nloc;
        if (old + 1u == (gen + 1u) * nloc) {
            __builtin_amdgcn_fence(__ATOMIC_RELEASE, "agent");
            asm volatile("s_waitcnt vmcnt(0)" ::: "memory");
            const unsigned og = xb_add(&bar[XB_TOP], 1u);
            const unsigned tg = og / nx;
            if (og + 1u == (tg + 1u) * nx) xb_add(&bar[XB_TOPGEN], 1u);
            else XB_SPIN(xb_ld(&bar[XB_TOPGEN]) == tg, bar);
            __builtin_amdgcn_fence(__ATOMIC_ACQUIRE, "agent");
            xb_add(&bar[XB_XGEN(b.x)], 1u);
            asm volatile("s_waitcnt vmcnt(0)" ::: "memory");
        } else {
            XB_SPIN(xb_ld(&bar[XB_XGEN(b.x)]) == gen, bar);
            __builtin_amdgcn_fence(__ATOMIC_ACQUIRE, "agent");
            asm volatile("s_waitcnt vmcnt(0)" ::: "memory");
        }
    }
    __syncthreads();
}

constexpr int NWAVES = 8;
constexpr size_t MiB = 1u << 20;
constexpr size_t WS_CTL = 0, CTL_ZERO_BYTES = 1 * MiB;
constexpr size_t WS_WIN = 2 * MiB, WS_WOUT = 8 * MiB, WS_S5IN = 10 * MiB, WS_GLU = 12 * MiB, WS_S5OUT = 16 * MiB, WS_PG = 18 * MiB, WS_MQ = 26 * MiB;
constexpr size_t WS_WGU = 40 * MiB, WS_WD = 104 * MiB;
constexpr size_t WS_XB = 136 * MiB, WS_H = 200 * MiB, WS_MASK = 376 * MiB, WS_O = 384 * MiB, WS_F1 = 448 * MiB, WS_END = 512 * MiB;
constexpr int CW_TMO = 0, CW_CODE = 1, CW_CNT = 2048  , CW_BAR = 4096;
constexpr size_t WS_TOKW = 512 * 1024  , WS_LIST = 38 * MiB  ;
constexpr size_t WS_HMID = 200 * MiB  , WS_CB = 268 * MiB  ;
constexpr int RING_OFF = 0, RING_BYTES = 131072, LDS_BYTES = 147456, LDSCTL_OFF = LDS_BYTES - 512, MISC_OFF = LDSCTL_OFF + 320;

struct Frame {
    LAS unsigned char* lds; volatile LAS unsigned* MISC; gu32* ctl;
    int tid, lane, wave, vcu, G;
};
struct Args { const float* in[30]; float* out; unsigned char* ws; int ph_lo, ph_hi, li, pad; };

__device__ __forceinline__ void tr_item(const float* __restrict__ W, int ldw, bf16* WT, int ldt, int k0, int c0, int nc, int r0, LAS float* scr, int lane) {
    f32x4 v[8];
#pragma unroll
    for (int i = 0; i < 8; ++i) { const int idx = lane + 64 * i, kk = idx >> 3, c4 = (idx & 7) * 4; v[i] = (c4 < nc) ? *(const GAS f32x4*)(W + (size_t)(k0 + kk) * ldw + c0 + c4) : (f32x4){0.f, 0.f, 0.f, 0.f}; }
#pragma unroll
    for (int i = 0; i < 8; ++i) { const int idx = lane + 64 * i, kk = idx >> 3, c4 = (idx & 7) * 4; LAS float* s = scr + kk * 33 + c4; s[0] = v[i].x; s[1] = v[i].y; s[2] = v[i].z; s[3] = v[i].w; }
    LDS_WAIT(); asm volatile("" ::: "memory");
    const int c = lane & 7;
#pragma unroll
    for (int j = 0; j < 4; ++j) { const int n = (lane >> 3) + 8 * j; const LAS float* s = scr + (8 * c) * 33 + n;
        v4u o; o.x = pk2(s[0 * 33], s[1 * 33]); o.y = pk2(s[2 * 33], s[3 * 33]); o.z = pk2(s[4 * 33], s[5 * 33]); o.w = pk2(s[6 * 33], s[7 * 33]);
        if (n < nc) *(GAS v4u*)(WT + (size_t)(r0 + n) * ldt + k0 + 8 * c) = o; }
    LDS_WAIT(); asm volatile("" ::: "memory");
}

struct TrDesc { const float* W; int ldw; bf16* WT; int ldt, k0, c0, nc, r0; };
__device__ __forceinline__ void tr_load(const TrDesc& d, f32x4 (&v)[8], int lane) {
#pragma unroll
    for (int i = 0; i < 8; ++i) { const int idx = lane + 64 * i, kk = idx >> 3, c4 = (idx & 7) * 4; v[i] = (c4 < d.nc) ? __builtin_nontemporal_load((const GAS f32x4*)(d.W + (size_t)(d.k0 + kk) * d.ldw + d.c0 + c4)) : (f32x4){0.f, 0.f, 0.f, 0.f}; }
}
__device__ __forceinline__ void tr_store(const TrDesc& d, const f32x4 (&v)[8], LAS float* scr, int lane) {
#pragma unroll
    for (int i = 0; i < 8; ++i) { const int idx = lane + 64 * i, kk = idx >> 3, c4 = (idx & 7) * 4; LAS float* s = scr + kk * 33 + c4; s[0] = v[i].x; s[1] = v[i].y; s[2] = v[i].z; s[3] = v[i].w; }
    LDS_WAIT(); asm volatile("" ::: "memory");
    const int c = lane & 7;
#pragma unroll
    for (int j = 0; j < 4; ++j) { const int n = (lane >> 3) + 8 * j; const LAS float* s = scr + (8 * c) * 33 + n;
        v4u o; o.x = pk2(s[0 * 33], s[1 * 33]); o.y = pk2(s[2 * 33], s[3 * 33]); o.z = pk2(s[4 * 33], s[5 * 33]); o.w = pk2(s[6 * 33], s[7 * 33]);
        if (n < d.nc) *(GAS v4u*)(d.WT + (size_t)(d.r0 + n) * d.ldt + d.k0 + 8 * c) = o; }
    LDS_WAIT(); asm volatile("" ::: "memory");
}
__device__ __forceinline__ int tr_seg_items(int K, int ncols) { return (K / 64) * ((ncols + 31) / 32); }
__device__ __forceinline__ void tr_seg(const float* W, int ldw, int K, int c0, int ncols, bf16* WT, int ldt, int r0, int it, LAS float* scr, int lane) {
    const int nblk = (ncols + 31) / 32, kb = it / nblk, nb = it % nblk; const int rem = ncols - nb * 32;
    tr_item(W, ldw, WT, ldt, kb * 64, c0 + nb * 32, rem < 32 ? rem : 32, r0 + nb * 32, scr, lane);
}
constexpr size_t WS_UPD = WS_F1, WS_DEC = WS_LIST;
constexpr size_t OUT_SPREV = 16 * MiB, OUT_OI = 48 * MiB;
constexpr int GP = 72;
#define MFMA32(a, b, c) __builtin_amdgcn_mfma_f32_32x32x16_bf16((a), (b), (c), 0, 0, 0)
__device__ __forceinline__ int crow(int reg, int h) { return (reg & 3) + 8 * (reg >> 2) + 4 * h; }
__device__ __forceinline__ f32x16 mma_tile64(const LAS bf16* A, const LAS bf16* Bt, int lane) {
    const int r = lane & 31, h = lane >> 5; f32x16 acc;
#pragma unroll
    for (int i = 0; i < 16; ++i) acc[i] = 0.f;
#pragma unroll
    for (int kk = 0; kk < 4; ++kk) { const bf16x8 a = *(const LAS bf16x8*)(A + r * GP + kk * 16 + 8 * h), b = *(const LAS bf16x8*)(Bt + r * GP + kk * 16 + 8 * h); acc = MFMA32(a, b, acc); }
    return acc;
}
constexpr int GLA1_HALF = 71168;
__device__ __forceinline__ void gla1_pair(Frame& F, const Args& a, int unit0) {
    const int hw = F.wave >> 2, wl = F.wave & 3, lt = F.tid & 255, lane = F.lane, unit = unit0 + hw;
    const int b = unit >> 7, n = (unit >> 2) & 31, h = unit & 3;
    const size_t tok0 = (size_t)b * SEQ + n * 64;
    const bf16* H = (const bf16*)(a.ws + WS_H);
    LAS unsigned char* L = F.lds + RING_OFF + hw * GLA1_HALF;
    LAS float* CUM = (LAS float*)L;
    LAS bf16* P = (LAS bf16*)L;
    LAS bf16* QD = (LAS bf16*)(L + 16640);
    LAS bf16* KI = (LAS bf16*)(L + 25856);
    LAS bf16* KET = (LAS bf16*)(L + 35072);
    LAS bf16* VT = (LAS bf16*)(L + 44288);
    LAS float* GW = (LAS float*)(L + 62720);
    LAS float* GB = (LAS float*)(L + 66816);
    LAS float* BG = (LAS float*)(L + 67072);
    const float* gw2 = a.in[3]; const float* gb = a.in[4];
#pragma unroll
    for (int k = 0; k < 4; ++k) { const int i = lt + 256 * k; GW[i] = gw2[(i >> 6) * 256 + h * 64 + (i & 63)]; BG[i] = bf2f(H[(tok0 + (i >> 4)) * HP + HC_BG + (i & 15)]); }
    if (lt < 64) GB[lt] = gb[h * 64 + lt];
    v4u qv[2], kv[2], vv[4];
#pragma unroll
    for (int k = 0; k < 2; ++k) { const int idx = lt + 256 * k, t = idx >> 3, d8 = (idx & 7) * 8; qv[k] = *(const GAS v4u*)(H + (tok0 + t) * HP + HC_BQ + h * 64 + d8); kv[k] = *(const GAS v4u*)(H + (tok0 + t) * HP + HC_BK + h * 64 + d8); }
#pragma unroll
    for (int k = 0; k < 4; ++k) { const int idx = lt + 256 * k, j = idx & 63, e8 = (idx >> 6) * 8; vv[k] = *(const GAS v4u*)(H + (tok0 + j) * HP + HC_BV + h * 128 + e8); }
    __syncthreads();
#pragma unroll 4
    for (int k = 0; k < 16; ++k) { const int idx = lt + 256 * k, t = idx >> 6, d = idx & 63; float z = GB[d];
#pragma unroll
        for (int r = 0; r < 16; ++r) z = fmaf(BG[t * 16 + r], GW[r * 64 + d], z);
        const float ls = -(fmaxf(-z, 0.f) + log1pf(__expf(-fabsf(z)))); CUM[t * 65 + d] = ls * (1.f / 16.f); }
    __syncthreads();
#pragma unroll 4
    for (int dd = 0; dd < 16; ++dd) { const int d = wl * 16 + dd; float v = CUM[lane * 65 + d];
#pragma unroll
        for (int o = 1; o < 64; o <<= 1) { const float t = __shfl_up(v, o); if (lane >= o) v += t; }
        CUM[lane * 65 + d] = v; }
    __syncthreads();
    bf16* QG = (bf16*)a.out;
#pragma unroll
    for (int k = 0; k < 2; ++k) { const int idx = lt + 256 * k, t = idx >> 3, d8 = (idx & 7) * 8; unsigned qo[4], ko[4]; const unsigned qw[4] = {qv[k].x, qv[k].y, qv[k].z, qv[k].w}, kw[4] = {kv[k].x, kv[k].y, kv[k].z, kv[k].w};
#pragma unroll
        for (int p2 = 0; p2 < 4; ++p2) { float qd[2], ki[2];
#pragma unroll
            for (int s = 0; s < 2; ++s) { const int d = d8 + 2 * p2 + s; const float c = CUM[t * 65 + d], last = CUM[63 * 65 + d];
                const float q = (s ? __uint_as_float(qw[p2] & 0xffff0000u) : __uint_as_float(qw[p2] << 16)) * 0.125f, kk = s ? __uint_as_float(kw[p2] & 0xffff0000u) : __uint_as_float(kw[p2] << 16);
                qd[s] = q * __expf(c); ki[s] = kk * __expf(-c); KET[d * GP + t] = (bf16)f2bf(kk * __expf(last - c)); }
            qo[p2] = pk2(qd[0], qd[1]); ko[p2] = pk2(ki[0], ki[1]); }
        const v4u qq = (v4u){qo[0], qo[1], qo[2], qo[3]}; *(LAS v4u*)(QD + t * GP + d8) = qq; *(GAS v4u*)(QG + (tok0 + t) * 256 + h * 64 + d8) = qq; *(LAS v4u*)(KI + t * GP + d8) = (v4u){ko[0], ko[1], ko[2], ko[3]}; }
    if (lt < 64) ((float*)(a.ws + WS_DEC))[unit * 64 + lt] = __expf(CUM[63 * 65 + lt]);
#pragma unroll
    for (int k = 0; k < 4; ++k) { const int idx = lt + 256 * k, j = idx & 63, e8 = (idx >> 6) * 8; const v4u v = vv[k];
        VT[(e8 + 0) * GP + j] = (bf16)(v.x & 0xffff); VT[(e8 + 1) * GP + j] = (bf16)(v.x >> 16); VT[(e8 + 2) * GP + j] = (bf16)(v.y & 0xffff); VT[(e8 + 3) * GP + j] = (bf16)(v.y >> 16);
        VT[(e8 + 4) * GP + j] = (bf16)(v.z & 0xffff); VT[(e8 + 5) * GP + j] = (bf16)(v.z >> 16); VT[(e8 + 6) * GP + j] = (bf16)(v.w & 0xffff); VT[(e8 + 7) * GP + j] = (bf16)(v.w >> 16); }
    __syncthreads();
    { const int ti = wl >> 1, tj = wl & 1, nn = lane & 31, hh = lane >> 5;
        if (tj <= ti) { const f32x16 c = mma_tile64(QD + 32 * ti * GP, KI + 32 * tj * GP, lane);
#pragma unroll
            for (int i = 0; i < 16; ++i) { const int qi = 32 * ti + crow(i, hh), kj = 32 * tj + nn; P[qi * GP + kj] = (bf16)f2bf(kj <= qi ? c[i] : 0.f); } }
        else {
#pragma unroll
            for (int i = 0; i < 16; ++i) P[(32 * ti + crow(i, hh)) * GP + 32 * tj + nn] = (bf16)0; } }
    __syncthreads();
    bf16* oi = (bf16*)((unsigned char*)a.out + OUT_OI); float* up = (float*)(a.ws + WS_UPD) + (size_t)unit * 8192;
#pragma unroll
    for (int k = 0; k < 2; ++k) { const int tile = wl * 2 + k, nn = lane & 31, hh = lane >> 5;
      { const int ti = tile >> 2, te = tile & 3;
        const f32x16 c = mma_tile64(P + 32 * ti * GP, VT + 32 * te * GP, lane);
#pragma unroll
        for (int i = 0; i < 16; ++i) oi[(tok0 + 32 * ti + crow(i, hh)) * 512 + h * 128 + 32 * te + nn] = (bf16)f2bf(c[i]); }
      { const int te = tile >> 1, td = tile & 1;
        const f32x16 c = mma_tile64(VT + 32 * te * GP, KET + 32 * td * GP, lane);
#pragma unroll
        for (int i = 0; i < 16; ++i) up[(32 * te + crow(i, hh)) * 64 + 32 * td + nn] = c[i]; } }
    __syncthreads();
}
__device__ __forceinline__ void gla2_scan(Frame& F, const Args& a) {
    const float* UPD = (const float*)(a.ws + WS_UPD); const float* DEC = (const float*)(a.ws + WS_DEC); bf16* SP = (bf16*)((unsigned char*)a.out + OUT_SPREV);
    for (int x = F.vcu * (NWAVES * 64) + F.tid; x < BATCH * 4 * 128 * 16; x += F.G * NWAVES * 64) {
        const int d4 = (x & 15) * 4, e = (x >> 4) & 127, bh = x >> 11, b = bh >> 2, h = bh & 3; f32x4 S = (f32x4){0.f, 0.f, 0.f, 0.f};
        for (int n0 = 0; n0 < 32; n0 += 8) { f32x4 u[8], dc[8];
#pragma unroll
            for (int k = 0; k < 8; ++k) { const int unit = b * 128 + (n0 + k) * 4 + h; u[k] = *(const GAS f32x4*)(UPD + (size_t)unit * 8192 + e * 64 + d4); dc[k] = *(const GAS f32x4*)(DEC + unit * 64 + d4); }
#pragma unroll
            for (int k = 0; k < 8; ++k) { const int unit = b * 128 + (n0 + k) * 4 + h; v2u o; o.x = pk2(S.x, S.y); o.y = pk2(S.z, S.w); *(GAS v2u*)(SP + (size_t)unit * 8192 + e * 64 + d4) = o; S = dc[k] * S + u[k]; } } }
}
constexpr int GLA3_HALF = 61440;
__device__ __forceinline__ void gla3_pair(Frame& F, const Args& a, int unit0) {
    const int hw = F.wave >> 2, wl = F.wave & 3, lt = F.tid & 255, lane = F.lane, unit = unit0 + hw;
    const int b = unit >> 7, n = (unit >> 2) & 31, h = unit & 3;
    const size_t tok0 = (size_t)b * SEQ + n * 64;
    const bf16* H = (const bf16*)(a.ws + WS_H); const bf16* SP = (const bf16*)((const unsigned char*)a.out + OUT_SPREV) + (size_t)unit * 8192; const bf16* oi = (const bf16*)((const unsigned char*)a.out + OUT_OI);
    LAS unsigned char* L = F.lds + RING_OFF + hw * GLA3_HALF;
    LAS bf16* QD = (LAS bf16*)L;
    LAS bf16* ST = (LAS bf16*)(L + 9216);
    LAS float* OF = (LAS float*)(L + 27648);
    const int nn = lane & 31, hh = lane >> 5;
    v4u qreg[2], sreg[4]; bf16 oiv[2][16]; unsigned short brv[16][2];
#pragma unroll
    for (int k = 0; k < 2; ++k) { const int idx = lt + 256 * k, t = idx >> 3, d8 = (idx & 7) * 8; qreg[k] = *(const GAS v4u*)((const bf16*)a.out + (tok0 + t) * 256 + h * 64 + d8); }
#pragma unroll
    for (int k = 0; k < 4; ++k) { const int idx = lt + 256 * k, e = idx >> 3, d8 = (idx & 7) * 8; sreg[k] = *(const GAS v4u*)(SP + e * 64 + d8); }
#pragma unroll
    for (int k = 0; k < 2; ++k) { const int tile = wl * 2 + k, ti = tile >> 2, te = tile & 3;
#pragma unroll
        for (int i = 0; i < 16; ++i) oiv[k][i] = oi[(tok0 + 32 * ti + crow(i, hh)) * 512 + h * 128 + 32 * te + nn]; }
#pragma unroll
    for (int rr = 0; rr < 16; ++rr) { const bf16* br = H + (tok0 + wl * 16 + rr) * HP + HC_BR + h * 128; brv[rr][0] = br[lane]; brv[rr][1] = br[lane + 64]; }
    const float* ng = a.in[5]; const float ng0 = ng[h * 128 + lane], ng1 = ng[h * 128 + lane + 64];
#pragma unroll
    for (int k = 0; k < 2; ++k) { const int idx = lt + 256 * k, t = idx >> 3, d8 = (idx & 7) * 8; *(LAS v4u*)(QD + t * GP + d8) = qreg[k]; }
#pragma unroll
    for (int k = 0; k < 4; ++k) { const int idx = lt + 256 * k, e = idx >> 3, d8 = (idx & 7) * 8; *(LAS v4u*)(ST + e * GP + d8) = sreg[k]; }
    __syncthreads();
#pragma unroll
    for (int k = 0; k < 2; ++k) { const int tile = wl * 2 + k, ti = tile >> 2, te = tile & 3;
      const f32x16 c = mma_tile64(QD + 32 * ti * GP, ST + 32 * te * GP, lane);
#pragma unroll
      for (int i = 0; i < 16; ++i) { const int r = 32 * ti + crow(i, hh), e = 32 * te + nn; OF[r * 132 + e] = c[i] + bf2f(oiv[k][i]); } }
    __syncthreads();
    bf16* O = (bf16*)(a.ws + WS_O);
#pragma unroll
    for (int rr = 0; rr < 16; ++rr) { const int r = wl * 16 + rr; const float x0 = OF[r * 132 + lane], x1 = OF[r * 132 + lane + 64];
        const float mean = wsum(x0 + x1) * (1.f / 128.f), d0 = x0 - mean, d1 = x1 - mean, var = wsum(d0 * d0 + d1 * d1) * (1.f / 128.f), rs = 1.f / sqrtf(var + LN_EPS);
        const float r0 = bf2f(brv[rr][0]), r1 = bf2f(brv[rr][1]);
        bf16* o = O + (tok0 + r) * D + 512 + h * 128;
        o[lane] = (bf16)f2bf(d0 * rs * ng0 * (r0 / (1.f + __expf(-r0)))); o[lane + 64] = (bf16)f2bf(d1 * rs * ng1 * (r1 / (1.f + __expf(-r1)))); }
    __syncthreads();
}
constexpr int SCP = 2048 + 16;
__device__ __forceinline__ unsigned fkey(float f) { const unsigned u = __float_as_uint(f); return (u & 0x80000000u) ? ~u : (u | 0x80000000u); }
__device__ __forceinline__ int wave_sum_dpp(int x) {
    x += __builtin_amdgcn_update_dpp(0, x, 0xB1, 0xF, 0xF, true);
    x += __builtin_amdgcn_update_dpp(0, x, 0x4E, 0xF, 0xF, true);
    x += __builtin_amdgcn_update_dpp(0, x, 0x141, 0xF, 0xF, true);
    x += __builtin_amdgcn_update_dpp(0, x, 0x140, 0xF, 0xF, true);
    x += __builtin_amdgcn_update_dpp(0, x, 0x142, 0xA, 0xF, false);
    x += __builtin_amdgcn_update_dpp(0, x, 0x143, 0xC, 0xF, false);
    return __builtin_amdgcn_readlane(x, 63);
}
#define CNT_GE(acc, k, c) asm volatile("v_cmp_ge_u32 vcc, %1, %2\n\tv_addc_co_u32 %0, vcc, 0, %0, vcc" : "+v"(acc) : "v"(k), "v"(c) : "vcc")
#define CNT_GT(acc, k, c) asm volatile("v_cmp_gt_u32 vcc, %1, %2\n\tv_addc_co_u32 %0, vcc, 0, %0, vcc" : "+v"(acc) : "v"(k), "v"(c) : "vcc")
template <int NCH> __device__ __forceinline__ unsigned topk_search(const unsigned (&key)[32], bool& exact) {
    unsigned K = 0u; exact = false;
#pragma unroll 1
    for (int bit = 31; bit >= 0; --bit) { const unsigned cand = K | (1u << bit); int acc = 0;
#pragma unroll
        for (int j = 0; j < NCH * 4; ++j) CNT_GE(acc, key[j], cand);
        const int cnt = wave_sum_dpp(acc);
        if (cnt >= 256) { K = cand; if (cnt == 256) { exact = true; break; } } }
    return K;
}
template <int NCH> __device__ __forceinline__ int count_gt(const unsigned (&key)[32], unsigned K) { int acc = 0;
#pragma unroll
    for (int j = 0; j < NCH * 4; ++j) CNT_GT(acc, key[j], K);
    return wave_sum_dpp(acc); }
__device__ __forceinline__ void dsa1_unit(Frame& F, const Args& a, int b, int qt) {
    const int lane = F.lane, w = F.wave, fr = lane & 15, fq = lane >> 4, t0 = qt * 16;
    const bf16* H = (const bf16*)(a.ws + WS_H) + (size_t)b * SEQ * HP;
    LAS float* SC = (LAS float*)(F.lds + RING_OFF);
    bf16x8 af[4][2]; float wq[4][4];
#pragma unroll
    for (int qg = 0; qg < 4; ++qg) {
#pragma unroll
        for (int kk = 0; kk < 2; ++kk) af[qg][kk] = *(const GAS bf16x8*)(H + (size_t)(t0 + qg * 4 + (fr >> 2)) * HP + HC_IQ + (fr & 3) * 64 + kk * 32 + fq * 8);
        const v2u wv = *(const GAS v2u*)(H + (size_t)(t0 + qg * 4 + fq) * HP + HC_IW);
        wq[qg][0] = __uint_as_float(wv.x << 16); wq[qg][1] = __uint_as_float(wv.x & 0xffff0000u); wq[qg][2] = __uint_as_float(wv.y << 16); wq[qg][3] = __uint_as_float(wv.y & 0xffff0000u); }
    const int nkb = qt + 1, nmine = (nkb - w + 7) >> 3;
#ifndef PROBE
#define PROBE -1
#endif
    for (int _rp = 0; _rp < (PROBE == 22 ? 2 : 1); ++_rp)
#pragma unroll 1
    for (int i0 = 0; i0 < nmine; i0 += 8) {
        bf16x8 bfr[8][2];
#pragma unroll
        for (int u = 0; u < 8; ++u) if (i0 + u < nmine) { const int kb = w + 8 * (i0 + u);
#pragma unroll
            for (int kk = 0; kk < 2; ++kk) bfr[u][kk] = *(const GAS bf16x8*)(H + (size_t)(kb * 16 + fr) * HP + HC_IK + kk * 32 + fq * 8); }
#pragma unroll
        for (int u = 0; u < 8; ++u) if (i0 + u < nmine) { const int kb = w + 8 * (i0 + u);
#pragma unroll
            for (int qg = 0; qg < 4; ++qg) { f32x4 c = (f32x4){0.f, 0.f, 0.f, 0.f};
                c = __builtin_amdgcn_mfma_f32_16x16x32_bf16(af[qg][0], bfr[u][0], c, 0, 0, 0); c = __builtin_amdgcn_mfma_f32_16x16x32_bf16(af[qg][1], bfr[u][1], c, 0, 0, 0);
                float sc = 0.f;
#pragma unroll
                for (int i = 0; i < 4; ++i) sc += wq[qg][i] * fmaxf(c[i], 0.f);
                SC[(qg * 4 + fq) * SCP + kb * 16 + fr] = sc; } } }
    __syncthreads();
    unsigned long long* MASK = (unsigned long long*)(a.ws + WS_MASK);
    for (int _rp = 0; _rp < (PROBE == 23 ? 2 : 1); ++_rp)
#pragma unroll 1
    for (int rr = 0; rr < 2; ++rr) { const int r = w + 8 * rr, t = t0 + r, jmax = t >> 6, nch = (jmax >> 2) + 1;
        unsigned key[32];
#pragma unroll
        for (int c = 0; c < 8; ++c) {
            if (c < nch) {
#pragma unroll
                for (int jj = 0; jj < 4; ++jj) { const int j = c * 4 + jj, s = j * 64 + lane; const float f = SC[r * SCP + s]; key[j] = (s <= t) ? fkey(f) : 0u; } }
            else {
#pragma unroll
                for (int jj = 0; jj < 4; ++jj) key[c * 4 + jj] = 0u; } }
        unsigned long long mine = 0ull;
        if (t < 256) {
#pragma unroll
            for (int j = 0; j < 4; ++j) { const unsigned long long bm = __ballot(j * 64 + lane <= t); if (lane == j) mine = bm; }
        } else {
            unsigned K; bool exact; int cgt = 0;
            switch (nch) {
                case 1: K = topk_search<1>(key, exact); if (!exact) cgt = count_gt<1>(key, K); break;
                case 2: K = topk_search<2>(key, exact); if (!exact) cgt = count_gt<2>(key, K); break;
                case 3: K = topk_search<3>(key, exact); if (!exact) cgt = count_gt<3>(key, K); break;
                case 4: K = topk_search<4>(key, exact); if (!exact) cgt = count_gt<4>(key, K); break;
                case 5: K = topk_search<5>(key, exact); if (!exact) cgt = count_gt<5>(key, K); break;
                case 6: K = topk_search<6>(key, exact); if (!exact) cgt = count_gt<6>(key, K); break;
                case 7: K = topk_search<7>(key, exact); if (!exact) cgt = count_gt<7>(key, K); break;
                default: K = topk_search<8>(key, exact); if (!exact) cgt = count_gt<8>(key, K); break;
            }
            const int quota = 256 - cgt; int taken = 0;
#pragma unroll
            for (int j = 0; j < 32; ++j) {
                unsigned long long bm;
                if (exact) bm = __ballot(key[j] >= K);
                else { const unsigned long long eq = __ballot(key[j] == K); const int pre = __builtin_amdgcn_mbcnt_hi((unsigned)(eq >> 32), __builtin_amdgcn_mbcnt_lo((unsigned)eq, 0u));
                       bm = __ballot(key[j] > K || (key[j] == K && taken + pre < quota)); taken += __builtin_popcountll(eq); }
                if (lane == j) mine = bm; }
        }
        if (lane < 32) MASK[((size_t)b * SEQ + t) * 32 + lane] = mine; }
    __syncthreads();
}

constexpr float LOG2E = 1.4426950408889634f, SCL2 = 0.125f * 1.4426950408889634f;
__device__ __forceinline__ bf16x8 pack_step(const f32x16& x, int s) {
    v4u p;
    asm volatile("v_cvt_pk_bf16_f32 %0, %4, %5\n\tv_cvt_pk_bf16_f32 %1, %6, %7\n\tv_cvt_pk_bf16_f32 %2, %8, %9\n\tv_cvt_pk_bf16_f32 %3, %10, %11\n\ts_nop 1"
                 : "=&v"(p[0]), "=&v"(p[1]), "=&v"(p[2]), "=&v"(p[3])
                 : "v"(x[8 * s]), "v"(x[8 * s + 1]), "v"(x[8 * s + 2]), "v"(x[8 * s + 3]), "v"(x[8 * s + 4]), "v"(x[8 * s + 5]), "v"(x[8 * s + 6]), "v"(x[8 * s + 7]));
    return __builtin_bit_cast(bf16x8, p);
}
__device__ __forceinline__ void dsa2_unit(Frame& F, const Args& a, int b, int g, int qb) {
    const int tid = F.tid, lane = F.lane, w = F.wave, n = lane & 31, h = lane >> 5, hl = w >> 1, hh = g * 4 + hl, t0 = qb * 64, tq0 = t0 + 32 * (w & 1);
    const bf16* H = (const bf16*)(a.ws + WS_H) + (size_t)b * SEQ * HP;
    const unsigned long long* MW = (const unsigned long long*)(a.ws + WS_MASK) + ((size_t)b * SEQ + tq0 + n) * 32;
    LAS unsigned char* L = F.lds + RING_OFF;
    LAS float* BT = (LAS float*)(L + 55296);
    LAS bf16* OS = (LAS bf16*)(L + 57344 + w * 4608);
    const float* relb = a.in[1];
    BT[tid] = relb[T5B[tid & 127] * 8 + g * 4 + (tid >> 7)] * LOG2E;
    const float B31 = relb[31 * 8 + hh] * LOG2E;
    bf16x8 Qf[4];
#pragma unroll
    for (int kk = 0; kk < 4; ++kk) Qf[kk] = *(const GAS bf16x8*)(H + (size_t)(tq0 + n) * HP + HC_AQ + hh * 64 + kk * 16 + 8 * h);
    f32x16 O[2];
#pragma unroll
    for (int i = 0; i < 16; ++i) { O[0][i] = 0.f; O[1][i] = 0.f; }
    float m = -1e30f, lsum = 0.f;
    const int krow = tid >> 3, kc8 = (tid & 7) * 8, vrow = tid & 63, vc8 = (tid >> 6) * 8, nt = qb + 1;
    v4u kreg, vreg;
#define DSA_LOADT(kt) do { kreg = *(const GAS v4u*)(H + (size_t)((kt) * 64 + krow) * HP + HC_AK + g * 64 + kc8); vreg = *(const GAS v4u*)(H + (size_t)((kt) * 64 + vrow) * HP + HC_AV + g * 64 + vc8); } while (0)
#define DSA_WRITET(bu) do { LAS bf16* _ks = (LAS bf16*)(L + (bu) * 18432); LAS bf16* _vt = (LAS bf16*)(L + (bu) * 18432 + 9216); *(LAS v4u*)(_ks + krow * GP + kc8) = kreg; \
        _vt[(vc8 + 0) * GP + vrow] = (bf16)(vreg.x & 0xffff); _vt[(vc8 + 1) * GP + vrow] = (bf16)(vreg.x >> 16); _vt[(vc8 + 2) * GP + vrow] = (bf16)(vreg.y & 0xffff); _vt[(vc8 + 3) * GP + vrow] = (bf16)(vreg.y >> 16); \
        _vt[(vc8 + 4) * GP + vrow] = (bf16)(vreg.z & 0xffff); _vt[(vc8 + 5) * GP + vrow] = (bf16)(vreg.z >> 16); _vt[(vc8 + 6) * GP + vrow] = (bf16)(vreg.w & 0xffff); _vt[(vc8 + 7) * GP + vrow] = (bf16)(vreg.w >> 16); } while (0)
#define DSA_QK(Sd, bu) do { const LAS bf16* _ks = (const LAS bf16*)(L + (bu) * 18432); _Pragma("unroll") for (int sb = 0; sb < 2; ++sb) { _Pragma("unroll") for (int i = 0; i < 16; ++i) Sd[sb][i] = 0.f; \
        _Pragma("unroll") for (int kk = 0; kk < 4; ++kk) { const bf16x8 ka = *(const LAS bf16x8*)(_ks + (32 * sb + n) * GP + kk * 16 + 8 * h); Sd[sb] = MFMA32(ka, Qf[kk], Sd[sb]); } } } while (0)
    DSA_LOADT(0); DSA_WRITET(0);
    if (nt > 1) { DSA_LOADT(1); DSA_WRITET(1); }
    if (nt > 2) DSA_LOADT(2);
    unsigned long long mw = MW[0];
    __syncthreads();
#define DSA_MASK(p, wsh, pos) do { int _t; asm volatile("v_bfe_i32 %1, %2, %3, 1\n\tv_and_b32 %0, %0, %1" : "+v"(p), "=&v"(_t) : "v"(wsh), "n"(pos)); } while (0)
#define DSA_TILE(Sc, Sn, kt) do { \
        const int s1 = slot == 2 ? 0 : slot + 1, s2 = s1 == 2 ? 0 : s1 + 1; \
        if ((kt) + 2 < nt) DSA_WRITET(s2); \
        if ((kt) + 3 < nt) DSA_LOADT((kt) + 3); \
        const unsigned long long mwn = ((kt) + 1 < nt) ? MW[(kt) + 1] : 0ull; \
        if ((kt) + 1 < nt) DSA_QK(Sn, s1); \
        const LAS bf16* VT = (const LAS bf16*)(L + slot * 18432 + 9216); \
        const unsigned wsh0 = (unsigned)mw >> (4 * h), wsh1 = (unsigned)(mw >> 32) >> (4 * h); \
        float mx = -1e30f; \
        if ((kt) < qb - 2) {     \
            _Pragma("unroll") for (int sb = 0; sb < 2; ++sb) _Pragma("unroll") for (int i = 0; i < 16; ++i) { Sc[sb][i] = fmaf(Sc[sb][i], SCL2, B31); mx = fmaxf(mx, Sc[sb][i]); } \
        } else { const int dbase = tq0 + n - (kt) * 64 - 4 * h; \
            _Pragma("unroll") for (int sb = 0; sb < 2; ++sb) _Pragma("unroll") for (int i = 0; i < 16; ++i) { int dist = dbase - (32 * sb + (i & 3) + 8 * (i >> 2)); dist = dist < 0 ? 0 : (dist > 127 ? 127 : dist); \
                Sc[sb][i] = fmaf(Sc[sb][i], SCL2, BT[hl * 128 + dist]); mx = fmaxf(mx, Sc[sb][i]); } } \
        mx = fmaxf(mx, __shfl_xor(mx, 32)); \
        const float mn = fmaxf(m, mx); \
        if (__any(mn > m)) { const float al = __builtin_amdgcn_exp2f(m - mn); _Pragma("unroll") for (int i = 0; i < 16; ++i) { O[0][i] *= al; O[1][i] *= al; } lsum *= al; } \
        m = mn; \
        _Pragma("unroll") for (int i = 0; i < 16; ++i) { float p0 = __builtin_amdgcn_exp2f(Sc[0][i] - m), p1 = __builtin_amdgcn_exp2f(Sc[1][i] - m); \
            DSA_MASK(p0, wsh0, (i & 3) + 8 * (i >> 2)); DSA_MASK(p1, wsh1, (i & 3) + 8 * (i >> 2)); Sc[0][i] = p0; Sc[1][i] = p1; lsum += p0 + p1; } \
        _Pragma("unroll") for (int sb = 0; sb < 2; ++sb) _Pragma("unroll") for (int s = 0; s < 2; ++s) { const bf16x8 pf = pack_step(Sc[sb], s); \
            _Pragma("unroll") for (int db = 0; db < 2; ++db) { const LAS bf16* vp = VT + (32 * db + n) * GP + 32 * sb + 16 * s + 4 * h; \
                const bf16x4 lo = *(const LAS bf16x4*)vp, hi = *(const LAS bf16x4*)(vp + 8); \
                const bf16x8 vf = __builtin_shufflevector(lo, hi, 0, 1, 2, 3, 4, 5, 6, 7); O[db] = MFMA32(vf, pf, O[db]); } } \
        mw = mwn; slot = s1; \
        asm volatile("s_waitcnt lgkmcnt(0)" ::: "memory"); __builtin_amdgcn_s_barrier(); asm volatile("" ::: "memory"); } while (0)
    f32x16 SA[2], SB[2];
    DSA_QK(SA, 0);
    int slot = 0;
#pragma unroll 1
    for (int kt = 0; kt < nt; kt += 2) {
        DSA_TILE(SA, SB, kt);
        if (kt + 1 < nt) DSA_TILE(SB, SA, kt + 1);
    }
#undef DSA_TILE
#undef DSA_MASK
#undef DSA_LOADT
#undef DSA_WRITET
#undef DSA_QK
    const float lt = lsum + __shfl_xor(lsum, 32), inv = 1.f / lt;
#pragma unroll
    for (int db = 0; db < 2; ++db)
#pragma unroll
        for (int i = 0; i < 16; ++i) OS[n * GP + 32 * db + crow(i, h)] = (bf16)f2bf(O[db][i] * inv);
    asm volatile("s_waitcnt lgkmcnt(0)" ::: "memory");
    bf16* Og = (bf16*)(a.ws + WS_O) + ((size_t)b * SEQ + tq0) * D + hh * 64;
#pragma unroll
    for (int k = 0; k < 4; ++k) { const int idx = lane + 64 * k, row = idx >> 3, c8 = (idx & 7) * 8; *(GAS v4u*)(Og + (size_t)row * D + c8) = *(const LAS v4u*)(OS + row * GP + c8); }
    __syncthreads();
}
#define CONV_MOE 1
__device__ __forceinline__ void s5_build_group(Frame& F, const Args& a, int g, int part, LAS unsigned char* base) {
    LAS f32x2* AP = (LAS f32x2*)base;
    LAS f32x2* BB = (LAS f32x2*)(base + 8704);
    LAS f32x2* CC = (LAS f32x2*)(base + 8704 + 8192);
    LAS float* KT = (LAS float*)(base + 8704 + 16384);
    const float* lam_re = a.in[8]; const float* lam_im = a.in[9]; const float* log_dt = a.in[10];
    const float* b_re = a.in[11]; const float* b_im = a.in[12]; const float* c_re = a.in[13]; const float* c_im = a.in[14]; const float* dsk = a.in[15];
    const int tid = F.tid;
    if (tid < 64) { const int p = tid;
        const float lr = fminf(lam_re[g * 64 + p], -1e-4f), li = lam_im[g * 64 + p], dt = expf(log_dt[g]);
        const float mag = expf(lr * dt), are = mag * cosf(li * dt), aim = mag * sinf(li * dt);
        const float den = lr * lr + li * li, nr = are - 1.f, cre = (nr * lr + aim * li) / den, cim = (aim * lr - nr * li) / den;
        float pr = 1.f, pi = 0.f;
        for (int m = 0; m <= 16; ++m) { AP[m * 64 + p] = (f32x2){pr, pi}; const float t = pr * are - pi * aim; pi = pr * aim + pi * are; pr = t; }
        for (int c = 0; c < 16; ++c) { const float br = b_re[(g * 64 + p) * 16 + c], bi = b_im[(g * 64 + p) * 16 + c]; BB[p * 16 + c] = (f32x2){cre * br - cim * bi, cre * bi + cim * br}; }
    }
    for (int e = tid; e < 1024; e += NWAVES * 64) CC[e] = (f32x2){c_re[g * 1024 + e], c_im[g * 1024 + e]};
    __syncthreads();
    for (int e = tid; e < 4096; e += NWAVES * 64) { const int m = e >> 8, c = (e >> 4) & 15, c2 = e & 15; float acc = 0.f;
        for (int p = 0; p < 64; ++p) { const f32x2 cc = CC[c * 64 + p], ap = AP[m * 64 + p], bb = BB[p * 16 + c2];
            const float tr = cc.x * ap.x - cc.y * ap.y, ti = cc.x * ap.y + cc.y * ap.x; acc += tr * bb.x - ti * bb.y; }
        KT[e] = acc; }
    __syncthreads();
    bf16* MQ = (bf16*)(a.ws + WS_MQ) + (size_t)g * 256 * 384; bf16* PG = (bf16*)(a.ws + WS_PG) + (size_t)g * 256 * 256;
    for (int v = tid; v < 64 * 48; v += NWAVES * 64) { const int row = 64 * part + v / 48, cv = v % 48, j = row >> 4, c = row & 15, col0 = cv * 8; float val[8];
        if (col0 < 256) { const int i = col0 >> 4, c20 = col0 & 15;
#pragma unroll
            for (int q = 0; q < 8; ++q) { float t = (i <= j) ? KT[((j - i) << 8) + (c << 4) + c20 + q] : 0.f; if (i == j && c == c20 + q) t += dsk[g * 16 + c]; val[q] = t; } }
        else { const int p0 = (col0 - 256) & 63; const bool im = (col0 - 256) >= 64;
#pragma unroll
            for (int q = 0; q < 8; ++q) { const f32x2 cc = CC[c * 64 + p0 + q], ap = AP[(j + 1) * 64 + p0 + q]; val[q] = im ? -(cc.x * ap.y + cc.y * ap.x) : (cc.x * ap.x - cc.y * ap.y); } }
        v4u o; o.x = pk2(val[0], val[1]); o.y = pk2(val[2], val[3]); o.z = pk2(val[4], val[5]); o.w = pk2(val[6], val[7]);
        *(GAS v4u*)(MQ + (size_t)row * 384 + col0) = o; }
    for (int v = tid; v < 64 * 32; v += NWAVES * 64) { const int row = 64 * part + (v >> 5), col0 = (v & 31) * 8, i = col0 >> 4, c20 = col0 & 15; float val[8];
        if (row < 128) { const int p = row & 63; const bool im = row >= 64; const f32x2 ap = AP[(15 - i) * 64 + p];
#pragma unroll
            for (int q = 0; q < 8; ++q) { const f32x2 bb = BB[p * 16 + c20 + q]; val[q] = im ? (ap.x * bb.y + ap.y * bb.x) : (ap.x * bb.x - ap.y * bb.y); } }
        else {
#pragma unroll
            for (int q = 0; q < 8; ++q) val[q] = 0.f; }
        v4u o; o.x = pk2(val[0], val[1]); o.y = pk2(val[2], val[3]); o.z = pk2(val[4], val[5]); o.w = pk2(val[6], val[7]);
        *(GAS v4u*)(PG + (size_t)row * 256 + col0) = o; }
    __syncthreads();
}
__device__ __forceinline__ void s5_scan_local(Frame& F, const Args& a) {
    const float* lam_re = a.in[8]; const float* lam_im = a.in[9]; const float* log_dt = a.in[10];
    bf16* UA = (bf16*)(a.ws + WS_H); const float* Z = (const float*)(a.ws + WS_H + 96 * MiB);
    const int p = F.lane, nun = (512 - F.vcu + F.G - 1) / F.G;
    for (int q = F.wave; q < 2 * nun; q += NWAVES) { const int L = (q >> 1) * F.G + F.vcu, g = L >> 3, b = 2 * (L & 7) + (q & 1);
        const float lr = fminf(lam_re[g * 64 + p], -1e-4f), li = lam_im[g * 64 + p], dt = expf(log_dt[g]);
        const float mag = expf(lr * dt); float ar = mag * cosf(li * dt), ai = mag * sinf(li * dt);
#pragma unroll
        for (int k = 0; k < 4; ++k) { const float t = ar * ar - ai * ai; ai = 2.f * ar * ai; ar = t; }
        float sr = 0.f, si = 0.f;
        const float* zp = Z + ((size_t)(g * 2048 + b * 128)) * 128 + p; bf16* up = UA + ((size_t)(g * 2048 + b * 128)) * 384 + 256 + p;
        for (int n0 = 0; n0 < 128; n0 += 16) { float zr[16], zi[16];
#pragma unroll
            for (int k = 0; k < 16; ++k) { zr[k] = zp[(size_t)(n0 + k) * 128]; zi[k] = zp[(size_t)(n0 + k) * 128 + 64]; }
#pragma unroll
            for (int k = 0; k < 16; ++k) { up[(size_t)(n0 + k) * 384] = (bf16)f2bf(sr); up[(size_t)(n0 + k) * 384 + 64] = (bf16)f2bf(si);
                const float t = ar * sr - ai * si + zr[k]; si = ar * si + ai * sr + zi[k]; sr = t; } } }
}
template <int COMB, bool ROUTE, bool F32OUT>
__device__ __forceinline__ void ln_phase(Frame& F, const bf16* src, const bf16* cb, const float* gamma, const float* beta, float* dst, bf16* dstb,
                                         const float* rc, const float* rbc, const float* rf, const float* rbf, unsigned* cnt, int* list, float* tokw) {
    const int gw = F.vcu * NWAVES + F.wave, NGW = F.G * NWAVES, lane = F.lane;
    f32x4 gv[4], bv[4];
#pragma unroll
    for (int j = 0; j < 4; ++j) { gv[j] = ((const GAS f32x4*)gamma)[lane + 64 * j]; bv[j] = ((const GAS f32x4*)beta)[lane + 64 * j]; }
    volatile LAS unsigned* RT = (volatile LAS unsigned*)(F.lds + RING_OFF);
    int lrow = F.wave * 16;
    f32x4 rcv[16];
    LAS f32x4* RF = (LAS f32x4*)(F.lds + RING_OFF + 4096);
    if (ROUTE) { if (F.tid < 16) RT[F.tid] = 0u;
#pragma unroll
        for (int j = 0; j < 4; ++j)
#pragma unroll
            for (int q = 0; q < 4; ++q) rcv[j * 4 + q] = *(const GAS f32x4*)(rc + (size_t)(256 * j + 4 * lane + q) * 4);
        for (int i = F.tid; i < 4096; i += NWAVES * 64) RF[i] = ((const GAS f32x4*)rf)[i];
        __syncthreads(); }
    v2u nx[4], na[4], nb[4];
    { const GAS v2u* xr = (const GAS v2u*)(src + (size_t)gw * D) + lane;
#pragma unroll
      for (int j = 0; j < 4; ++j) nx[j] = xr[64 * j];
      if (COMB == 1) { const GAS v2u* c0 = (const GAS v2u*)(cb + (size_t)gw * D) + lane; const GAS v2u* c1 = (const GAS v2u*)(cb + ((size_t)NTOK + gw) * D) + lane;
#pragma unroll
          for (int j = 0; j < 4; ++j) { na[j] = c0[64 * j]; nb[j] = c1[64 * j]; } } }
    for (int row = gw; row < NTOK; row += NGW) {
        f32x4 v[4]; float s = 0.f;
#pragma unroll
        for (int j = 0; j < 4; ++j) { v[j].x = __uint_as_float(nx[j].x << 16); v[j].y = __uint_as_float(nx[j].x & 0xffff0000u); v[j].z = __uint_as_float(nx[j].y << 16); v[j].w = __uint_as_float(nx[j].y & 0xffff0000u); }
        if (COMB == 1) {
#pragma unroll
            for (int j = 0; j < 4; ++j) { const v2u a = na[j], b = nb[j];
                v[j].x = v[j].x * ALPHA + (__uint_as_float(a.x << 16) + __uint_as_float(b.x << 16)); v[j].y = v[j].y * ALPHA + (__uint_as_float(a.x & 0xffff0000u) + __uint_as_float(b.x & 0xffff0000u));
                v[j].z = v[j].z * ALPHA + (__uint_as_float(a.y << 16) + __uint_as_float(b.y << 16)); v[j].w = v[j].w * ALPHA + (__uint_as_float(a.y & 0xffff0000u) + __uint_as_float(b.y & 0xffff0000u)); } }
        if (row + NGW < NTOK) { const int nr = row + NGW; const GAS v2u* xr = (const GAS v2u*)(src + (size_t)nr * D) + lane;
#pragma unroll
            for (int j = 0; j < 4; ++j) nx[j] = xr[64 * j];
            if (COMB == 1) { const GAS v2u* c0 = (const GAS v2u*)(cb + (size_t)nr * D) + lane; const GAS v2u* c1 = (const GAS v2u*)(cb + ((size_t)NTOK + nr) * D) + lane;
#pragma unroll
                for (int j = 0; j < 4; ++j) { na[j] = c0[64 * j]; nb[j] = c1[64 * j]; } } }
#pragma unroll
        for (int j = 0; j < 4; ++j) s += (v[j].x + v[j].y) + (v[j].z + v[j].w);
        const float mean = wsum(s) * (1.f / D); float s2 = 0.f;
#pragma unroll
        for (int j = 0; j < 4; ++j) { v[j] = v[j] - mean; s2 += (v[j].x * v[j].x + v[j].y * v[j].y) + (v[j].z * v[j].z + v[j].w * v[j].w); }
        const float rstd = 1.f / sqrtf(wsum(s2) * (1.f / D) + LN_EPS);
        GAS v2u* ob = (GAS v2u*)(dstb + (size_t)row * D) + lane;
#pragma unroll
        for (int j = 0; j < 4; ++j) { v[j] = v[j] * rstd * gv[j] + bv[j]; v2u w; w.x = pk2(v[j].x, v[j].y); w.y = pk2(v[j].z, v[j].w); if (dstb) ob[64 * j] = w;
            if (F32OUT) ((GAS f32x4*)(dst + (size_t)row * D) + lane)[64 * j] = v[j]; }
        if (ROUTE) {
            float gl[4] = {0.f, 0.f, 0.f, 0.f};
#pragma unroll
            for (int j = 0; j < 4; ++j)
#pragma unroll
                for (int q = 0; q < 4; ++q) { const f32x4 r = rcv[j * 4 + q]; const float xv = v[j][q];
                    gl[0] = fmaf(xv, r.x, gl[0]); gl[1] = fmaf(xv, r.y, gl[1]); gl[2] = fmaf(xv, r.z, gl[2]); gl[3] = fmaf(xv, r.w, gl[3]); }
#pragma unroll
            for (int g = 0; g < 4; ++g) gl[g] = wsum(gl[g]) + rbc[g];
            int gs = 0; float gm = gl[0];
#pragma unroll
            for (int g = 1; g < 4; ++g) if (gl[g] > gm) { gm = gl[g]; gs = g; }
            float se = 0.f;
#pragma unroll
            for (int g = 0; g < 4; ++g) se += expf(gl[g] - gm);
            const float gwt = 1.f / se;
            float fl[4] = {0.f, 0.f, 0.f, 0.f}; const LAS f32x4* rfg = RF + gs * D;
#pragma unroll
            for (int j = 0; j < 4; ++j)
#pragma unroll
                for (int q = 0; q < 4; ++q) { const f32x4 r = rfg[256 * j + 4 * lane + q]; const float xv = v[j][q];
                    fl[0] = fmaf(xv, r.x, fl[0]); fl[1] = fmaf(xv, r.y, fl[1]); fl[2] = fmaf(xv, r.z, fl[2]); fl[3] = fmaf(xv, r.w, fl[3]); }
#pragma unroll
            for (int e = 0; e < 4; ++e) fl[e] = wsum(fl[e]) + rbf[gs * 4 + e];
            int i1 = 0; float v1 = fl[0];
#pragma unroll
            for (int e = 1; e < 4; ++e) if (fl[e] > v1) { v1 = fl[e]; i1 = e; }
            int i2 = -1; float v2 = -INFINITY;
#pragma unroll
            for (int e = 0; e < 4; ++e) if (e != i1 && fl[e] > v2) { v2 = fl[e]; i2 = e; }
            const float e2 = expf(v2 - v1), w1 = gwt / (1.f + e2), w2 = gwt * e2 / (1.f + e2);
            if (lane == 0) { const int ea = gs * 4 + i1, eb = gs * 4 + i2;
                const unsigned pa = __hip_atomic_fetch_add((LAS unsigned*)RT + ea, 1u, __ATOMIC_RELAXED, __HIP_MEMORY_SCOPE_WORKGROUP), pb = __hip_atomic_fetch_add((LAS unsigned*)RT + eb, 1u, __ATOMIC_RELAXED, __HIP_MEMORY_SCOPE_WORKGROUP);
                RT[64 + lrow] = (unsigned)ea | ((unsigned)eb << 8) | (pa << 16); RT[64 + 128 + lrow] = pb; tokw[row * 2] = w1; tokw[row * 2 + 1] = w2; }
            ++lrow;
        }
    }
    if (ROUTE) {
        __syncthreads();
        if (F.tid < 16) RT[32 + F.tid] = __hip_atomic_fetch_add(cnt + 64 * F.tid, RT[F.tid], RLX_AGENT);
        __syncthreads();
        if (F.tid < 128) { const int lr = F.tid, rw = lr >> 4, it = lr & 15, row = F.vcu * NWAVES + rw + it * NGW;
            if (row < NTOK) { const unsigned e = RT[64 + lr], pb = RT[64 + 128 + lr]; const int ea = e & 255, eb = (e >> 8) & 255; const unsigned pa = e >> 16;
                list[ea * NTOK + RT[32 + ea] + pa] = row * 2; list[eb * NTOK + RT[32 + eb] + pb] = row * 2 + 1; } }
        __syncthreads();
    }
}

__device__ __forceinline__ void moe_convert(const Args& a, int layer, int part  , int wk, int nw, LAS float* scr, int lane) {
    unsigned char* ws = a.ws;
    constexpr int PER = 64, NU = NEXP * 2 * 4 * PER, PERD = 256, ND = NEXP * PERD;
    auto desc = [&](int it) { TrDesc d;
        if (it < NU) { int j = it / PER; const int r = it % PER, pn = j & 3; j >>= 2; const int which = j & 1; j >>= 1; const int le = layer * NEXP + j, kb = r >> 2, nb = r & 3;
            d.W = a.in[27 + which] + (size_t)le * D * MOE_F; d.ldw = MOE_F; d.WT = (bf16*)(ws + WS_WGU) + (size_t)le * 1024 * D; d.ldt = D; d.k0 = kb * 64; d.c0 = pn * 128 + nb * 32; d.nc = 32; d.r0 = pn * 256 + which * 128 + nb * 32; }
        else { const int q = it - NU, le = layer * NEXP + q / PERD, r = q % PERD, kb = r >> 5, nb = r & 31;
            d.W = a.in[29] + (size_t)le * MOE_F * D; d.ldw = D; d.WT = (bf16*)(ws + WS_WD) + (size_t)le * D * MOE_F; d.ldt = MOE_F; d.k0 = kb * 64; d.c0 = nb * 32; d.nc = 32; d.r0 = nb * 32; }
        return d; };
    const int lo = part == 1 ? NU : 0, hi = part == 0 ? NU : NU + ND;
    f32x4 va[8], vb[8]; int it = lo + wk;
    if (it < hi) { TrDesc d0 = desc(it); tr_load(d0, va, lane); }
    for (; it < hi; it += 2 * nw) {
        const TrDesc d0 = desc(it); const bool h1 = it + nw < hi, h2 = it + 2 * nw < hi;
        if (h1) { const TrDesc d1 = desc(it + nw); tr_load(d1, vb, lane); }
        tr_store(d0, va, scr, lane);
        if (h2) { const TrDesc d2 = desc(it + 2 * nw); tr_load(d2, va, lane); }
        if (h1) { const TrDesc d1 = desc(it + nw); tr_store(d1, vb, scr, lane); }
    }
}
__device__ __forceinline__ void p0_prologue(Frame& F, const Args& a) {
    for (int u = F.vcu; u < 256; u += F.G) s5_build_group(F, a, u >> 2, u & 3, F.lds + RING_OFF);
    LAS float* scr = (LAS float*)(F.lds + RING_OFF + F.wave * 16384);
    const int gw = F.vcu * NWAVES + F.wave, NGW = F.G * NWAVES, lane = F.lane;
    unsigned char* ws = a.ws;
    { const float* x = a.in[0]; bf16* xb = (bf16*)(ws + WS_XB); const size_t n8 = (size_t)NTOK * D / 8, st = (size_t)NGW * 64;
      for (size_t i = (size_t)gw * 64 + lane; i < n8; i += 4 * st) { f32x4 v0[4], v1[4];
#pragma unroll
          for (int u = 0; u < 4; ++u) if (i + u * st < n8) { v0[u] = __builtin_nontemporal_load((const GAS f32x4*)(x + (i + u * st) * 8)); v1[u] = __builtin_nontemporal_load((const GAS f32x4*)(x + (i + u * st) * 8 + 4)); }
#pragma unroll
          for (int u = 0; u < 4; ++u) if (i + u * st < n8) { v4u o; o.x = pk2(v0[u].x, v0[u].y); o.y = pk2(v0[u].z, v0[u].w); o.z = pk2(v1[u].x, v1[u].y); o.w = pk2(v1[u].z, v1[u].w);
              *(GAS v4u*)(xb + (i + u * st) * 8) = o; } } }
    { const float* W = a.in[2]; bf16* WT = (bf16*)(ws + WS_WIN);
      const int n0 = tr_seg_items(D, 1088), n1 = tr_seg_items(D, 4), n2 = tr_seg_items(D, 16), n3 = tr_seg_items(D, 1024), n4 = tr_seg_items(D, 512);
      for (int it = gw; it < n0; it += NGW) tr_seg(W, ABP, D, 0, 1088, WT, D, 0, it, scr, lane);
      for (int it = gw; it < n1; it += NGW) tr_seg(W, ABP, D, 1088, 4, WT, D, HC_IW, it, scr, lane);
      for (int it = gw; it < n2; it += NGW) tr_seg(W, ABP, D, 2116, 16, WT, D, HC_BG, it, scr, lane);
      for (int it = gw; it < n3; it += NGW) tr_seg(W, ABP, D, 1092, 1024, WT, D, HC_BQ, it, scr, lane);
      for (int it = gw; it < n4; it += NGW) tr_seg(W, ABP, D, 2132, 512, WT, D, HC_BR, it, scr, lane);
      for (int i = gw * 64 + lane; i < 172 * (D / 8); i += NGW * 64) { const int rr = i / (D / 8), cc = i % (D / 8); const int row = rr < 4 ? 1092 + rr : 1112 + (rr - 4);
          *(GAS v4u*)(WT + (size_t)row * D + cc * 8) = (v4u){0u, 0u, 0u, 0u}; } }
    { const int n = tr_seg_items(D, D);
      for (int it = gw; it < n; it += NGW) tr_seg(a.in[6], D, D, 0, D, (bf16*)(ws + WS_WOUT), D, 0, it, scr, lane);
      for (int it = gw; it < n; it += NGW) tr_seg(a.in[7], D, D, 0, D, (bf16*)(ws + WS_S5IN), D, 0, it, scr, lane);
      for (int it = gw; it < n; it += NGW) tr_seg(a.in[18], D, D, 0, D, (bf16*)(ws + WS_S5OUT), D, 0, it, scr, lane); }
    { const int n = 2 * 8 * tr_seg_items(D, 128);
      for (int it = gw; it < n; it += NGW) { const int per = tr_seg_items(D, 128), j = it / per, which = j & 1, pn = j >> 1;
          tr_seg(a.in[16 + which], D, D, pn * 128, 128, (bf16*)(ws + WS_GLU), D, pn * 256 + which * 128, it % per, scr, lane); } }
    __syncthreads();
}


#define MOE_PHASES(L, PU, PD, PL, LG, LB) \
    if (IN(PU)) { \
        pg8::Gemm g{(const bf16*)(ws + WS_XB), (const bf16*)(ws + WS_WGU) + (size_t)(L) * NEXP * 1024 * D, D, D, D}; \
        pg8::MoeOrder S; S.list = (const int*)(ws + WS_LIST); S.G = F.G; S.c = F.vcu;     _Pragma("unroll") for (int _e = 0; _e < NEXP; ++_e) S.cnt[_e] = __builtin_amdgcn_readfirstlane((int)__hip_atomic_load((unsigned*)(F.ctl + CW_CNT + 1024 * (L)) + 64 * _e, RLX_AGENT)); \
        pg8::EpiGated<1> E{(bf16*)(ws + WS_HMID), MOE_F}; \
        RP(PU) pg8::gemm_phase<pg8::EpiGated<1>, pg8::MoeOrder, true>(F.lds + RING_OFF, g, S, E); \
        if ((L) == 0) { int _T = 0; _Pragma("unroll") for (int _e = 0; _e < NEXP; ++_e) _T += (S.cnt[_e] + 255) >> 8; const int _n5 = 4 * _T - 4 * F.G;     \
            const bool _all = _n5 < 0 || _n5 >= F.G; const int _wk = _all ? F.vcu * NWAVES + F.wave : (F.vcu - _n5) * NWAVES + F.wave, _nw = _all ? F.G * NWAVES : (F.G - _n5) * NWAVES; \
            if (_all || F.vcu >= _n5) { LAS float* _scr = (LAS float*)(F.lds + RING_OFF + F.wave * 16384); moe_convert(args, 0, 1, _wk, _nw, _scr, F.lane); moe_convert(args, 1, 2, _wk, _nw, _scr, F.lane); } } \
        if (BOTH(PU)) GRID_BAR(); } \
    if (IN(PD)) { \
        pg8::Gemm g{(const bf16*)(ws + WS_HMID), (const bf16*)(ws + WS_WD) + (size_t)(L) * NEXP * D * MOE_F, MOE_F, MOE_F, MOE_F}; \
        pg8::MoeOrder S; S.list = (const int*)(ws + WS_LIST); S.G = F.G; S.c = F.vcu;     _Pragma("unroll") for (int _e = 0; _e < NEXP; ++_e) S.cnt[_e] = __builtin_amdgcn_readfirstlane((int)__hip_atomic_load((unsigned*)(F.ctl + CW_CNT + 1024 * (L)) + 64 * _e, RLX_AGENT)); \
        pg8::EpiMoeDown E{(const float*)(ws + WS_TOKW), (bf16*)(ws + WS_CB)}; \
        RP(PD) pg8::gemm_phase<pg8::EpiMoeDown, pg8::MoeOrder, false>(F.lds + RING_OFF, g, S, E); \
        if (BOTH(PD)) GRID_BAR(); } \
    if (IN(PL)) { \
        if ((L) == 0) ln_phase<1, false, false>(F, (const bf16*)(ws + WS_XB), (const bf16*)(ws + WS_CB), LG, LB, nullptr, (bf16*)(ws + WS_XB), nullptr, nullptr, nullptr, nullptr, nullptr, nullptr, nullptr); \
        else ln_phase<1, false, true>(F, (const bf16*)(ws + WS_XB), (const bf16*)(ws + WS_CB), LG, LB, args.out, nullptr, nullptr, nullptr, nullptr, nullptr, nullptr, nullptr, nullptr); \
        if (BOTH(PL)) GRID_BAR(); }

__global__ void __launch_bounds__(NWAVES * 64, 2) mk_fwd(Args args) {
    extern __shared__ __attribute__((aligned(16))) unsigned char lds[];
    Frame F;
    F.lds = (LAS unsigned char*)lds; F.MISC = (volatile LAS unsigned*)(F.lds + MISC_OFF);
    F.tid = threadIdx.x; F.lane = F.tid & 63; F.wave = __builtin_amdgcn_readfirstlane(F.tid >> 6);
    F.G = gridDim.x; { const int bx = blockIdx.x; F.vcu = (F.G % 8 == 0) ? (bx % 8) * (F.G / 8) + bx / 8 : bx; }
    unsigned char* ws = args.ws;
    F.ctl = (gu32*)(ws + WS_CTL);
    for (int u = F.tid; u < (LDS_BYTES - LDSCTL_OFF) / 4; u += NWAVES * 64) ((LAS unsigned*)(F.lds + LDSCTL_OFF))[u] = 0u;
    __syncthreads();
    XcdBarrier bar = xcd_barrier_post((unsigned*)(F.ctl + CW_BAR) + args.li * XCD_BAR_WORDS, F.MISC + 8);
    const int lo = args.ph_lo, hi = args.ph_hi;
#define IN(k) (lo <= (k) && (k) < hi)
#define BOTH(k) (IN(k) && IN((k) + 1))
#define GRID_BAR() xcd_barrier(bar)
#define RP(k) for (int _rp = 0; _rp < ((PROBE == (k)) ? 2 : 1); ++_rp)
    if (IN(0)) { RP(0) p0_prologue(F, args); if (BOTH(0)) GRID_BAR(); }
    if (IN(1)) {
        pg8::Gemm g{(const bf16*)(ws + WS_XB), (const bf16*)(ws + WS_WIN), D, D, D}; pg8::StaticOrder S; S.init(NTOK, HP, F.G, (int)blockIdx.x);
        pg8::EpiStoreBf16 E{(bf16*)(ws + WS_H), HP};
        RP(1) pg8::gemm_phase<pg8::EpiStoreBf16, pg8::StaticOrder, false>(F.lds + RING_OFF, g, S, E);
        { const int units = (NTOK / 256) * (HP / 256), rem = units % F.G;
          if ((int)blockIdx.x >= rem) moe_convert(args, 0, 0, ((int)blockIdx.x - rem) * NWAVES + F.wave, (F.G - rem) * NWAVES, (LAS float*)(F.lds + RING_OFF + F.wave * 16384), F.lane); }
        if (BOTH(1)) GRID_BAR();
    }


    if (IN(2)) {
        RP(20) for (int k = 0, x = F.vcu; x < 2048; ++k, x += F.G) { const int b = x >> 7, qb = x & 127; dsa1_unit(F, args, b, (k & 1) ? 127 - qb : qb); }
        RP(21) for (int u = F.vcu; u < 1024; u += F.G) gla1_pair(F, args, 2 * u);
        if (BOTH(2)) GRID_BAR(); }
    if (IN(3)) {
        RP(30) gla2_scan(F, args);
        RP(31) for (int v = F.vcu; v < 256; v += F.G) { const int bg = v >> 3, s = v & 7;
#pragma unroll 1
            for (int k = 0; k < 4; ++k) { const int qb = k == 0 ? s : (k == 1 ? 15 - s : (k == 2 ? 16 + s : 31 - s)); dsa2_unit(F, args, bg >> 1, bg & 1, qb); } }
        if (BOTH(3)) GRID_BAR(); }
    if (IN(4)) { RP(4) for (int u = F.vcu; u < 1024; u += F.G) gla3_pair(F, args, 2 * u); if (BOTH(4)) GRID_BAR(); }
    if (IN(5)) {
        pg8::Gemm g{(const bf16*)(ws + WS_O), (const bf16*)(ws + WS_WOUT), D, D, D}; pg8::StaticOrder S; S.init(NTOK, D, F.G, (int)blockIdx.x);
        pg8::EpiPre E{(const bf16*)(ws + WS_XB), (bf16*)(ws + WS_H), D};
        RP(5) pg8::gemm_phase<pg8::EpiPre, pg8::StaticOrder, false>(F.lds + RING_OFF, g, S, E);
        if (BOTH(5)) GRID_BAR();
    }
    if (IN(6)) {
        ln_phase<0, true, false>(F, (const bf16*)(ws + WS_H), nullptr, args.in[19], args.in[20], nullptr, (bf16*)(ws + WS_XB), args.in[23], args.in[24], args.in[25], args.in[26],
                          (unsigned*)(F.ctl + CW_CNT), (int*)(ws + WS_LIST), (float*)(ws + WS_TOKW));
        if (BOTH(6)) GRID_BAR(); }
    MOE_PHASES(0, 7, 8, 9, args.in[21], args.in[22])
    if (IN(10)) {
        pg8::Gemm g{(const bf16*)(ws + WS_XB), (const bf16*)(ws + WS_S5IN), D, D, D}; pg8::StaticOrder S; S.init(NTOK, D, F.G, (int)blockIdx.x);
        pg8::EpiS5U E{(bf16*)(ws + WS_H)};
        RP(10) pg8::gemm_phase<pg8::EpiS5U, pg8::StaticOrder, false>(F.lds + RING_OFF, g, S, E);
        if (BOTH(10)) GRID_BAR();
    }
    if (IN(11)) {
        { pg8::Gemm g{(const bf16*)(ws + WS_H), (const bf16*)(ws + WS_PG), 384, 256, 256}; pg8::S5Order S{F.G, F.vcu};
          pg8::EpiS5Z E{(float*)(ws + WS_H + 96 * MiB)};
          pg8::gemm_phase<pg8::EpiS5Z, pg8::S5Order, false>(F.lds + RING_OFF, g, S, E); }
        VM_WAIT(); __syncthreads();
        s5_scan_local(F, args);
        VM_WAIT(); __syncthreads();
        { pg8::Gemm g{(const bf16*)(ws + WS_H), (const bf16*)(ws + WS_MQ), 384, 384, 384}; pg8::S5Order S{F.G, F.vcu};
          pg8::EpiS5Y E{(bf16*)(ws + WS_O)};
          pg8::gemm_phase<pg8::EpiS5Y, pg8::S5Order, false>(F.lds + RING_OFF, g, S, E); }
        if (IN(14)) GRID_BAR();
    }
    if (IN(14)) {
        pg8::Gemm g{(const bf16*)(ws + WS_O), (const bf16*)(ws + WS_GLU), D, D, D}; pg8::StaticOrder S; S.init(NTOK, 2 * D, F.G, (int)blockIdx.x);
        pg8::EpiGated<0> E{(bf16*)(ws + WS_F1), D};
        RP(14) pg8::gemm_phase<pg8::EpiGated<0>, pg8::StaticOrder, false>(F.lds + RING_OFF, g, S, E);
        if (BOTH(14)) GRID_BAR();
    }
    if (IN(15)) {
        pg8::Gemm g{(const bf16*)(ws + WS_F1), (const bf16*)(ws + WS_S5OUT), D, D, D}; pg8::StaticOrder S; S.init(NTOK, D, F.G, (int)blockIdx.x);
        pg8::EpiPre E{(const bf16*)(ws + WS_XB), (bf16*)(ws + WS_H), D};
        pg8::gemm_phase<pg8::EpiPre, pg8::StaticOrder, false>(F.lds + RING_OFF, g, S, E);
        if (BOTH(15)) GRID_BAR();
    }
    if (IN(16)) {
        ln_phase<0, true, false>(F, (const bf16*)(ws + WS_H), nullptr, args.in[19] + D, args.in[20] + D, nullptr, (bf16*)(ws + WS_XB), args.in[23] + D * 4, args.in[24] + 4, args.in[25] + 4 * D * 4, args.in[26] + 16,
                          (unsigned*)(F.ctl + CW_CNT + 1024), (int*)(ws + WS_LIST), (float*)(ws + WS_TOKW));
        if (BOTH(16)) GRID_BAR(); }
    MOE_PHASES(1, 17, 18, 19, args.in[21] + D, args.in[22] + D)
#undef IN
#undef BOTH
}
static int g_grid = 0;
extern "C" void kernel_launch(void* const* d_in, const int* in_sizes, int n_in, void* d_out, int out_size, void* d_ws, size_t ws_size, hipStream_t stream) {
    if (g_grid == 0) {
        if (n_in != 30 || out_size != NTOK * D || ws_size < WS_END) { fprintf(stderr, "kernel_launch: unexpected problem (n_in %d out %d ws %zu)\n", n_in, out_size, ws_size); g_grid = -1; return; }
        int dev = 0, cus = 0, per_cu = 0;
        if (hipGetDevice(&dev) != hipSuccess || hipDeviceGetAttribute(&cus, hipDeviceAttributeMultiprocessorCount, dev) != hipSuccess) { g_grid = -1; return; }
        if (hipFuncSetAttribute((const void*)mk_fwd, hipFuncAttributeMaxDynamicSharedMemorySize, LDS_BYTES) != hipSuccess) { fprintf(stderr, "kernel_launch: hipFuncSetAttribute failed\n"); g_grid = -1; return; }
        if (hipOccupancyMaxActiveBlocksPerMultiprocessor(&per_cu, (const void*)mk_fwd, NWAVES * 64, LDS_BYTES) != hipSuccess || per_cu < 1) fprintf(stderr, "kernel_launch: occupancy query says %d\n", per_cu);
        (void)hipGetLastError();
        if (cus < 256) { fprintf(stderr, "kernel_launch: built for a 256-CU MI355X (one workgroup per CU); found %d CUs\n", cus); g_grid = -1; return; }
        g_grid = 256;
    }
    if (g_grid < 0) return;
    (void)hipMemsetAsync((char*)d_ws + WS_CTL, 0, CTL_ZERO_BYTES, stream);
    Args a{};
    for (int i = 0; i < 30; ++i) a.in[i] = (const float*)d_in[i];
    a.out = (float*)d_out; a.ws = (unsigned char*)d_ws; a.ph_lo = 0; a.ph_hi = 20; a.li = 0; a.pad = 0;
    hipLaunchKernelGGL(mk_fwd, dim3(g_grid), dim3(NWAVES * 64), LDS_BYTES, stream, a);
}
```

```cpp
#include <hip/hip_runtime.h>
#include <math.h>
#include <stdio.h>
#include <stdint.h>

#define GAS __attribute__((address_space(1)))
#define LAS __attribute__((address_space(3)))
typedef unsigned short bf16;
typedef unsigned v4u __attribute__((ext_vector_type(4)));
typedef unsigned v2u __attribute__((ext_vector_type(2)));
typedef float f32x4 __attribute__((ext_vector_type(4)));
typedef float f32x2 __attribute__((ext_vector_type(2)));
typedef float f32x16 __attribute__((ext_vector_type(16)));
typedef short bf16x8 __attribute__((ext_vector_type(8)));
typedef short bf16x4 __attribute__((ext_vector_type(4)));
typedef GAS unsigned gu32;
#define RLX_AGENT __ATOMIC_RELAXED, __HIP_MEMORY_SCOPE_AGENT
#define LDS_WAIT() asm volatile("s_waitcnt lgkmcnt(0)" ::: "memory")
#define VM_WAIT() asm volatile("s_waitcnt vmcnt(0)" ::: "memory")

constexpr int D = 1024, BATCH = 16, SEQ = 2048, NTOK = BATCH * SEQ;
constexpr int ABP = 2644;
constexpr int HP = 2816;
constexpr int HC_AQ = 0, HC_AK = 512, HC_AV = 640, HC_IQ = 768, HC_IK = 1024, HC_IW = 1088, HC_BG = 1096, HC_BQ = 1280, HC_BK = 1536, HC_BV = 1792, HC_BR = 2304;
constexpr float ALPHA = 1.4142135623730951f;
constexpr float LN_EPS = 1e-5f;
constexpr int NEXP = 16, MOE_F = 512;
constexpr int MAXSLOT = 65536 + NEXP * 256;

__device__ __forceinline__ float bf2f(bf16 v) { return __uint_as_float(((unsigned)v) << 16); }
__device__ __forceinline__ unsigned f2bf(float f) { unsigned u = __float_as_uint(f); return (u + 0x7fffu + ((u >> 16) & 1u)) >> 16; }
__device__ __forceinline__ unsigned pk2(float lo, float hi) { return f2bf(lo) | (f2bf(hi) << 16); }
__device__ __forceinline__ float wsum(float v) {
#define WS_DPP(ctrl, rm, bc) v += __int_as_float(__builtin_amdgcn_update_dpp(0, __float_as_int(v), ctrl, rm, 0xF, bc))
    WS_DPP(0xB1, 0xF, true); WS_DPP(0x4E, 0xF, true); WS_DPP(0x141, 0xF, true); WS_DPP(0x140, 0xF, true); WS_DPP(0x142, 0xA, false); WS_DPP(0x143, 0xC, false);
#undef WS_DPP
    return __int_as_float(__builtin_amdgcn_readlane(__float_as_int(v), 63));
}
__device__ const unsigned char T5B[128] = {0, 1, 2, 3, 4, 5, 6, 7, 8, 9, 10, 11, 12, 13, 14, 15, 16, 16, 16, 17, 17, 18, 18, 18, 19, 19, 19, 20, 20, 20, 20, 21, 21, 21, 21, 22, 22, 22, 22, 22, 23, 23, 23, 23, 23, 23, 24, 24, 24, 24, 24, 24, 25, 25, 25, 25, 25, 25, 25, 26, 26, 26, 26, 26, 26, 26, 26, 27, 27, 27, 27, 27, 27, 27, 27, 27, 27, 28, 28, 28, 28, 28, 28, 28, 28, 28, 28, 29, 29, 29, 29, 29, 29, 29, 29, 29, 29, 29, 29, 30, 30, 30, 30, 30, 30, 30, 30, 30, 30, 30, 30, 30, 30, 31, 31, 31, 31, 31, 31, 31, 31, 31, 31, 31, 31, 31, 31, 31};
namespace pg8 {
#define PG8_LAS __attribute__((address_space(3)))
constexpr int BM = 256, BK = 64, HALF = 128, HTB = HALF * BK * 2  , STAGE_BYTES = 8 * HTB, NXCD = 8, WGM = 8;
__host__ __device__ __forceinline__ int lds_byte(int r, int c) { const int st = (r >> 4) * 2 + (c >> 5), rr = r & 15, cc = c & 31, ob = rr * 64 + cc * 2; return st * 1024 + (ob ^ (((ob >> 9) & 1) << 5)); }
__host__ __device__ __forceinline__ void stage_rc(int b, int& R, int& C) { const int st = b / 1024, sb = b % 1024, swz = sb ^ (((sb >> 9) & 1) << 5); R = (st >> 1) * 16 + swz / 64; C = (st & 1) * 32 + (swz % 64) / 2; }
__host__ __device__ __forceinline__ int perm32(int rho) { const int n = rho >> 4, i = rho & 15; return 8 * (i >> 2) + 4 * n + (i & 3); }

struct Unit { int arow0, brow0, pm, pn, aux, cnt; const int* gather; };
struct Gemm { const bf16* A; const bf16* Bt; int lda, ldb, K; };

struct StaticOrder {
    int nM, nN, nwg, G, c;
    __device__ void init(int M, int N, int G_, int c_) { nM = M / BM; nN = N / BM; nwg = nM * nN; G = G_; c = c_; }
    __device__ bool next(int i, Unit& u) const {
        const long L = (long)i * G + c; if (L >= nwg) return false;
        int wgid = (int)L; { const int q = nwg / NXCD, r = nwg % NXCD, xcd = wgid % NXCD, off = wgid / NXCD; wgid = (xcd < r ? xcd * (q + 1) : r * (q + 1) + (xcd - r) * q) + off; }
        const int nig = WGM * nN, gid = wgid / nig, fm = gid * WGM, gsz = (nM - fm) < WGM ? (nM - fm) : WGM;
        u.pm = fm + ((wgid % nig) % gsz); u.pn = (wgid % nig) / gsz; u.arow0 = u.pm * BM; u.brow0 = u.pn * BM; u.aux = 0; u.cnt = BM; u.gather = nullptr; return true;
    }
};
__device__ __forceinline__ unsigned cvt_pk_bf16(float lo, float hi) { unsigned r; asm volatile("v_cvt_pk_bf16_f32 %0, %1, %2" : "=v"(r) : "v"(lo), "v"(hi)); return r; }

template <class Epi, class Sched, bool GATHER = false>
__device__ __forceinline__ void gemm_phase(PG8_LAS unsigned char* lds, const Gemm g, const Sched& S, const Epi& E) {
    const int tid = threadIdx.x, wid = __builtin_amdgcn_readfirstlane(tid >> 6), lane = tid & 63, wr = wid >> 2, wc = wid & 3, fr = lane & 15, fq = lane >> 4;
    const int K = g.K, nt = K / BK;
    unsigned voffA[2], voffB[2];
#pragma unroll
    for (int i = 0; i < 2; ++i) { int R, C; stage_rc(tid * 16 + i * 8192, R, C); const int Rb = Epi::PERM ? ((R & ~31) + perm32(R & 31)) : R;
        voffA[i] = GATHER ? (unsigned)(C * 2) : (unsigned)(R * g.lda + C) * 2u; voffB[i] = (unsigned)(Rb * g.ldb + C) * 2u; }
    const size_t kstep = (size_t)(BK * 2);
    const size_t hstepA = (size_t)HALF * g.lda * 2, hstepB = (size_t)HALF * g.ldb * 2;
    const unsigned ldsw = (unsigned)wid * 1024u;
    const int aoff = lds_byte(wr * 64 + fr, fq * 8), boff = lds_byte(wc * 32 + fr, fq * 8);
#define PG8_SA(b, h) (((b) * 2 + (h)) * HTB)
#define PG8_SB(b, h) ((4 + (b) * 2 + (h)) * HTB)
#define PG8_STAGE(bufoff, gbase, voff) do { _Pragma("unroll") for (int _i = 0; _i < 2; ++_i) \
        __builtin_amdgcn_global_load_lds((const unsigned*)((const char*)(gbase) + (voff)[_i]), (PG8_LAS unsigned*)(lds + (bufoff) + ldsw + _i * 8192), 16, 0, 0); } while (0)
#define PG8_STAGE_A(bufoff, P, O, h, ko) do { _Pragma("unroll") for (int _i = 0; _i < 2; ++_i) { \
        const char* _p; if constexpr (GATHER) { const unsigned _t = _i ? ((O)[h] >> 16) : ((O)[h] & 0xffffu); _p = (const char*)(P) + (ko) + (size_t)(_t * (unsigned)(g.lda * 2) + voffA[_i]); } \
        else _p = (const char*)(P) + (ko) + (size_t)(h) * hstepA + voffA[_i]; \
        __builtin_amdgcn_global_load_lds((const unsigned*)_p, (PG8_LAS unsigned*)(lds + (bufoff) + ldsw + _i * 8192), 16, 0, 0); } } while (0)
#define PG8_LDA(dst, b, h) do { _Pragma("unroll") for (int m = 0; m < 4; ++m) _Pragma("unroll") for (int k = 0; k < 2; ++k) dst[m][k] = *(const PG8_LAS bf16x8*)(lds + PG8_SA(b, h) + aoff + m * 2048 + k * 1024); } while (0)
#define PG8_LDB(dst, b, h) do { _Pragma("unroll") for (int n = 0; n < 2; ++n) _Pragma("unroll") for (int k = 0; k < 2; ++k) dst[n][k] = *(const PG8_LAS bf16x8*)(lds + PG8_SB(b, h) + boff + n * 2048 + k * 1024); } while (0)
#define PG8_MMA(ai, bj, At, Bt) do { __builtin_amdgcn_s_setprio(1); _Pragma("unroll") for (int m = 0; m < 4; ++m) _Pragma("unroll") for (int n = 0; n < 2; ++n) _Pragma("unroll") for (int k = 0; k < 2; ++k) \
        acc[ai][bj][m][n] = __builtin_amdgcn_mfma_f32_16x16x32_bf16(Bt[n][k], At[m][k], acc[ai][bj][m][n], 0, 0, 0); __builtin_amdgcn_s_setprio(0); } while (0)
#define PG8_WAIT_V(n) asm volatile("s_waitcnt vmcnt(" #n ")" ::: "memory")
#define PG8_WAIT_L(n) asm volatile("s_waitcnt lgkmcnt(" #n ")" ::: "memory")
#define PG8_BAR __builtin_amdgcn_s_barrier()
#define PG8_SCHED __builtin_amdgcn_sched_barrier(0)
    Unit cur, nxt; int ui = 0;
    if (!S.next(0, cur)) return;
    f32x4 acc[2][2][4][2];
#pragma unroll
    for (int a = 0; a < 2; ++a)
#pragma unroll
        for (int b = 0; b < 2; ++b)
#pragma unroll
            for (int m = 0; m < 4; ++m)
#pragma unroll
                for (int n = 0; n < 2; ++n) acc[a][b][m][n] = (f32x4){0.f, 0.f, 0.f, 0.f};
    bf16x8 At[4][2], B0[2][2], B1[2][2];
    unsigned OA[2], ON[2];
    const char* cA; const char* cB;
#define PG8_SETUP(u, P, O) do { \
        if constexpr (GATHER) { P = (const char*)g.A; _Pragma("unroll") for (int _h = 0; _h < 2; ++_h) { unsigned _pk = 0u; _Pragma("unroll") for (int _i = 0; _i < 2; ++_i) { \
            int _R, _C; stage_rc(tid * 16 + _i * 8192, _R, _C); const int _r = _h * HALF + _R; const unsigned _t = (_r < (u).cnt) ? (unsigned)((u).gather[_r] >> 1) : 0u; _pk |= _t << (16 * _i); } O[_h] = _pk; } } \
        else { P = (const char*)g.A + (size_t)(u).arow0 * g.lda * 2; } } while (0)
    PG8_SETUP(cur, cA, OA);
    cB = (const char*)g.Bt + (size_t)cur.brow0 * g.ldb * 2;
    PG8_STAGE(PG8_SB(0, 0), cB, voffB); PG8_STAGE(PG8_SB(0, 1), cB + hstepB, voffB); PG8_STAGE_A(PG8_SA(0, 0), cA, OA, 0, 0); PG8_STAGE_A(PG8_SA(0, 1), cA, OA, 1, 0);
    if (wr == 1) PG8_BAR;
    PG8_WAIT_V(2); PG8_BAR;
    PG8_STAGE(PG8_SB(1, 0), cB + kstep, voffB); PG8_STAGE_A(PG8_SA(1, 0), cA, OA, 0, kstep); PG8_STAGE(PG8_SB(1, 1), cB + hstepB + kstep, voffB);
    PG8_WAIT_V(6); PG8_BAR;
    for (;;) {
        const bool has_next = S.next(ui + 1, nxt);
        const char* nA = cA; const char* nB = cB;
        if constexpr (GATHER) { ON[0] = OA[0]; ON[1] = OA[1]; }
        if (has_next) { PG8_SETUP(nxt, nA, ON); nB = (const char*)g.Bt + (size_t)nxt.brow0 * g.ldb * 2; }
        for (int t = 0; t < nt; t += 2) {
            const bool last = (t == nt - 2);
            const size_t k1 = (size_t)(t + 1) * kstep;
            const char* a2 = last ? nA : cA; const char* b2 = last ? nB : cB + (size_t)(t + 2) * kstep;
            const size_t k2 = last ? 0 : (size_t)(t + 2) * kstep, k3 = k2 + kstep;
            const char* b3 = b2 + kstep;
            unsigned O2[2];
            if constexpr (GATHER) { O2[0] = last ? ON[0] : OA[0]; O2[1] = last ? ON[1] : OA[1]; }
            PG8_LDB(B0, 0, 0); PG8_LDB(B1, 0, 1); PG8_SCHED; PG8_LDA(At, 0, 0); PG8_STAGE_A(PG8_SA(1, 1), cA, OA, 1, k1);
            PG8_WAIT_V(8); PG8_WAIT_L(0); PG8_BAR; PG8_MMA(0, 0, At, B0); PG8_MMA(0, 1, At, B1); PG8_BAR; PG8_SCHED;
            PG8_LDA(At, 0, 1); PG8_STAGE(PG8_SB(0, 0), b2, voffB); PG8_STAGE(PG8_SB(0, 1), b2 + hstepB, voffB); PG8_STAGE_A(PG8_SA(0, 0), a2, O2, 0, k2);
            PG8_WAIT_V(8); PG8_WAIT_L(0); PG8_BAR; PG8_MMA(1, 0, At, B0); PG8_MMA(1, 1, At, B1); PG8_BAR; PG8_SCHED;
            PG8_LDB(B0, 1, 0); PG8_LDB(B1, 1, 1); PG8_SCHED; PG8_LDA(At, 1, 0); PG8_STAGE_A(PG8_SA(0, 1), a2, O2, 1, k2);
            PG8_WAIT_V(8); PG8_WAIT_L(0); PG8_BAR; PG8_MMA(0, 0, At, B0); PG8_MMA(0, 1, At, B1); PG8_BAR; PG8_SCHED;
            PG8_LDA(At, 1, 1); PG8_STAGE(PG8_SB(1, 0), b3, voffB); PG8_STAGE(PG8_SB(1, 1), b3 + hstepB, voffB); PG8_STAGE_A(PG8_SA(1, 0), a2, O2, 0, k3);
            PG8_WAIT_V(8); PG8_WAIT_L(0); PG8_BAR; PG8_MMA(1, 0, At, B0); PG8_MMA(1, 1, At, B1); PG8_BAR; PG8_SCHED;
        }
        if (wr == 0) PG8_BAR;
        E(acc, cur, wr, wc, fr, fq);
        if (!has_next) break;
#pragma unroll
        for (int a = 0; a < 2; ++a)
#pragma unroll
            for (int b = 0; b < 2; ++b)
#pragma unroll
                for (int m = 0; m < 4; ++m)
#pragma unroll
                    for (int n = 0; n < 2; ++n) acc[a][b][m][n] = (f32x4){0.f, 0.f, 0.f, 0.f};
        cur = nxt; cA = nA; cB = nB; ++ui;
        if constexpr (GATHER) { OA[0] = ON[0]; OA[1] = ON[1]; }
        if (wr == 1) PG8_BAR;
    }
    PG8_WAIT_V(0);
    PG8_BAR;
#undef PG8_SA
#undef PG8_SB
#undef PG8_STAGE
#undef PG8_STAGE_A
#undef PG8_LDA
#undef PG8_LDB
#undef PG8_MMA
#undef PG8_WAIT_V
#undef PG8_WAIT_L
#undef PG8_BAR
#undef PG8_SCHED
#undef PG8_SETUP
}

struct EpiStoreBf16 {
    static constexpr bool PERM = true;
    bf16* O; int ldc;
    __device__ __forceinline__ void operator()(const f32x4 (&acc)[2][2][4][2], const Unit& u, int wr, int wc, int fr, int fq) const {
        const int row0 = u.pm * BM + wr * 64 + fr, col0 = u.pn * BM + wc * 32 + 8 * fq;
#pragma unroll
        for (int ai = 0; ai < 2; ++ai)
#pragma unroll
            for (int m = 0; m < 4; ++m) { bf16* rowp = O + (size_t)(row0 + ai * HALF + m * 16) * ldc + col0;
#pragma unroll
                for (int bj = 0; bj < 2; ++bj) { const f32x4 v0 = acc[ai][bj][m][0], v1 = acc[ai][bj][m][1];
                    v4u w; w.x = cvt_pk_bf16(v0[0], v0[1]); w.y = cvt_pk_bf16(v0[2], v0[3]); w.z = cvt_pk_bf16(v1[0], v1[1]); w.w = cvt_pk_bf16(v1[2], v1[3]);
                    *(v4u*)(rowp + bj * HALF) = w; } }
    }
};

struct EpiPre {
    static constexpr bool PERM = true;
    const bf16* base; bf16* out; int ldc;
    __device__ __forceinline__ void operator()(const f32x4 (&acc)[2][2][4][2], const Unit& u, int wr, int wc, int fr, int fq) const {
        const int row0 = u.pm * BM + wr * 64 + fr, col0 = u.pn * BM + wc * 32 + 8 * fq;
#pragma unroll
        for (int ai = 0; ai < 2; ++ai)
#pragma unroll
            for (int m = 0; m < 4; ++m) { const size_t off = (size_t)(row0 + ai * HALF + m * 16) * ldc + col0;
#pragma unroll
                for (int bj = 0; bj < 2; ++bj) { const v4u bs = *(const v4u*)(base + off + bj * HALF); const f32x4 v0 = acc[ai][bj][m][0], v1 = acc[ai][bj][m][1]; v4u w;
                    w.x = cvt_pk_bf16(fmaf(__uint_as_float(bs.x << 16), ALPHA, v0[0]), fmaf(__uint_as_float(bs.x & 0xffff0000u), ALPHA, v0[1]));
                    w.y = cvt_pk_bf16(fmaf(__uint_as_float(bs.y << 16), ALPHA, v0[2]), fmaf(__uint_as_float(bs.y & 0xffff0000u), ALPHA, v0[3]));
                    w.z = cvt_pk_bf16(fmaf(__uint_as_float(bs.z << 16), ALPHA, v1[0]), fmaf(__uint_as_float(bs.z & 0xffff0000u), ALPHA, v1[1]));
                    w.w = cvt_pk_bf16(fmaf(__uint_as_float(bs.w << 16), ALPHA, v1[2]), fmaf(__uint_as_float(bs.w & 0xffff0000u), ALPHA, v1[3]));
                    *(v4u*)(out + off + bj * HALF) = w; } }
    }
};
struct EpiS5U {
    static constexpr bool PERM = true;
    bf16* UA;
    __device__ __forceinline__ void operator()(const f32x4 (&acc)[2][2][4][2], const Unit& u, int wr, int wc, int fr, int fq) const {
#pragma unroll
        for (int ai = 0; ai < 2; ++ai)
#pragma unroll
            for (int m = 0; m < 4; ++m) { const int tok = u.pm * BM + ai * HALF + wr * 64 + m * 16 + fr; const int b = tok >> 11, l = tok & 2047, ch = l >> 4, tl = l & 15;
#pragma unroll
                for (int bj = 0; bj < 2; ++bj) { const int c0 = u.pn * BM + bj * HALF + wc * 32 + 8 * fq; const int g = c0 >> 4, cc = c0 & 15;
                    const f32x4 v0 = acc[ai][bj][m][0], v1 = acc[ai][bj][m][1];
                    v4u w; w.x = cvt_pk_bf16(v0[0], v0[1]); w.y = cvt_pk_bf16(v0[2], v0[3]); w.z = cvt_pk_bf16(v1[0], v1[1]); w.w = cvt_pk_bf16(v1[2], v1[3]);
                    *(v4u*)(UA + ((size_t)(g * 2048 + b * 128 + ch)) * 384 + tl * 16 + cc) = w; } }
    }
};
struct EpiS5Z {
    static constexpr bool PERM = false;
    float* Z;
    __device__ __forceinline__ void operator()(const f32x4 (&acc)[2][2][4][2], const Unit& u, int wr, int wc, int fr, int fq) const {
#pragma unroll
        for (int ai = 0; ai < 2; ++ai)
#pragma unroll
            for (int m = 0; m < 4; ++m) { float* rowp = Z + (size_t)(u.arow0 + ai * HALF + wr * 64 + m * 16 + fr) * 128 + wc * 32 + 4 * fq;
#pragma unroll
                for (int n = 0; n < 2; ++n) *(f32x4*)(rowp + n * 16) = acc[ai][0][m][n]; }
    }
};
__device__ __forceinline__ float gelu_tanh(float y) { const float z = 0.7978845608028654f * (y + 0.044715f * y * y * y); return y / (1.f + __expf(-2.f * z)); }
struct EpiS5Y {
    static constexpr bool PERM = true;
    bf16* G;
    __device__ __forceinline__ void operator()(const f32x4 (&acc)[2][2][4][2], const Unit& u, int wr, int wc, int fr, int fq) const {
        const int g = u.aux;
#pragma unroll
        for (int ai = 0; ai < 2; ++ai)
#pragma unroll
            for (int m = 0; m < 4; ++m) { const int row = u.pm * BM + ai * HALF + wr * 64 + m * 16 + fr; const int b = row >> 7, ch = row & 127;
#pragma unroll
                for (int bj = 0; bj < 2; ++bj) { const int c0 = bj * HALF + wc * 32 + 8 * fq; const int tl = c0 >> 4, cc = c0 & 15;
                    const f32x4 v0 = acc[ai][bj][m][0], v1 = acc[ai][bj][m][1];
                    v4u w; w.x = cvt_pk_bf16(gelu_tanh(v0[0]), gelu_tanh(v0[1])); w.y = cvt_pk_bf16(gelu_tanh(v0[2]), gelu_tanh(v0[3]));
                    w.z = cvt_pk_bf16(gelu_tanh(v1[0]), gelu_tanh(v1[1])); w.w = cvt_pk_bf16(gelu_tanh(v1[2]), gelu_tanh(v1[3]));
                    *(v4u*)(G + ((size_t)(b * 2048 + ch * 16 + tl)) * D + g * 16 + cc) = w; } }
    }
};
template <int ACT> struct EpiGated {
    static constexpr bool PERM = true;
    bf16* O; int ldc;
    __device__ __forceinline__ void operator()(const f32x4 (&acc)[2][2][4][2], const Unit& u, int wr, int wc, int fr, int fq) const {
        const int col0 = u.pn * HALF + wc * 32 + 8 * fq;
#pragma unroll
        for (int ai = 0; ai < 2; ++ai)
#pragma unroll
            for (int m = 0; m < 4; ++m) { const int row = u.pm * BM + ai * HALF + wr * 64 + m * 16 + fr; float r[8];
#pragma unroll
                for (int n = 0; n < 2; ++n)
#pragma unroll
                    for (int j = 0; j < 4; ++j) { const float v = acc[ai][0][m][n][j], gt = acc[ai][1][m][n][j];
                        r[n * 4 + j] = ACT == 0 ? v / (1.f + __expf(-gt)) : v / (1.f + __expf(-v)) * gt; }
                v4u w; w.x = cvt_pk_bf16(r[0], r[1]); w.y = cvt_pk_bf16(r[2], r[3]); w.z = cvt_pk_bf16(r[4], r[5]); w.w = cvt_pk_bf16(r[6], r[7]);
                *(v4u*)(O + (size_t)row * ldc + col0) = w; }
    }
};
struct S5Order {
    int G, c;
    __device__ bool next(int i, Unit& u) const { const int L = i * G + c; if (L >= 512) return false; const int g = L >> 3, rt = L & 7;
        u.arow0 = g * 2048 + rt * BM; u.brow0 = g * BM; u.pm = rt; u.pn = 0; u.aux = g; u.cnt = BM; u.gather = nullptr; return true; }
};

struct MoeOrder {
    int cnt[NEXP]; const int* list; int G, c;
    __device__ bool next(int i, Unit& u) const { const int L = i * G + c, rt = L >> 2, pn = L & 3; int acc = 0, se = -1, loc = 0, sc = 0;
#pragma unroll
        for (int e = 0; e < NEXP; ++e) { const int ce = cnt[e], nt = (ce + 255) >> 8; if (rt >= acc && rt < acc + nt) { se = e; loc = rt - acc; sc = ce; } acc += nt; }
        if (se < 0) return false;
        u.arow0 = rt * BM; u.brow0 = se * 1024 + pn * BM; u.pm = rt; u.pn = pn; u.aux = se; const int rem = sc - loc * BM; u.cnt = rem < BM ? rem : BM; u.gather = list + se * NTOK + loc * BM; return true; }
};
struct EpiMoeDown {
    static constexpr bool PERM = true;
    const float* tokw; bf16* CB;
    __device__ __forceinline__ void operator()(const f32x4 (&acc)[2][2][4][2], const Unit& u, int wr, int wc, int fr, int fq) const {
        const int col0 = u.pn * BM + wc * 32 + 8 * fq;
#pragma unroll
        for (int ai = 0; ai < 2; ++ai)
#pragma unroll
            for (int m = 0; m < 4; ++m) { const int r = ai * HALF + wr * 64 + m * 16 + fr;
                if (r < u.cnt) { const int ent = u.gather[r]; const int tok = ent >> 1, k = ent & 1; const float w = tokw[ent];
                    bf16* rowp = CB + ((size_t)k * NTOK + tok) * D + col0;
#pragma unroll
                    for (int bj = 0; bj < 2; ++bj) { const f32x4 v0 = acc[ai][bj][m][0] * w, v1 = acc[ai][bj][m][1] * w;
                        v4u o; o.x = cvt_pk_bf16(v0[0], v0[1]); o.y = cvt_pk_bf16(v0[2], v0[3]); o.z = cvt_pk_bf16(v1[0], v1[1]); o.w = cvt_pk_bf16(v1[2], v1[3]);
                        *(v4u*)(rowp + bj * HALF) = o; } } }
    }
};
}
#define XB_TMO      128
#define XB_XCNT(j)  (256  + 64 * (j))
#define XB_XSUB(j)  (1280 + 64 * (j))
#define XB_XGEN(j)  (2304 + 64 * (j))
#define XB_TOP      3328
#define XB_TOPGEN   3392
#define XCD_BAR_WORDS 3456
#define XB_SPIN_CAP (1u << 18)
__device__ __forceinline__ unsigned xb_ld(unsigned* p)              { return __hip_atomic_load(p, __ATOMIC_RELAXED, __HIP_MEMORY_SCOPE_AGENT); }
__device__ __forceinline__ unsigned xb_add(unsigned* p, unsigned v) { return __hip_atomic_fetch_add(p, v, __ATOMIC_RELAXED, __HIP_MEMORY_SCOPE_AGENT); }
__device__ __forceinline__ unsigned xb_xcc_id() { return (unsigned)__builtin_amdgcn_s_getreg((3 << 11) | 20) & 0xFu; }
#define XB_SPIN(cond, bar) do { unsigned _sp = 0; while (cond) { __builtin_amdgcn_s_sleep(1); \
    if ((++_sp & 255u) == 0u) { if (xb_ld(&(bar)[XB_TMO])) break; if (_sp > XB_SPIN_CAP) { atomicAdd(&(bar)[XB_TMO], 1u); break; } } } } while (0)
struct XcdBarrier { unsigned* bar; unsigned x; volatile LAS unsigned* st; };
__device__ __forceinline__ XcdBarrier xcd_barrier_post(unsigned* bar, volatile LAS unsigned* st) {
    XcdBarrier b; b.bar = bar; b.x = xb_xcc_id(); b.st = st;
    if (threadIdx.x == 0) (void)xb_add(&bar[XB_XCNT(b.x)], 1u);
    return b;
}
__device__ __forceinline__ void xcd_barrier_complete(unsigned* bar, unsigned x, unsigned& nloc, unsigned& nx) {
    const unsigned G = gridDim.x * gridDim.y * gridDim.z;
    unsigned sum, cnt, mine, sp = 0u;
    for (;;) {
        sum = 0u; cnt = 0u; mine = 0u;
#pragma unroll
        for (unsigned j = 0; j < 16; ++j) { const unsigned c = xb_ld(&bar[XB_XCNT(j)]); sum += c; cnt += (c > 0u) ? 1u : 0u; mine = (j == x) ? c : mine; }
        if (sum == G) break;
        __builtin_amdgcn_s_sleep(1);
        if ((++sp & 255u) == 0u) { if (xb_ld(&bar[XB_TMO])) break; if (sp > XB_SPIN_CAP) { atomicAdd(&bar[XB_TMO], 1u); break; } }
    }
    nloc = mine > 0u ? mine : 1u; nx = cnt > 0u ? cnt : 1u;
}
__device__ __forceinline__ void xcd_barrier(const XcdBarrier& b) {
    asm volatile("s_waitcnt vmcnt(0)" ::: "memory");
    __syncthreads();
    if (threadIdx.x == 0) {
        unsigned* bar = b.bar;
        __builtin_amdgcn_s_waitcnt(0);
        unsigned nloc = b.st[0], nx = b.st[1];
        if (nloc == 0u) { xcd_barrier_complete(bar, b.x, nloc, nx); b.st[0] = nloc; b.st[1] = nx; }
        const unsigned old = xb_add(&bar[XB_XSUB(b.x)], 1u);
        const unsigned gen = old / nloc;
        if (old + 1u == (gen + 1u) * nloc) {
            __builtin_amdgcn_fence(__ATOMIC_RELEASE, "agent");
            asm volatile("s_waitcnt vmcnt(0)" ::: "memory");
            const unsigned og = xb_add(&bar[XB_TOP], 1u);
            const unsigned tg = og / nx;
            if (og + 1u == (tg + 1u) * nx) xb_add(&bar[XB_TOPGEN], 1u);
            else XB_SPIN(xb_ld(&bar[XB_TOPGEN]) == tg, bar);
            __builtin_amdgcn_fence(__ATOMIC_ACQUIRE, "agent");
            xb_add(&bar[XB_XGEN(b.x)], 1u);
            asm volatile("s_waitcnt vmcnt(0)" ::: "memory");
        } else {
            XB_SPIN(xb_ld(&bar[XB_XGEN(b.x)]) == gen, bar);
            __builtin_amdgcn_fence(__ATOMIC_ACQUIRE, "agent");
            asm volatile("s_waitcnt vmcnt(0)" ::: "memory");
        }
    }
    __syncthreads();
}

constexpr int NWAVES = 8;
constexpr size_t MiB = 1u << 20;
constexpr size_t WS_CTL = 0, CTL_ZERO_BYTES = 1 * MiB;
constexpr size_t WS_WIN = 2 * MiB, WS_WOUT = 8 * MiB, WS_S5IN = 10 * MiB, WS_GLU = 12 * MiB, WS_S5OUT = 16 * MiB, WS_PG = 18 * MiB, WS_MQ = 26 * MiB;
constexpr size_t WS_WGU = 40 * MiB, WS_WD = 104 * MiB;
constexpr size_t WS_XB = 136 * MiB, WS_H = 200 * MiB, WS_MASK = 376 * MiB, WS_O = 384 * MiB, WS_F1 = 448 * MiB, WS_END = 512 * MiB;
constexpr int CW_TMO = 0, CW_CODE = 1, CW_CNT = 2048  , CW_BAR = 4096;
constexpr size_t WS_TOKW = 512 * 1024  , WS_LIST = 38 * MiB  ;
constexpr size_t WS_HMID = 200 * MiB  , WS_CB = 268 * MiB  ;
constexpr int RING_OFF = 0, RING_BYTES = 131072, LDS_BYTES = 147456, LDSCTL_OFF = LDS_BYTES - 512, MISC_OFF = LDSCTL_OFF + 320;

struct Frame {
    LAS unsigned char* lds; volatile LAS unsigned* MISC; gu32* ctl;
    int tid, lane, wave, vcu, G;
};
struct Args { const float* in[30]; float* out; unsigned char* ws; int ph_lo, ph_hi, li, pad; };

__device__ __forceinline__ void tr_item(const float* __restrict__ W, int ldw, bf16* WT, int ldt, int k0, int c0, int nc, int r0, LAS float* scr, int lane) {
    f32x4 v[8];
#pragma unroll
    for (int i = 0; i < 8; ++i) { const int idx = lane + 64 * i, kk = idx >> 3, c4 = (idx & 7) * 4; v[i] = (c4 < nc) ? *(const GAS f32x4*)(W + (size_t)(k0 + kk) * ldw + c0 + c4) : (f32x4){0.f, 0.f, 0.f, 0.f}; }
#pragma unroll
    for (int i = 0; i < 8; ++i) { const int idx = lane + 64 * i, kk = idx >> 3, c4 = (idx & 7) * 4; LAS float* s = scr + kk * 33 + c4; s[0] = v[i].x; s[1] = v[i].y; s[2] = v[i].z; s[3] = v[i].w; }
    LDS_WAIT(); asm volatile("" ::: "memory");
    const int c = lane & 7;
#pragma unroll
    for (int j = 0; j < 4; ++j) { const int n = (lane >> 3) + 8 * j; const LAS float* s = scr + (8 * c) * 33 + n;
        v4u o; o.x = pk2(s[0 * 33], s[1 * 33]); o.y = pk2(s[2 * 33], s[3 * 33]); o.z = pk2(s[4 * 33], s[5 * 33]); o.w = pk2(s[6 * 33], s[7 * 33]);
        if (n < nc) *(GAS v4u*)(WT + (size_t)(r0 + n) * ldt + k0 + 8 * c) = o; }
    LDS_WAIT(); asm volatile("" ::: "memory");
}

struct TrDesc { const float* W; int ldw; bf16* WT; int ldt, k0, c0, nc, r0; };
__device__ __forceinline__ void tr_load(const TrDesc& d, f32x4 (&v)[8], int lane) {
#pragma unroll
    for (int i = 0; i < 8; ++i) { const int idx = lane + 64 * i, kk = idx >> 3, c4 = (idx & 7) * 4; v[i] = (c4 < d.nc) ? __builtin_nontemporal_load((const GAS f32x4*)(d.W + (size_t)(d.k0 + kk) * d.ldw + d.c0 + c4)) : (f32x4){0.f, 0.f, 0.f, 0.f}; }
}
__device__ __forceinline__ void tr_store(const TrDesc& d, const f32x4 (&v)[8], LAS float* scr, int lane) {
#pragma unroll
    for (int i = 0; i < 8; ++i) { const int idx = lane + 64 * i, kk = idx >> 3, c4 = (idx & 7) * 4; LAS float* s = scr + kk * 33 + c4; s[0] = v[i].x; s[1] = v[i].y; s[2] = v[i].z; s[3] = v[i].w; }
    LDS_WAIT(); asm volatile("" ::: "memory");
    const int c = lane & 7;
#pragma unroll
    for (int j = 0; j < 4; ++j) { const int n = (lane >> 3) + 8 * j; const LAS float* s = scr + (8 * c) * 33 + n;
        v4u o; o.x = pk2(s[0 * 33], s[1 * 33]); o.y = pk2(s[2 * 33], s[3 * 33]); o.z = pk2(s[4 * 33], s[5 * 33]); o.w = pk2(s[6 * 33], s[7 * 33]);
        if (n < d.nc) *(GAS v4u*)(d.WT + (size_t)(d.r0 + n) * d.ldt + d.k0 + 8 * c) = o; }
    LDS_WAIT(); asm volatile("" ::: "memory");
}
__device__ __forceinline__ int tr_seg_items(int K, int ncols) { return (K / 64) * ((ncols + 31) / 32); }
__device__ __forceinline__ void tr_seg(const float* W, int ldw, int K, int c0, int ncols, bf16* WT, int ldt, int r0, int it, LAS float* scr, int lane) {
    const int nblk = (ncols + 31) / 32, kb = it / nblk, nb = it % nblk; const int rem = ncols - nb * 32;
    tr_item(W, ldw, WT, ldt, kb * 64, c0 + nb * 32, rem < 32 ? rem : 32, r0 + nb * 32, scr, lane);
}
constexpr size_t WS_UPD = WS_F1, WS_DEC = WS_LIST;
constexpr size_t OUT_SPREV = 16 * MiB, OUT_OI = 48 * MiB;
constexpr int GP = 72;
#define MFMA32(a, b, c) __builtin_amdgcn_mfma_f32_32x32x16_bf16((a), (b), (c), 0, 0, 0)
__device__ __forceinline__ int crow(int reg, int h) { return (reg & 3) + 8 * (reg >> 2) + 4 * h; }
__device__ __forceinline__ f32x16 mma_tile64(const LAS bf16* A, const LAS bf16* Bt, int lane) {
    const int r = lane & 31, h = lane >> 5; f32x16 acc;
#pragma unroll
    for (int i = 0; i < 16; ++i) acc[i] = 0.f;
#pragma unroll
    for (int kk = 0; kk < 4; ++kk) { const bf16x8 a = *(const LAS bf16x8*)(A + r * GP + kk * 16 + 8 * h), b = *(const LAS bf16x8*)(Bt + r * GP + kk * 16 + 8 * h); acc = MFMA32(a, b, acc); }
    return acc;
}
constexpr int GLA1_HALF = 71168;
__device__ __forceinline__ void gla1_pair(Frame& F, const Args& a, int unit0) {
    const int hw = F.wave >> 2, wl = F.wave & 3, lt = F.tid & 255, lane = F.lane, unit = unit0 + hw;
    const int b = unit >> 7, n = (unit >> 2) & 31, h = unit & 3;
    const size_t tok0 = (size_t)b * SEQ + n * 64;
    const bf16* H = (const bf16*)(a.ws + WS_H);
    LAS unsigned char* L = F.lds + RING_OFF + hw * GLA1_HALF;
    LAS float* CUM = (LAS float*)L;
    LAS bf16* P = (LAS bf16*)L;
    LAS bf16* QD = (LAS bf16*)(L + 16640);
    LAS bf16* KI = (LAS bf16*)(L + 25856);
    LAS bf16* KET = (LAS bf16*)(L + 35072);
    LAS bf16* VT = (LAS bf16*)(L + 44288);
    LAS float* GW = (LAS float*)(L + 62720);
    LAS float* GB = (LAS float*)(L + 66816);
    LAS float* BG = (LAS float*)(L + 67072);
    const float* gw2 = a.in[3]; const float* gb = a.in[4];
#pragma unroll
    for (int k = 0; k < 4; ++k) { const int i = lt + 256 * k; GW[i] = gw2[(i >> 6) * 256 + h * 64 + (i & 63)]; BG[i] = bf2f(H[(tok0 + (i >> 4)) * HP + HC_BG + (i & 15)]); }
    if (lt < 64) GB[lt] = gb[h * 64 + lt];
    v4u qv[2], kv[2], vv[4];
#pragma unroll
    for (int k = 0; k < 2; ++k) { const int idx = lt + 256 * k, t = idx >> 3, d8 = (idx & 7) * 8; qv[k] = *(const GAS v4u*)(H + (tok0 + t) * HP + HC_BQ + h * 64 + d8); kv[k] = *(const GAS v4u*)(H + (tok0 + t) * HP + HC_BK + h * 64 + d8); }
#pragma unroll
    for (int k = 0; k < 4; ++k) { const int idx = lt + 256 * k, j = idx & 63, e8 = (idx >> 6) * 8; vv[k] = *(const GAS v4u*)(H + (tok0 + j) * HP + HC_BV + h * 128 + e8); }
    __syncthreads();
#pragma unroll 4
    for (int k = 0; k < 16; ++k) { const int idx = lt + 256 * k, t = idx >> 6, d = idx & 63; float z = GB[d];
#pragma unroll
        for (int r = 0; r < 16; ++r) z = fmaf(BG[t * 16 + r], GW[r * 64 + d], z);
        const float ls = -(fmaxf(-z, 0.f) + log1pf(__expf(-fabsf(z)))); CUM[t * 65 + d] = ls * (1.f / 16.f); }
    __syncthreads();
#pragma unroll 4
    for (int dd = 0; dd < 16; ++dd) { const int d = wl * 16 + dd; float v = CUM[lane * 65 + d];
#pragma unroll
        for (int o = 1; o < 64; o <<= 1) { const float t = __shfl_up(v, o); if (lane >= o) v += t; }
        CUM[lane * 65 + d] = v; }
    __syncthreads();
    bf16* QG = (bf16*)a.out;
#pragma unroll
    for (int k = 0; k < 2; ++k) { const int idx = lt + 256 * k, t = idx >> 3, d8 = (idx & 7) * 8; unsigned qo[4], ko[4]; const unsigned qw[4] = {qv[k].x, qv[k].y, qv[k].z, qv[k].w}, kw[4] = {kv[k].x, kv[k].y, kv[k].z, kv[k].w};
#pragma unroll
        for (int p2 = 0; p2 < 4; ++p2) { float qd[2], ki[2];
#pragma unroll
            for (int s = 0; s < 2; ++s) { const int d = d8 + 2 * p2 + s; const float c = CUM[t * 65 + d], last = CUM[63 * 65 + d];
                const float q = (s ? __uint_as_float(qw[p2] & 0xffff0000u) : __uint_as_float(qw[p2] << 16)) * 0.125f, kk = s ? __uint_as_float(kw[p2] & 0xffff0000u) : __uint_as_float(kw[p2] << 16);
                qd[s] = q * __expf(c); ki[s] = kk * __expf(-c); KET[d * GP + t] = (bf16)f2bf(kk * __expf(last - c)); }
            qo[p2] = pk2(qd[0], qd[1]); ko[p2] = pk2(ki[0], ki[1]); }
        const v4u qq = (v4u){qo[0], qo[1], qo[2], qo[3]}; *(LAS v4u*)(QD + t * GP + d8) = qq; *(GAS v4u*)(QG + (tok0 + t) * 256 + h * 64 + d8) = qq; *(LAS v4u*)(KI + t * GP + d8) = (v4u){ko[0], ko[1], ko[2], ko[3]}; }
    if (lt < 64) ((float*)(a.ws + WS_DEC))[unit * 64 + lt] = __expf(CUM[63 * 65 + lt]);
#pragma unroll
    for (int k = 0; k < 4; ++k) { const int idx = lt + 256 * k, j = idx & 63, e8 = (idx >> 6) * 8; const v4u v = vv[k];
        VT[(e8 + 0) * GP + j] = (bf16)(v.x & 0xffff); VT[(e8 + 1) * GP + j] = (bf16)(v.x >> 16); VT[(e8 + 2) * GP + j] = (bf16)(v.y & 0xffff); VT[(e8 + 3) * GP + j] = (bf16)(v.y >> 16);
        VT[(e8 + 4) * GP + j] = (bf16)(v.z & 0xffff); VT[(e8 + 5) * GP + j] = (bf16)(v.z >> 16); VT[(e8 + 6) * GP + j] = (bf16)(v.w & 0xffff); VT[(e8 + 7) * GP + j] = (bf16)(v.w >> 16); }
    __syncthreads();
    { const int ti = wl >> 1, tj = wl & 1, nn = lane & 31, hh = lane >> 5;
        if (tj <= ti) { const f32x16 c = mma_tile64(QD + 32 * ti * GP, KI + 32 * tj * GP, lane);
#pragma unroll
            for (int i = 0; i < 16; ++i) { const int qi = 32 * ti + crow(i, hh), kj = 32 * tj + nn; P[qi * GP + kj] = (bf16)f2bf(kj <= qi ? c[i] : 0.f); } }
        else {
#pragma unroll
            for (int i = 0; i < 16; ++i) P[(32 * ti + crow(i, hh)) * GP + 32 * tj + nn] = (bf16)0; } }
    __syncthreads();
    bf16* oi = (bf16*)((unsigned char*)a.out + OUT_OI); float* up = (float*)(a.ws + WS_UPD) + (size_t)unit * 8192;
#pragma unroll
    for (int k = 0; k < 2; ++k) { const int tile = wl * 2 + k, nn = lane & 31, hh = lane >> 5;
      { const int ti = tile >> 2, te = tile & 3;
        const f32x16 c = mma_tile64(P + 32 * ti * GP, VT + 32 * te * GP, lane);
#pragma unroll
        for (int i = 0; i < 16; ++i) oi[(tok0 + 32 * ti + crow(i, hh)) * 512 + h * 128 + 32 * te + nn] = (bf16)f2bf(c[i]); }
      { const int te = tile >> 1, td = tile & 1;
        const f32x16 c = mma_tile64(VT + 32 * te * GP, KET + 32 * td * GP, lane);
#pragma unroll
        for (int i = 0; i < 16; ++i) up[(32 * te + crow(i, hh)) * 64 + 32 * td + nn] = c[i]; } }
    __syncthreads();
}
__device__ __forceinline__ void gla2_scan(Frame& F, const Args& a) {
    const float* UPD = (const float*)(a.ws + WS_UPD); const float* DEC = (const float*)(a.ws + WS_DEC); bf16* SP = (bf16*)((unsigned char*)a.out + OUT_SPREV);
    for (int x = F.vcu * (NWAVES * 64) + F.tid; x < BATCH * 4 * 128 * 16; x += F.G * NWAVES * 64) {
        const int d4 = (x & 15) * 4, e = (x >> 4) & 127, bh = x >> 11, b = bh >> 2, h = bh & 3; f32x4 S = (f32x4){0.f, 0.f, 0.f, 0.f};
        for (int n0 = 0; n0 < 32; n0 += 8) { f32x4 u[8], dc[8];
#pragma unroll
            for (int k = 0; k < 8; ++k) { const int unit = b * 128 + (n0 + k) * 4 + h; u[k] = *(const GAS f32x4*)(UPD + (size_t)unit * 8192 + e * 64 + d4); dc[k] = *(const GAS f32x4*)(DEC + unit * 64 + d4); }
#pragma unroll
            for (int k = 0; k < 8; ++k) { const int unit = b * 128 + (n0 + k) * 4 + h; v2u o; o.x = pk2(S.x, S.y); o.y = pk2(S.z, S.w); *(GAS v2u*)(SP + (size_t)unit * 8192 + e * 64 + d4) = o; S = dc[k] * S + u[k]; } } }
}
constexpr int GLA3_HALF = 61440;
__device__ __forceinline__ void gla3_pair(Frame& F, const Args& a, int unit0) {
    const int hw = F.wave >> 2, wl = F.wave & 3, lt = F.tid & 255, lane = F.lane, unit = unit0 + hw;
    const int b = unit >> 7, n = (unit >> 2) & 31, h = unit & 3;
    const size_t tok0 = (size_t)b * SEQ + n * 64;
    const bf16* H = (const bf16*)(a.ws + WS_H); const bf16* SP = (const bf16*)((const unsigned char*)a.out + OUT_SPREV) + (size_t)unit * 8192; const bf16* oi = (const bf16*)((const unsigned char*)a.out + OUT_OI);
    LAS unsigned char* L = F.lds + RING_OFF + hw * GLA3_HALF;
    LAS bf16* QD = (LAS bf16*)L;
    LAS bf16* ST = (LAS bf16*)(L + 9216);
    LAS float* OF = (LAS float*)(L + 27648);
    const int nn = lane & 31, hh = lane >> 5;
    v4u qreg[2], sreg[4]; bf16 oiv[2][16]; unsigned short brv[16][2];
#pragma unroll
    for (int k = 0; k < 2; ++k) { const int idx = lt + 256 * k, t = idx >> 3, d8 = (idx & 7) * 8; qreg[k] = *(const GAS v4u*)((const bf16*)a.out + (tok0 + t) * 256 + h * 64 + d8); }
#pragma unroll
    for (int k = 0; k < 4; ++k) { const int idx = lt + 256 * k, e = idx >> 3, d8 = (idx & 7) * 8; sreg[k] = *(const GAS v4u*)(SP + e * 64 + d8); }
#pragma unroll
    for (int k = 0; k < 2; ++k) { const int tile = wl * 2 + k, ti = tile >> 2, te = tile & 3;
#pragma unroll
        for (int i = 0; i < 16; ++i) oiv[k][i] = oi[(tok0 + 32 * ti + crow(i, hh)) * 512 + h * 128 + 32 * te + nn]; }
#pragma unroll
    for (int rr = 0; rr < 16; ++rr) { const bf16* br = H + (tok0 + wl * 16 + rr) * HP + HC_BR + h * 128; brv[rr][0] = br[lane]; brv[rr][1] = br[lane + 64]; }
    const float* ng = a.in[5]; const float ng0 = ng[h * 128 + lane], ng1 = ng[h * 128 + lane + 64];
#pragma unroll
    for (int k = 0; k < 2; ++k) { const int idx = lt + 256 * k, t = idx >> 3, d8 = (idx & 7) * 8; *(LAS v4u*)(QD + t * GP + d8) = qreg[k]; }
#pragma unroll
    for (int k = 0; k < 4; ++k) { const int idx = lt + 256 * k, e = idx >> 3, d8 = (idx & 7) * 8; *(LAS v4u*)(ST + e * GP + d8) = sreg[k]; }
    __syncthreads();
#pragma unroll
    for (int k = 0; k < 2; ++k) { const int tile = wl * 2 + k, ti = tile >> 2, te = tile & 3;
      const f32x16 c = mma_tile64(QD + 32 * ti * GP, ST + 32 * te * GP, lane);
#pragma unroll
      for (int i = 0; i < 16; ++i) { const int r = 32 * ti + crow(i, hh), e = 32 * te + nn; OF[r * 132 + e] = c[i] + bf2f(oiv[k][i]); } }
    __syncthreads();
    bf16* O = (bf16*)(a.ws + WS_O);
#pragma unroll
    for (int rr = 0; rr < 16; ++rr) { const int r = wl * 16 + rr; const float x0 = OF[r * 132 + lane], x1 = OF[r * 132 + lane + 64];
        const float mean = wsum(x0 + x1) * (1.f / 128.f), d0 = x0 - mean, d1 = x1 - mean, var = wsum(d0 * d0 + d1 * d1) * (1.f / 128.f), rs = 1.f / sqrtf(var + LN_EPS);
        const float r0 = bf2f(brv[rr][0]), r1 = bf2f(brv[rr][1]);
        bf16* o = O + (tok0 + r) * D + 512 + h * 128;
        o[lane] = (bf16)f2bf(d0 * rs * ng0 * (r0 / (1.f + __expf(-r0)))); o[lane + 64] = (bf16)f2bf(d1 * rs * ng1 * (r1 / (1.f + __expf(-r1)))); }
    __syncthreads();
}
constexpr int SCP = 2048 + 16;
__device__ __forceinline__ unsigned fkey(float f) { const unsigned u = __float_as_uint(f); return (u & 0x80000000u) ? ~u : (u | 0x80000000u); }
__device__ __forceinline__ int wave_sum_dpp(int x) {
    x += __builtin_amdgcn_update_dpp(0, x, 0xB1, 0xF, 0xF, true);
    x += __builtin_amdgcn_update_dpp(0, x, 0x4E, 0xF, 0xF, true);
    x += __builtin_amdgcn_update_dpp(0, x, 0x141, 0xF, 0xF, true);
    x += __builtin_amdgcn_update_dpp(0, x, 0x140, 0xF, 0xF, true);
    x += __builtin_amdgcn_update_dpp(0, x, 0x142, 0xA, 0xF, false);
    x += __builtin_amdgcn_update_dpp(0, x, 0x143, 0xC, 0xF, false);
    return __builtin_amdgcn_readlane(x, 63);
}
#define CNT_GE(acc, k, c) asm volatile("v_cmp_ge_u32 vcc, %1, %2\n\tv_addc_co_u32 %0, vcc, 0, %0, vcc" : "+v"(acc) : "v"(k), "v"(c) : "vcc")
#define CNT_GT(acc, k, c) asm volatile("v_cmp_gt_u32 vcc, %1, %2\n\tv_addc_co_u32 %0, vcc, 0, %0, vcc" : "+v"(acc) : "v"(k), "v"(c) : "vcc")
template <int NCH> __device__ __forceinline__ unsigned topk_search(const unsigned (&key)[32], bool& exact) {
    unsigned K = 0u; exact = false;
#pragma unroll 1
    for (int bit = 31; bit >= 0; --bit) { const unsigned cand = K | (1u << bit); int acc = 0;
#pragma unroll
        for (int j = 0; j < NCH * 4; ++j) CNT_GE(acc, key[j], cand);
        const int cnt = wave_sum_dpp(acc);
        if (cnt >= 256) { K = cand; if (cnt == 256) { exact = true; break; } } }
    return K;
}
template <int NCH> __device__ __forceinline__ int count_gt(const unsigned (&key)[32], unsigned K) { int acc = 0;
#pragma unroll
    for (int j = 0; j < NCH * 4; ++j) CNT_GT(acc, key[j], K);
    return wave_sum_dpp(acc); }
struct Dsa1Ops { bf16x8 af[4][2]; float wq[4][4]; };
__device__ __forceinline__ void dsa1_load(Frame& F, const Args& a, int b, int qt, Dsa1Ops& o) {
    const int lane = F.lane, fr = lane & 15, fq = lane >> 4, t0 = qt * 16;
    const bf16* H = (const bf16*)(a.ws + WS_H) + (size_t)b * SEQ * HP;
#pragma unroll
    for (int qg = 0; qg < 4; ++qg) {
#pragma unroll
        for (int kk = 0; kk < 2; ++kk) o.af[qg][kk] = *(const GAS bf16x8*)(H + (size_t)(t0 + qg * 4 + (fr >> 2)) * HP + HC_IQ + (fr & 3) * 64 + kk * 32 + fq * 8);
        const v2u wv = *(const GAS v2u*)(H + (size_t)(t0 + qg * 4 + fq) * HP + HC_IW);
        o.wq[qg][0] = __uint_as_float(wv.x << 16); o.wq[qg][1] = __uint_as_float(wv.x & 0xffff0000u); o.wq[qg][2] = __uint_as_float(wv.y << 16); o.wq[qg][3] = __uint_as_float(wv.y & 0xffff0000u); }
}
__device__ __forceinline__ void dsa1_unit(Frame& F, const Args& a, int b, int qt, Dsa1Ops& cur, int nb, int nqt) {
    const int lane = F.lane, w = F.wave, fr = lane & 15, fq = lane >> 4, t0 = qt * 16;
    const bf16* H = (const bf16*)(a.ws + WS_H) + (size_t)b * SEQ * HP;
    LAS float* SC = (LAS float*)(F.lds + RING_OFF);
    const int nkb = qt + 1, nmine = (nkb - w + 7) >> 3;
#ifndef PROBE
#define PROBE -1
#endif
    for (int _rp = 0; _rp < (PROBE == 22 ? 2 : 1); ++_rp)
#pragma unroll 1
    for (int i0 = 0; i0 < nmine; i0 += 8) {
        bf16x8 bfr[8][2];
#pragma unroll
        for (int u = 0; u < 8; ++u) if (i0 + u < nmine) { const int kb = w + 8 * (i0 + u);
#pragma unroll
            for (int kk = 0; kk < 2; ++kk) bfr[u][kk] = *(const GAS bf16x8*)(H + (size_t)(kb * 16 + fr) * HP + HC_IK + kk * 32 + fq * 8); }
#pragma unroll
        for (int u = 0; u < 8; ++u) if (i0 + u < nmine) { const int kb = w + 8 * (i0 + u);
#pragma unroll
            for (int qg = 0; qg < 4; ++qg) { f32x4 c = (f32x4){0.f, 0.f, 0.f, 0.f};
                c = __builtin_amdgcn_mfma_f32_16x16x32_bf16(cur.af[qg][0], bfr[u][0], c, 0, 0, 0); c = __builtin_amdgcn_mfma_f32_16x16x32_bf16(cur.af[qg][1], bfr[u][1], c, 0, 0, 0);
                float sc = 0.f;
#pragma unroll
                for (int i = 0; i < 4; ++i) sc += cur.wq[qg][i] * fmaxf(c[i], 0.f);
                SC[(qg * 4 + fq) * SCP + kb * 16 + fr] = sc; } } }
    __syncthreads();
    if (nb >= 0) dsa1_load(F, a, nb, nqt, cur);
    unsigned long long* MASK = (unsigned long long*)(a.ws + WS_MASK);
    for (int _rp = 0; _rp < (PROBE == 23 ? 2 : 1); ++_rp)
#pragma unroll 1
    for (int rr = 0; rr < 2; ++rr) { const int r = w + 8 * rr, t = t0 + r, jmax = t >> 6, nch = (jmax >> 2) + 1;
        unsigned key[32];
#pragma unroll
        for (int c = 0; c < 8; ++c) {
            if (c < nch) {
#pragma unroll
                for (int jj = 0; jj < 4; ++jj) { const int j = c * 4 + jj, s = j * 64 + lane; const float f = SC[r * SCP + s]; key[j] = (s <= t) ? fkey(f) : 0u; } }
            else {
#pragma unroll
                for (int jj = 0; jj < 4; ++jj) key[c * 4 + jj] = 0u; } }
        unsigned long long mine = 0ull;
        if (t < 256) {
#pragma unroll
            for (int j = 0; j < 4; ++j) { const unsigned long long bm = __ballot(j * 64 + lane <= t); if (lane == j) mine = bm; }
        } else {
            unsigned K; bool exact; int cgt = 0;
            switch (nch) {
                case 1: K = topk_search<1>(key, exact); if (!exact) cgt = count_gt<1>(key, K); break;
                case 2: K = topk_search<2>(key, exact); if (!exact) cgt = count_gt<2>(key, K); break;
                case 3: K = topk_search<3>(key, exact); if (!exact) cgt = count_gt<3>(key, K); break;
                case 4: K = topk_search<4>(key, exact); if (!exact) cgt = count_gt<4>(key, K); break;
                case 5: K = topk_search<5>(key, exact); if (!exact) cgt = count_gt<5>(key, K); break;
                case 6: K = topk_search<6>(key, exact); if (!exact) cgt = count_gt<6>(key, K); break;
                case 7: K = topk_search<7>(key, exact); if (!exact) cgt = count_gt<7>(key, K); break;
                default: K = topk_search<8>(key, exact); if (!exact) cgt = count_gt<8>(key, K); break;
            }
            const int quota = 256 - cgt; int taken = 0;
#pragma unroll
            for (int j = 0; j < 32; ++j) {
                unsigned long long bm;
                if (exact) bm = __ballot(key[j] >= K);
                else { const unsigned long long eq = __ballot(key[j] == K); const int pre = __builtin_amdgcn_mbcnt_hi((unsigned)(eq >> 32), __builtin_amdgcn_mbcnt_lo((unsigned)eq, 0u));
                       bm = __ballot(key[j] > K || (key[j] == K && taken + pre < quota)); taken += __builtin_popcountll(eq); }
                if (lane == j) mine = bm; }
        }
        if (lane < 32) MASK[((size_t)b * SEQ + t) * 32 + lane] = mine; }
    __syncthreads();
}

constexpr float LOG2E = 1.4426950408889634f, SCL2 = 0.125f * 1.4426950408889634f;
__device__ __forceinline__ bf16x8 pack_step(const f32x16& x, int s) {
    v4u p;
    asm volatile("v_cvt_pk_bf16_f32 %0, %4, %5\n\tv_cvt_pk_bf16_f32 %1, %6, %7\n\tv_cvt_pk_bf16_f32 %2, %8, %9\n\tv_cvt_pk_bf16_f32 %3, %10, %11\n\ts_nop 1"
                 : "=&v"(p[0]), "=&v"(p[1]), "=&v"(p[2]), "=&v"(p[3])
                 : "v"(x[8 * s]), "v"(x[8 * s + 1]), "v"(x[8 * s + 2]), "v"(x[8 * s + 3]), "v"(x[8 * s + 4]), "v"(x[8 * s + 5]), "v"(x[8 * s + 6]), "v"(x[8 * s + 7]));
    return __builtin_bit_cast(bf16x8, p);
}
__device__ __forceinline__ void dsa2_unit(Frame& F, const Args& a, int b, int g, int qb) {
    const int tid = F.tid, lane = F.lane, w = F.wave, n = lane & 31, h = lane >> 5, hl = w >> 1, hh = g * 4 + hl, t0 = qb * 64, tq0 = t0 + 32 * (w & 1);
    const bf16* H = (const bf16*)(a.ws + WS_H) + (size_t)b * SEQ * HP;
    const unsigned long long* MW = (const unsigned long long*)(a.ws + WS_MASK) + ((size_t)b * SEQ + tq0 + n) * 32;
    LAS unsigned char* L = F.lds + RING_OFF;
    LAS float* BT = (LAS float*)(L + 55296);
    LAS bf16* OS = (LAS bf16*)(L + 57344 + w * 4608);
    const float* relb = a.in[1];
    BT[tid] = relb[T5B[tid & 127] * 8 + g * 4 + (tid >> 7)] * LOG2E;
    const float B31 = relb[31 * 8 + hh] * LOG2E;
    bf16x8 Qf[4];
#pragma unroll
    for (int kk = 0; kk < 4; ++kk) Qf[kk] = *(const GAS bf16x8*)(H + (size_t)(tq0 + n) * HP + HC_AQ + hh * 64 + kk * 16 + 8 * h);
    f32x16 O[2];
#pragma unroll
    for (int i = 0; i < 16; ++i) { O[0][i] = 0.f; O[1][i] = 0.f; }
    float m = -1e30f, lsum = 0.f;
    const int krow = tid >> 3, kc8 = (tid & 7) * 8, vrow = tid & 63, vc8 = (tid >> 6) * 8, nt = qb + 1;
    v4u kreg, vreg;
#define DSA_LOADT(kt) do { kreg = *(const GAS v4u*)(H + (size_t)((kt) * 64 + krow) * HP + HC_AK + g * 64 + kc8); vreg = *(const GAS v4u*)(H + (size_t)((kt) * 64 + vrow) * HP + HC_AV + g * 64 + vc8); } while (0)
#define DSA_WRITET(bu) do { LAS bf16* _ks = (LAS bf16*)(L + (bu) * 18432); LAS bf16* _vt = (LAS bf16*)(L + (bu) * 18432 + 9216); *(LAS v4u*)(_ks + krow * GP + kc8) = kreg; \
        _vt[(vc8 + 0) * GP + vrow] = (bf16)(vreg.x & 0xffff); _vt[(vc8 + 1) * GP + vrow] = (bf16)(vreg.x >> 16); _vt[(vc8 + 2) * GP + vrow] = (bf16)(vreg.y & 0xffff); _vt[(vc8 + 3) * GP + vrow] = (bf16)(vreg.y >> 16); \
        _vt[(vc8 + 4) * GP + vrow] = (bf16)(vreg.z & 0xffff); _vt[(vc8 + 5) * GP + vrow] = (bf16)(vreg.z >> 16); _vt[(vc8 + 6) * GP + vrow] = (bf16)(vreg.w & 0xffff); _vt[(vc8 + 7) * GP + vrow] = (bf16)(vreg.w >> 16); } while (0)
#define DSA_QK(Sd, bu) do { const LAS bf16* _ks = (const LAS bf16*)(L + (bu) * 18432); _Pragma("unroll") for (int sb = 0; sb < 2; ++sb) { _Pragma("unroll") for (int i = 0; i < 16; ++i) Sd[sb][i] = 0.f; \
        _Pragma("unroll") for (int kk = 0; kk < 4; ++kk) { const bf16x8 ka = *(const LAS bf16x8*)(_ks + (32 * sb + n) * GP + kk * 16 + 8 * h); Sd[sb] = MFMA32(ka, Qf[kk], Sd[sb]); } } } while (0)
    DSA_LOADT(0); DSA_WRITET(0);
    if (nt > 1) { DSA_LOADT(1); DSA_WRITET(1); }
    if (nt > 2) DSA_LOADT(2);
    unsigned long long mw = MW[0];
    __syncthreads();
#define DSA_MASK(p, wsh, pos) do { int _t; asm volatile("v_bfe_i32 %1, %2, %3, 1\n\tv_and_b32 %0, %0, %1" : "+v"(p), "=&v"(_t) : "v"(wsh), "n"(pos)); } while (0)
#define DSA_TILE(Sc, Sn, kt) do { \
        const int s1 = slot == 2 ? 0 : slot + 1, s2 = s1 == 2 ? 0 : s1 + 1; \
        if ((kt) + 2 < nt) DSA_WRITET(s2); \
        if ((kt) + 3 < nt) DSA_LOADT((kt) + 3); \
        const unsigned long long mwn = ((kt) + 1 < nt) ? MW[(kt) + 1] : 0ull; \
        if ((kt) + 1 < nt) DSA_QK(Sn, s1); \
        const LAS bf16* VT = (const LAS bf16*)(L + slot * 18432 + 9216); \
        const unsigned wsh0 = (unsigned)mw >> (4 * h), wsh1 = (unsigned)(mw >> 32) >> (4 * h); \
        float mx = -1e30f; \
        if ((kt) < qb - 2) {     \
            _Pragma("unroll") for (int sb = 0; sb < 2; ++sb) _Pragma("unroll") for (int i = 0; i < 16; ++i) { Sc[sb][i] = fmaf(Sc[sb][i], SCL2, B31); mx = fmaxf(mx, Sc[sb][i]); } \
        } else { const int dbase = tq0 + n - (kt) * 64 - 4 * h; \
            _Pragma("unroll") for (int sb = 0; sb < 2; ++sb) _Pragma("unroll") for (int i = 0; i < 16; ++i) { int dist = dbase - (32 * sb + (i & 3) + 8 * (i >> 2)); dist = dist < 0 ? 0 : (dist > 127 ? 127 : dist); \
                Sc[sb][i] = fmaf(Sc[sb][i], SCL2, BT[hl * 128 + dist]); mx = fmaxf(mx, Sc[sb][i]); } } \
        mx = fmaxf(mx, __shfl_xor(mx, 32)); \
        const float mn = fmaxf(m, mx); \
        if (__any(mn > m)) { const float al = __builtin_amdgcn_exp2f(m - mn); _Pragma("unroll") for (int i = 0; i < 16; ++i) { O[0][i] *= al; O[1][i] *= al; } lsum *= al; } \
        m = mn; \
        _Pragma("unroll") for (int i = 0; i < 16; ++i) { float p0 = __builtin_amdgcn_exp2f(Sc[0][i] - m), p1 = __builtin_amdgcn_exp2f(Sc[1][i] - m); \
            DSA_MASK(p0, wsh0, (i & 3) + 8 * (i >> 2)); DSA_MASK(p1, wsh1, (i & 3) + 8 * (i >> 2)); Sc[0][i] = p0; Sc[1][i] = p1; lsum += p0 + p1; } \
        _Pragma("unroll") for (int sb = 0; sb < 2; ++sb) _Pragma("unroll") for (int s = 0; s < 2; ++s) { const bf16x8 pf = pack_step(Sc[sb], s); \
            _Pragma("unroll") for (int db = 0; db < 2; ++db) { const LAS bf16* vp = VT + (32 * db + n) * GP + 32 * sb + 16 * s + 4 * h; \
                const bf16x4 lo = *(const LAS bf16x4*)vp, hi = *(const LAS bf16x4*)(vp + 8); \
                const bf16x8 vf = __builtin_shufflevector(lo, hi, 0, 1, 2, 3, 4, 5, 6, 7); O[db] = MFMA32(vf, pf, O[db]); } } \
        mw = mwn; slot = s1; \
        asm volatile("s_waitcnt lgkmcnt(0)" ::: "memory"); __builtin_amdgcn_s_barrier(); asm volatile("" ::: "memory"); } while (0)
    f32x16 SA[2], SB[2];
    DSA_QK(SA, 0);
    int slot = 0;
#pragma unroll 1
    for (int kt = 0; kt < nt; kt += 2) {
        DSA_TILE(SA, SB, kt);
        if (kt + 1 < nt) DSA_TILE(SB, SA, kt + 1);
    }
#undef DSA_TILE
#undef DSA_MASK
#undef DSA_LOADT
#undef DSA_WRITET
#undef DSA_QK
    const float lt = lsum + __shfl_xor(lsum, 32), inv = 1.f / lt;
#pragma unroll
    for (int db = 0; db < 2; ++db)
#pragma unroll
        for (int i = 0; i < 16; ++i) OS[n * GP + 32 * db + crow(i, h)] = (bf16)f2bf(O[db][i] * inv);
    asm volatile("s_waitcnt lgkmcnt(0)" ::: "memory");
    bf16* Og = (bf16*)(a.ws + WS_O) + ((size_t)b * SEQ + tq0) * D + hh * 64;
#pragma unroll
    for (int k = 0; k < 4; ++k) { const int idx = lane + 64 * k, row = idx >> 3, c8 = (idx & 7) * 8; *(GAS v4u*)(Og + (size_t)row * D + c8) = *(const LAS v4u*)(OS + row * GP + c8); }
    __syncthreads();
}
#define CONV_MOE 1
__device__ __forceinline__ void s5_build_group(Frame& F, const Args& a, int g, int part, LAS unsigned char* base) {
    LAS f32x2* AP = (LAS f32x2*)base;
    LAS f32x2* BB = (LAS f32x2*)(base + 8704);
    LAS f32x2* CC = (LAS f32x2*)(base + 8704 + 8192);
    LAS float* KT = (LAS float*)(base + 8704 + 16384);
    const float* lam_re = a.in[8]; const float* lam_im = a.in[9]; const float* log_dt = a.in[10];
    const float* b_re = a.in[11]; const float* b_im = a.in[12]; const float* c_re = a.in[13]; const float* c_im = a.in[14]; const float* dsk = a.in[15];
    const int tid = F.tid;
    if (tid < 64) { const int p = tid;
        const float lr = fminf(lam_re[g * 64 + p], -1e-4f), li = lam_im[g * 64 + p], dt = expf(log_dt[g]);
        const float mag = expf(lr * dt), are = mag * cosf(li * dt), aim = mag * sinf(li * dt);
        const float den = lr * lr + li * li, nr = are - 1.f, cre = (nr * lr + aim * li) / den, cim = (aim * lr - nr * li) / den;
        float pr = 1.f, pi = 0.f;
        for (int m = 0; m <= 16; ++m) { AP[m * 64 + p] = (f32x2){pr, pi}; const float t = pr * are - pi * aim; pi = pr * aim + pi * are; pr = t; }
        for (int c = 0; c < 16; ++c) { const float br = b_re[(g * 64 + p) * 16 + c], bi = b_im[(g * 64 + p) * 16 + c]; BB[p * 16 + c] = (f32x2){cre * br - cim * bi, cre * bi + cim * br}; }
    }
    for (int e = tid; e < 1024; e += NWAVES * 64) CC[e] = (f32x2){c_re[g * 1024 + e], c_im[g * 1024 + e]};
    __syncthreads();
    for (int e = tid; e < 4096; e += NWAVES * 64) { const int m = e >> 8, c = (e >> 4) & 15, c2 = e & 15; float acc = 0.f;
        for (int p = 0; p < 64; ++p) { const f32x2 cc = CC[c * 64 + p], ap = AP[m * 64 + p], bb = BB[p * 16 + c2];
            const float tr = cc.x * ap.x - cc.y * ap.y, ti = cc.x * ap.y + cc.y * ap.x; acc += tr * bb.x - ti * bb.y; }
        KT[e] = acc; }
    __syncthreads();
    bf16* MQ = (bf16*)(a.ws + WS_MQ) + (size_t)g * 256 * 384; bf16* PG = (bf16*)(a.ws + WS_PG) + (size_t)g * 256 * 256;
    for (int v = tid; v < 64 * 48; v += NWAVES * 64) { const int row = 64 * part + v / 48, cv = v % 48, j = row >> 4, c = row & 15, col0 = cv * 8; float val[8];
        if (col0 < 256) { const int i = col0 >> 4, c20 = col0 & 15;
#pragma unroll
            for (int q = 0; q < 8; ++q) { float t = (i <= j) ? KT[((j - i) << 8) + (c << 4) + c20 + q] : 0.f; if (i == j && c == c20 + q) t += dsk[g * 16 + c]; val[q] = t; } }
        else { const int p0 = (col0 - 256) & 63; const bool im = (col0 - 256) >= 64;
#pragma unroll
            for (int q = 0; q < 8; ++q) { const f32x2 cc = CC[c * 64 + p0 + q], ap = AP[(j + 1) * 64 + p0 + q]; val[q] = im ? -(cc.x * ap.y + cc.y * ap.x) : (cc.x * ap.x - cc.y * ap.y); } }
        v4u o; o.x = pk2(val[0], val[1]); o.y = pk2(val[2], val[3]); o.z = pk2(val[4], val[5]); o.w = pk2(val[6], val[7]);
        *(GAS v4u*)(MQ + (size_t)row * 384 + col0) = o; }
    for (int v = tid; v < 64 * 32; v += NWAVES * 64) { const int row = 64 * part + (v >> 5), col0 = (v & 31) * 8, i = col0 >> 4, c20 = col0 & 15; float val[8];
        if (row < 128) { const int p = row & 63; const bool im = row >= 64; const f32x2 ap = AP[(15 - i) * 64 + p];
#pragma unroll
            for (int q = 0; q < 8; ++q) { const f32x2 bb = BB[p * 16 + c20 + q]; val[q] = im ? (ap.x * bb.y + ap.y * bb.x) : (ap.x * bb.x - ap.y * bb.y); } }
        else {
#pragma unroll
            for (int q = 0; q < 8; ++q) val[q] = 0.f; }
        v4u o; o.x = pk2(val[0], val[1]); o.y = pk2(val[2], val[3]); o.z = pk2(val[4], val[5]); o.w = pk2(val[6], val[7]);
        *(GAS v4u*)(PG + (size_t)row * 256 + col0) = o; }
    __syncthreads();
}
__device__ __forceinline__ void s5_scan_local(Frame& F, const Args& a) {
    const float* lam_re = a.in[8]; const float* lam_im = a.in[9]; const float* log_dt = a.in[10];
    bf16* UA = (bf16*)(a.ws + WS_H); const float* Z = (const float*)(a.ws + WS_H + 96 * MiB);
    const int p = F.lane, nun = (512 - F.vcu + F.G - 1) / F.G;
    for (int q = F.wave; q < 2 * nun; q += NWAVES) { const int L = (q >> 1) * F.G + F.vcu, g = L >> 3, b = 2 * (L & 7) + (q & 1);
        const float lr = fminf(lam_re[g * 64 + p], -1e-4f), li = lam_im[g * 64 + p], dt = expf(log_dt[g]);
        const float mag = expf(lr * dt); float ar = mag * cosf(li * dt), ai = mag * sinf(li * dt);
#pragma unroll
        for (int k = 0; k < 4; ++k) { const float t = ar * ar - ai * ai; ai = 2.f * ar * ai; ar = t; }
        float sr = 0.f, si = 0.f;
        const float* zp = Z + ((size_t)(g * 2048 + b * 128)) * 128 + p; bf16* up = UA + ((size_t)(g * 2048 + b * 128)) * 384 + 256 + p;
        for (int n0 = 0; n0 < 128; n0 += 16) { float zr[16], zi[16];
#pragma unroll
            for (int k = 0; k < 16; ++k) { zr[k] = zp[(size_t)(n0 + k) * 128]; zi[k] = zp[(size_t)(n0 + k) * 128 + 64]; }
#pragma unroll
            for (int k = 0; k < 16; ++k) { up[(size_t)(n0 + k) * 384] = (bf16)f2bf(sr); up[(size_t)(n0 + k) * 384 + 64] = (bf16)f2bf(si);
                const float t = ar * sr - ai * si + zr[k]; si = ar * si + ai * sr + zi[k]; sr = t; } } }
}
template <int COMB, bool ROUTE, bool F32OUT>
__device__ __forceinline__ void ln_phase(Frame& F, const bf16* src, const bf16* cb, const float* gamma, const float* beta, float* dst, bf16* dstb,
                                         const float* rc, const float* rbc, const float* rf, const float* rbf, unsigned* cnt, int* list, float* tokw) {
    const int gw = F.vcu * NWAVES + F.wave, NGW = F.G * NWAVES, lane = F.lane;
    f32x4 gv[4], bv[4];
#pragma unroll
    for (int j = 0; j < 4; ++j) { gv[j] = ((const GAS f32x4*)gamma)[lane + 64 * j]; bv[j] = ((const GAS f32x4*)beta)[lane + 64 * j]; }
    volatile LAS unsigned* RT = (volatile LAS unsigned*)(F.lds + RING_OFF);
    int lrow = F.wave * 16;
    f32x4 rcv[16];
    LAS f32x4* RF = (LAS f32x4*)(F.lds + RING_OFF + 4096);
    if (ROUTE) { if (F.tid < 16) RT[F.tid] = 0u;
#pragma unroll
        for (int j = 0; j < 4; ++j)
#pragma unroll
            for (int q = 0; q < 4; ++q) rcv[j * 4 + q] = *(const GAS f32x4*)(rc + (size_t)(256 * j + 4 * lane + q) * 4);
        for (int i = F.tid; i < 4096; i += NWAVES * 64) RF[i] = ((const GAS f32x4*)rf)[i];
        __syncthreads(); }
    v2u nx[4], na[4], nb[4];
    { const GAS v2u* xr = (const GAS v2u*)(src + (size_t)gw * D) + lane;
#pragma unroll
      for (int j = 0; j < 4; ++j) nx[j] = xr[64 * j];
      if (COMB == 1) { const GAS v2u* c0 = (const GAS v2u*)(cb + (size_t)gw * D) + lane; const GAS v2u* c1 = (const GAS v2u*)(cb + ((size_t)NTOK + gw) * D) + lane;
#pragma unroll
          for (int j = 0; j < 4; ++j) { na[j] = c0[64 * j]; nb[j] = c1[64 * j]; } } }
    for (int row = gw; row < NTOK; row += NGW) {
        f32x4 v[4]; float s = 0.f;
#pragma unroll
        for (int j = 0; j < 4; ++j) { v[j].x = __uint_as_float(nx[j].x << 16); v[j].y = __uint_as_float(nx[j].x & 0xffff0000u); v[j].z = __uint_as_float(nx[j].y << 16); v[j].w = __uint_as_float(nx[j].y & 0xffff0000u); }
        if (COMB == 1) {
#pragma unroll
            for (int j = 0; j < 4; ++j) { const v2u a = na[j], b = nb[j];
                v[j].x = v[j].x * ALPHA + (__uint_as_float(a.x << 16) + __uint_as_float(b.x << 16)); v[j].y = v[j].y * ALPHA + (__uint_as_float(a.x & 0xffff0000u) + __uint_as_float(b.x & 0xffff0000u));
                v[j].z = v[j].z * ALPHA + (__uint_as_float(a.y << 16) + __uint_as_float(b.y << 16)); v[j].w = v[j].w * ALPHA + (__uint_as_float(a.y & 0xffff0000u) + __uint_as_float(b.y & 0xffff0000u)); } }
        if (row + NGW < NTOK) { const int nr = row + NGW; const GAS v2u* xr = (const GAS v2u*)(src + (size_t)nr * D) + lane;
#pragma unroll
            for (int j = 0; j < 4; ++j) nx[j] = xr[64 * j];
            if (COMB == 1) { const GAS v2u* c0 = (const GAS v2u*)(cb + (size_t)nr * D) + lane; const GAS v2u* c1 = (const GAS v2u*)(cb + ((size_t)NTOK + nr) * D) + lane;
#pragma unroll
                for (int j = 0; j < 4; ++j) { na[j] = c0[64 * j]; nb[j] = c1[64 * j]; } } }
#pragma unroll
        for (int j = 0; j < 4; ++j) s += (v[j].x + v[j].y) + (v[j].z + v[j].w);
        const float mean = wsum(s) * (1.f / D); float s2 = 0.f;
#pragma unroll
        for (int j = 0; j < 4; ++j) { v[j] = v[j] - mean; s2 += (v[j].x * v[j].x + v[j].y * v[j].y) + (v[j].z * v[j].z + v[j].w * v[j].w); }
        const float rstd = 1.f / sqrtf(wsum(s2) * (1.f / D) + LN_EPS);
        GAS v2u* ob = (GAS v2u*)(dstb + (size_t)row * D) + lane;
#pragma unroll
        for (int j = 0; j < 4; ++j) { v[j] = v[j] * rstd * gv[j] + bv[j]; v2u w; w.x = pk2(v[j].x, v[j].y); w.y = pk2(v[j].z, v[j].w); if (dstb) ob[64 * j] = w;
            if (F32OUT) ((GAS f32x4*)(dst + (size_t)row * D) + lane)[64 * j] = v[j]; }
        if (ROUTE) {
            float gl[4] = {0.f, 0.f, 0.f, 0.f};
#pragma unroll
            for (int j = 0; j < 4; ++j)
#pragma unroll
                for (int q = 0; q < 4; ++q) { const f32x4 r = rcv[j * 4 + q]; const float xv = v[j][q];
                    gl[0] = fmaf(xv, r.x, gl[0]); gl[1] = fmaf(xv, r.y, gl[1]); gl[2] = fmaf(xv, r.z, gl[2]); gl[3] = fmaf(xv, r.w, gl[3]); }
#pragma unroll
            for (int g = 0; g < 4; ++g) gl[g] = wsum(gl[g]) + rbc[g];
            int gs = 0; float gm = gl[0];
#pragma unroll
            for (int g = 1; g < 4; ++g) if (gl[g] > gm) { gm = gl[g]; gs = g; }
            float se = 0.f;
#pragma unroll
            for (int g = 0; g < 4; ++g) se += expf(gl[g] - gm);
            const float gwt = 1.f / se;
            float fl[4] = {0.f, 0.f, 0.f, 0.f}; const LAS f32x4* rfg = RF + gs * D;
#pragma unroll
            for (int j = 0; j < 4; ++j)
#pragma unroll
                for (int q = 0; q < 4; ++q) { const f32x4 r = rfg[256 * j + 4 * lane + q]; const float xv = v[j][q];
                    fl[0] = fmaf(xv, r.x, fl[0]); fl[1] = fmaf(xv, r.y, fl[1]); fl[2] = fmaf(xv, r.z, fl[2]); fl[3] = fmaf(xv, r.w, fl[3]); }
#pragma unroll
            for (int e = 0; e < 4; ++e) fl[e] = wsum(fl[e]) + rbf[gs * 4 + e];
            int i1 = 0; float v1 = fl[0];
#pragma unroll
            for (int e = 1; e < 4; ++e) if (fl[e] > v1) { v1 = fl[e]; i1 = e; }
            int i2 = -1; float v2 = -INFINITY;
#pragma unroll
            for (int e = 0; e < 4; ++e) if (e != i1 && fl[e] > v2) { v2 = fl[e]; i2 = e; }
            const float e2 = expf(v2 - v1), w1 = gwt / (1.f + e2), w2 = gwt * e2 / (1.f + e2);
            if (lane == 0) { const int ea = gs * 4 + i1, eb = gs * 4 + i2;
                const unsigned pa = __hip_atomic_fetch_add((LAS unsigned*)RT + ea, 1u, __ATOMIC_RELAXED, __HIP_MEMORY_SCOPE_WORKGROUP), pb = __hip_atomic_fetch_add((LAS unsigned*)RT + eb, 1u, __ATOMIC_RELAXED, __HIP_MEMORY_SCOPE_WORKGROUP);
                RT[64 + lrow] = (unsigned)ea | ((unsigned)eb << 8) | (pa << 16); RT[64 + 128 + lrow] = pb; tokw[row * 2] = w1; tokw[row * 2 + 1] = w2; }
            ++lrow;
        }
    }
    if (ROUTE) {
        __syncthreads();
        if (F.tid < 16) RT[32 + F.tid] = __hip_atomic_fetch_add(cnt + 64 * F.tid, RT[F.tid], RLX_AGENT);
        __syncthreads();
        if (F.tid < 128) { const int lr = F.tid, rw = lr >> 4, it = lr & 15, row = F.vcu * NWAVES + rw + it * NGW;
            if (row < NTOK) { const unsigned e = RT[64 + lr], pb = RT[64 + 128 + lr]; const int ea = e & 255, eb = (e >> 8) & 255; const unsigned pa = e >> 16;
                list[ea * NTOK + RT[32 + ea] + pa] = row * 2; list[eb * NTOK + RT[32 + eb] + pb] = row * 2 + 1; } }
        __syncthreads();
    }
}

__device__ __forceinline__ void moe_convert(const Args& a, int layer, int part  , int wk, int nw, LAS float* scr, int lane) {
    unsigned char* ws = a.ws;
    constexpr int PER = 64, NU = NEXP * 2 * 4 * PER, PERD = 256, ND = NEXP * PERD;
    auto desc = [&](int it) { TrDesc d;
        if (it < NU) { int j = it / PER; const int r = it % PER, pn = j & 3; j >>= 2; const int which = j & 1; j >>= 1; const int le = layer * NEXP + j, kb = r >> 2, nb = r & 3;
            d.W = a.in[27 + which] + (size_t)le * D * MOE_F; d.ldw = MOE_F; d.WT = (bf16*)(ws + WS_WGU) + (size_t)le * 1024 * D; d.ldt = D; d.k0 = kb * 64; d.c0 = pn * 128 + nb * 32; d.nc = 32; d.r0 = pn * 256 + which * 128 + nb * 32; }
        else { const int q = it - NU, le = layer * NEXP + q / PERD, r = q % PERD, kb = r >> 5, nb = r & 31;
            d.W = a.in[29] + (size_t)le * MOE_F * D; d.ldw = D; d.WT = (bf16*)(ws + WS_WD) + (size_t)le * D * MOE_F; d.ldt = MOE_F; d.k0 = kb * 64; d.c0 = nb * 32; d.nc = 32; d.r0 = nb * 32; }
        return d; };
    const int lo = part == 1 ? NU : 0, hi = part == 0 ? NU : NU + ND;
    f32x4 va[8], vb[8]; int it = lo + wk;
    if (it < hi) { TrDesc d0 = desc(it); tr_load(d0, va, lane); }
    for (; it < hi; it += 2 * nw) {
        const TrDesc d0 = desc(it); const bool h1 = it + nw < hi, h2 = it + 2 * nw < hi;
        if (h1) { const TrDesc d1 = desc(it + nw); tr_load(d1, vb, lane); }
        tr_store(d0, va, scr, lane);
        if (h2) { const TrDesc d2 = desc(it + 2 * nw); tr_load(d2, va, lane); }
        if (h1) { const TrDesc d1 = desc(it + nw); tr_store(d1, vb, scr, lane); }
    }
}
__device__ __forceinline__ void p0_prologue(Frame& F, const Args& a) {
    for (int u = F.vcu; u < 256; u += F.G) s5_build_group(F, a, u >> 2, u & 3, F.lds + RING_OFF);
    LAS float* scr = (LAS float*)(F.lds + RING_OFF + F.wave * 16384);
    const int gw = F.vcu * NWAVES + F.wave, NGW = F.G * NWAVES, lane = F.lane;
    unsigned char* ws = a.ws;
    { const float* x = a.in[0]; bf16* xb = (bf16*)(ws + WS_XB); const size_t n8 = (size_t)NTOK * D / 8, st = (size_t)NGW * 64;
      for (size_t i = (size_t)gw * 64 + lane; i < n8; i += 4 * st) { f32x4 v0[4], v1[4];
#pragma unroll
          for (int u = 0; u < 4; ++u) if (i + u * st < n8) { v0[u] = __builtin_nontemporal_load((const GAS f32x4*)(x + (i + u * st) * 8)); v1[u] = __builtin_nontemporal_load((const GAS f32x4*)(x + (i + u * st) * 8 + 4)); }
#pragma unroll
          for (int u = 0; u < 4; ++u) if (i + u * st < n8) { v4u o; o.x = pk2(v0[u].x, v0[u].y); o.y = pk2(v0[u].z, v0[u].w); o.z = pk2(v1[u].x, v1[u].y); o.w = pk2(v1[u].z, v1[u].w);
              *(GAS v4u*)(xb + (i + u * st) * 8) = o; } } }
    { const float* W = a.in[2]; bf16* WT = (bf16*)(ws + WS_WIN);
      const int n0 = tr_seg_items(D, 1088), n1 = tr_seg_items(D, 4), n2 = tr_seg_items(D, 16), n3 = tr_seg_items(D, 1024), n4 = tr_seg_items(D, 512);
      for (int it = gw; it < n0; it += NGW) tr_seg(W, ABP, D, 0, 1088, WT, D, 0, it, scr, lane);
      for (int it = gw; it < n1; it += NGW) tr_seg(W, ABP, D, 1088, 4, WT, D, HC_IW, it, scr, lane);
      for (int it = gw; it < n2; it += NGW) tr_seg(W, ABP, D, 2116, 16, WT, D, HC_BG, it, scr, lane);
      for (int it = gw; it < n3; it += NGW) tr_seg(W, ABP, D, 1092, 1024, WT, D, HC_BQ, it, scr, lane);
      for (int it = gw; it < n4; it += NGW) tr_seg(W, ABP, D, 2132, 512, WT, D, HC_BR, it, scr, lane);
      for (int i = gw * 64 + lane; i < 172 * (D / 8); i += NGW * 64) { const int rr = i / (D / 8), cc = i % (D / 8); const int row = rr < 4 ? 1092 + rr : 1112 + (rr - 4);
          *(GAS v4u*)(WT + (size_t)row * D + cc * 8) = (v4u){0u, 0u, 0u, 0u}; } }
    { const int n = tr_seg_items(D, D);
      for (int it = gw; it < n; it += NGW) tr_seg(a.in[6], D, D, 0, D, (bf16*)(ws + WS_WOUT), D, 0, it, scr, lane);
      for (int it = gw; it < n; it += NGW) tr_seg(a.in[7], D, D, 0, D, (bf16*)(ws + WS_S5IN), D, 0, it, scr, lane);
      for (int it = gw; it < n; it += NGW) tr_seg(a.in[18], D, D, 0, D, (bf16*)(ws + WS_S5OUT), D, 0, it, scr, lane); }
    { const int n = 2 * 8 * tr_seg_items(D, 128);
      for (int it = gw; it < n; it += NGW) { const int per = tr_seg_items(D, 128), j = it / per, which = j & 1, pn = j >> 1;
          tr_seg(a.in[16 + which], D, D, pn * 128, 128, (bf16*)(ws + WS_GLU), D, pn * 256 + which * 128, it % per, scr, lane); } }
    __syncthreads();
}


#define MOE_PHASES(L, PU, PD, PL, LG, LB) \
    if (IN(PU)) { \
        pg8::Gemm g{(const bf16*)(ws + WS_XB), (const bf16*)(ws + WS_WGU) + (size_t)(L) * NEXP * 1024 * D, D, D, D}; \
        pg8::MoeOrder S; S.list = (const int*)(ws + WS_LIST); S.G = F.G; S.c = F.vcu;     _Pragma("unroll") for (int _e = 0; _e < NEXP; ++_e) S.cnt[_e] = __builtin_amdgcn_readfirstlane((int)__hip_atomic_load((unsigned*)(F.ctl + CW_CNT + 1024 * (L)) + 64 * _e, RLX_AGENT)); \
        pg8::EpiGated<1> E{(bf16*)(ws + WS_HMID), MOE_F}; \
        RP(PU) pg8::gemm_phase<pg8::EpiGated<1>, pg8::MoeOrder, true>(F.lds + RING_OFF, g, S, E); \
        if ((L) == 0) { int _T = 0; _Pragma("unroll") for (int _e = 0; _e < NEXP; ++_e) _T += (S.cnt[_e] + 255) >> 8; const int _n5 = 4 * _T - 4 * F.G;     \
            const bool _all = _n5 < 0 || _n5 >= F.G; const int _wk = _all ? F.vcu * NWAVES + F.wave : (F.vcu - _n5) * NWAVES + F.wave, _nw = _all ? F.G * NWAVES : (F.G - _n5) * NWAVES; \
            if (_all || F.vcu >= _n5) { LAS float* _scr = (LAS float*)(F.lds + RING_OFF + F.wave * 16384); moe_convert(args, 0, 1, _wk, _nw, _scr, F.lane); moe_convert(args, 1, 2, _wk, _nw, _scr, F.lane); } } \
        if (BOTH(PU)) GRID_BAR(); } \
    if (IN(PD)) { \
        pg8::Gemm g{(const bf16*)(ws + WS_HMID), (const bf16*)(ws + WS_WD) + (size_t)(L) * NEXP * D * MOE_F, MOE_F, MOE_F, MOE_F}; \
        pg8::MoeOrder S; S.list = (const int*)(ws + WS_LIST); S.G = F.G; S.c = F.vcu;     _Pragma("unroll") for (int _e = 0; _e < NEXP; ++_e) S.cnt[_e] = __builtin_amdgcn_readfirstlane((int)__hip_atomic_load((unsigned*)(F.ctl + CW_CNT + 1024 * (L)) + 64 * _e, RLX_AGENT)); \
        pg8::EpiMoeDown E{(const float*)(ws + WS_TOKW), (bf16*)(ws + WS_CB)}; \
        RP(PD) pg8::gemm_phase<pg8::EpiMoeDown, pg8::MoeOrder, false>(F.lds + RING_OFF, g, S, E); \
        if (BOTH(PD)) GRID_BAR(); } \
    if (IN(PL)) { \
        if ((L) == 0) ln_phase<1, false, false>(F, (const bf16*)(ws + WS_XB), (const bf16*)(ws + WS_CB), LG, LB, nullptr, (bf16*)(ws + WS_XB), nullptr, nullptr, nullptr, nullptr, nullptr, nullptr, nullptr); \
        else ln_phase<1, false, true>(F, (const bf16*)(ws + WS_XB), (const bf16*)(ws + WS_CB), LG, LB, args.out, nullptr, nullptr, nullptr, nullptr, nullptr, nullptr, nullptr, nullptr); \
        if (BOTH(PL)) GRID_BAR(); }

__global__ void __launch_bounds__(NWAVES * 64, 2) mk_fwd(Args args) {
    extern __shared__ __attribute__((aligned(16))) unsigned char lds[];
    Frame F;
    F.lds = (LAS unsigned char*)lds; F.MISC = (volatile LAS unsigned*)(F.lds + MISC_OFF);
    F.tid = threadIdx.x; F.lane = F.tid & 63; F.wave = __builtin_amdgcn_readfirstlane(F.tid >> 6);
    F.G = gridDim.x; { const int bx = blockIdx.x; F.vcu = (F.G % 8 == 0) ? (bx % 8) * (F.G / 8) + bx / 8 : bx; }
    unsigned char* ws = args.ws;
    F.ctl = (gu32*)(ws + WS_CTL);
    for (int u = F.tid; u < (LDS_BYTES - LDSCTL_OFF) / 4; u += NWAVES * 64) ((LAS unsigned*)(F.lds + LDSCTL_OFF))[u] = 0u;
    __syncthreads();
    XcdBarrier bar = xcd_barrier_post((unsigned*)(F.ctl + CW_BAR) + args.li * XCD_BAR_WORDS, F.MISC + 8);
    const int lo = args.ph_lo, hi = args.ph_hi;
#define IN(k) (lo <= (k) && (k) < hi)
#define BOTH(k) (IN(k) && IN((k) + 1))
#define GRID_BAR() xcd_barrier(bar)
#define RP(k) for (int _rp = 0; _rp < ((PROBE == (k)) ? 2 : 1); ++_rp)
    if (IN(0)) { RP(0) p0_prologue(F, args); if (BOTH(0)) GRID_BAR(); }
    if (IN(1)) {
        pg8::Gemm g{(const bf16*)(ws + WS_XB), (const bf16*)(ws + WS_WIN), D, D, D}; pg8::StaticOrder S; S.init(NTOK, HP, F.G, (int)blockIdx.x);
        pg8::EpiStoreBf16 E{(bf16*)(ws + WS_H), HP};
        RP(1) pg8::gemm_phase<pg8::EpiStoreBf16, pg8::StaticOrder, false>(F.lds + RING_OFF, g, S, E);
        { const int units = (NTOK / 256) * (HP / 256), rem = units % F.G;
          if ((int)blockIdx.x >= rem) moe_convert(args, 0, 0, ((int)blockIdx.x - rem) * NWAVES + F.wave, (F.G - rem) * NWAVES, (LAS float*)(F.lds + RING_OFF + F.wave * 16384), F.lane); }
        if (BOTH(1)) GRID_BAR();
    }


    if (IN(2)) {
        RP(20) { Dsa1Ops ops; { const int x = F.vcu; if (x < 2048) dsa1_load(F, args, x >> 7, x & 127, ops); }
          for (int k = 0, x = F.vcu; x < 2048; ++k, x += F.G) { const int b = x >> 7, qb = x & 127, xn = x + F.G;
              const int nb = xn < 2048 ? (xn >> 7) : -1, nq = xn & 127; dsa1_unit(F, args, b, (k & 1) ? 127 - qb : qb, ops, nb, ((k + 1) & 1) ? 127 - nq : nq); } }
        RP(21) for (int u = F.vcu; u < 1024; u += F.G) gla1_pair(F, args, 2 * u);
        if (BOTH(2)) GRID_BAR(); }
    if (IN(3)) {
        RP(30) gla2_scan(F, args);
        RP(31) for (int v = F.vcu; v < 256; v += F.G) { const int bg = v >> 3, s = v & 7;
#pragma unroll 1
            for (int k = 0; k < 4; ++k) { const int qb = k == 0 ? s : (k == 1 ? 15 - s : (k == 2 ? 16 + s : 31 - s)); dsa2_unit(F, args, bg >> 1, bg & 1, qb); } }
        if (BOTH(3)) GRID_BAR(); }
    if (IN(4)) { RP(4) for (int u = F.vcu; u < 1024; u += F.G) gla3_pair(F, args, 2 * u); if (BOTH(4)) GRID_BAR(); }
    if (IN(5)) {
        pg8::Gemm g{(const bf16*)(ws + WS_O), (const bf16*)(ws + WS_WOUT), D, D, D}; pg8::StaticOrder S; S.init(NTOK, D, F.G, (int)blockIdx.x);
        pg8::EpiPre E{(const bf16*)(ws + WS_XB), (bf16*)(ws + WS_H), D};
        RP(5) pg8::gemm_phase<pg8::EpiPre, pg8::StaticOrder, false>(F.lds + RING_OFF, g, S, E);
        if (BOTH(5)) GRID_BAR();
    }
    if (IN(6)) {
        ln_phase<0, true, false>(F, (const bf16*)(ws + WS_H), nullptr, args.in[19], args.in[20], nullptr, (bf16*)(ws + WS_XB), args.in[23], args.in[24], args.in[25], args.in[26],
                          (unsigned*)(F.ctl + CW_CNT), (int*)(ws + WS_LIST), (float*)(ws + WS_TOKW));
        if (BOTH(6)) GRID_BAR(); }
    MOE_PHASES(0, 7, 8, 9, args.in[21], args.in[22])
    if (IN(10)) {
        pg8::Gemm g{(const bf16*)(ws + WS_XB), (const bf16*)(ws + WS_S5IN), D, D, D}; pg8::StaticOrder S; S.init(NTOK, D, F.G, (int)blockIdx.x);
        pg8::EpiS5U E{(bf16*)(ws + WS_H)};
        RP(10) pg8::gemm_phase<pg8::EpiS5U, pg8::StaticOrder, false>(F.lds + RING_OFF, g, S, E);
        if (BOTH(10)) GRID_BAR();
    }
    if (IN(11)) {
        { pg8::Gemm g{(const bf16*)(ws + WS_H), (const bf16*)(ws + WS_PG), 384, 256, 256}; pg8::S5Order S{F.G, F.vcu};
          pg8::EpiS5Z E{(float*)(ws + WS_H + 96 * MiB)};
          pg8::gemm_phase<pg8::EpiS5Z, pg8::S5Order, false>(F.lds + RING_OFF, g, S, E); }
        VM_WAIT(); __syncthreads();
        s5_scan_local(F, args);
        VM_WAIT(); __syncthreads();
        { pg8::Gemm g{(const bf16*)(ws + WS_H), (const bf16*)(ws + WS_MQ), 384, 384, 384}; pg8::S5Order S{F.G, F.vcu};
          pg8::EpiS5Y E{(bf16*)(ws + WS_O)};
          pg8::gemm_phase<pg8::EpiS5Y, pg8::S5Order, false>(F.lds + RING_OFF, g, S, E); }
        if (IN(14)) GRID_BAR();
    }
    if (IN(14)) {
        pg8::Gemm g{(const bf16*)(ws + WS_O), (const bf16*)(ws + WS_GLU), D, D, D}; pg8::StaticOrder S; S.init(NTOK, 2 * D, F.G, (int)blockIdx.x);
        pg8::EpiGated<0> E{(bf16*)(ws + WS_F1), D};
        RP(14) pg8::gemm_phase<pg8::EpiGated<0>, pg8::StaticOrder, false>(F.lds + RING_OFF, g, S, E);
        if (BOTH(14)) GRID_BAR();
    }
    if (IN(15)) {
        pg8::Gemm g{(const bf16*)(ws + WS_F1), (const bf16*)(ws + WS_S5OUT), D, D, D}; pg8::StaticOrder S; S.init(NTOK, D, F.G, (int)blockIdx.x);
        pg8::EpiPre E{(const bf16*)(ws + WS_XB), (bf16*)(ws + WS_H), D};
        pg8::gemm_phase<pg8::EpiPre, pg8::StaticOrder, false>(F.lds + RING_OFF, g, S, E);
        if (BOTH(15)) GRID_BAR();
    }
    if (IN(16)) {
        ln_phase<0, true, false>(F, (const bf16*)(ws + WS_H), nullptr, args.in[19] + D, args.in[20] + D, nullptr, (bf16*)(ws + WS_XB), args.in[23] + D * 4, args.in[24] + 4, args.in[25] + 4 * D * 4, args.in[26] + 16,
                          (unsigned*)(F.ctl + CW_CNT + 1024), (int*)(ws + WS_LIST), (float*)(ws + WS_TOKW));
        if (BOTH(16)) GRID_BAR(); }
    MOE_PHASES(1, 17, 18, 19, args.in[21] + D, args.in[22] + D)
#undef IN
#undef BOTH
}
static int g_grid = 0;
extern "C" void kernel_launch(void* const* d_in, const int* in_sizes, int n_in, void* d_out, int out_size, void* d_ws, size_t ws_size, hipStream_t stream) {
    if (g_grid == 0) {
        if (n_in != 30 || out_size != NTOK * D || ws_size < WS_END) { fprintf(stderr, "kernel_launch: unexpected problem (n_in %d out %d ws %zu)\n", n_in, out_size, ws_size); g_grid = -1; return; }
        int dev = 0, cus = 0, per_cu = 0;
        if (hipGetDevice(&dev) != hipSuccess || hipDeviceGetAttribute(&cus, hipDeviceAttributeMultiprocessorCount, dev) != hipSuccess) { g_grid = -1; return; }
        if (hipFuncSetAttribute((const void*)mk_fwd, hipFuncAttributeMaxDynamicSharedMemorySize, LDS_BYTES) != hipSuccess) { fprintf(stderr, "kernel_launch: hipFuncSetAttribute failed\n"); g_grid = -1; return; }
        if (hipOccupancyMaxActiveBlocksPerMultiprocessor(&per_cu, (const void*)mk_fwd, NWAVES * 64, LDS_BYTES) != hipSuccess || per_cu < 1) fprintf(stderr, "kernel_launch: occupancy query says %d\n", per_cu);
        (void)hipGetLastError();
        if (cus < 256) { fprintf(stderr, "kernel_launch: built for a 256-CU MI355X (one workgroup per CU); found %d CUs\n", cus); g_grid = -1; return; }
        g_grid = 256;
    }
    if (g_grid < 0) return;
    (void)hipMemsetAsync((char*)d_ws + WS_CTL, 0, CTL_ZERO_BYTES, stream);
    Args a{};
    for (int i = 0; i < 30; ++i) a.in[i] = (const float*)d_in[i];
    a.out = (float*)d_out; a.ws = (unsigned char*)d_ws; a.ph_lo = 0; a.ph_hi = 20; a.li = 0; a.pad = 0;
    hipLaunchKernelGGL(mk_fwd, dim3(g_grid), dim3(NWAVES * 64), LDS_BYTES, stream, a);
}
```

```cpp
#include <hip/hip_runtime.h>
#include <math.h>
#include <stdio.h>
#include <stdint.h>

#define GAS __attribute__((address_space(1)))
#define LAS __attribute__((address_space(3)))
typedef unsigned short bf16;
typedef unsigned v4u __attribute__((ext_vector_type(4)));
typedef unsigned v2u __attribute__((ext_vector_type(2)));
typedef float f32x4 __attribute__((ext_vector_type(4)));
typedef float f32x2 __attribute__((ext_vector_type(2)));
typedef float f32x16 __attribute__((ext_vector_type(16)));
typedef short bf16x8 __attribute__((ext_vector_type(8)));
typedef short bf16x4 __attribute__((ext_vector_type(4)));
typedef GAS unsigned gu32;
#define RLX_AGENT __ATOMIC_RELAXED, __HIP_MEMORY_SCOPE_AGENT
#define LDS_WAIT() asm volatile("s_waitcnt lgkmcnt(0)" ::: "memory")
#define VM_WAIT() asm volatile("s_waitcnt vmcnt(0)" ::: "memory")

constexpr int D = 1024, BATCH = 16, SEQ = 2048, NTOK = BATCH * SEQ;
constexpr int ABP = 2644;
constexpr int HP = 2816;
constexpr int HC_AQ = 0, HC_AK = 512, HC_AV = 640, HC_IQ = 768, HC_IK = 1024, HC_IW = 1088, HC_BG = 1096, HC_BQ = 1280, HC_BK = 1536, HC_BV = 1792, HC_BR = 2304;
constexpr float ALPHA = 1.4142135623730951f;
constexpr float LN_EPS = 1e-5f;
constexpr int NEXP = 16, MOE_F = 512;
constexpr int MAXSLOT = 65536 + NEXP * 256;

__device__ __forceinline__ float bf2f(bf16 v) { return __uint_as_float(((unsigned)v) << 16); }
__device__ __forceinline__ unsigned f2bf(float f) { unsigned u = __float_as_uint(f); return (u + 0x7fffu + ((u >> 16) & 1u)) >> 16; }
__device__ __forceinline__ unsigned cvt2bf(float lo, float hi) { unsigned r; asm volatile("v_cvt_pk_bf16_f32 %0, %1, %2" : "=v"(r) : "v"(lo), "v"(hi)); return r; }
__device__ __forceinline__ unsigned pk2(float lo, float hi) { return f2bf(lo) | (f2bf(hi) << 16); }
__device__ __forceinline__ float wsum(float v) {
#define WS_DPP(ctrl, rm, bc) v += __int_as_float(__builtin_amdgcn_update_dpp(0, __float_as_int(v), ctrl, rm, 0xF, bc))
    WS_DPP(0xB1, 0xF, true); WS_DPP(0x4E, 0xF, true); WS_DPP(0x141, 0xF, true); WS_DPP(0x140, 0xF, true); WS_DPP(0x142, 0xA, false); WS_DPP(0x143, 0xC, false);
#undef WS_DPP
    return __int_as_float(__builtin_amdgcn_readlane(__float_as_int(v), 63));
}
__device__ const unsigned char T5B[128] = {0, 1, 2, 3, 4, 5, 6, 7, 8, 9, 10, 11, 12, 13, 14, 15, 16, 16, 16, 17, 17, 18, 18, 18, 19, 19, 19, 20, 20, 20, 20, 21, 21, 21, 21, 22, 22, 22, 22, 22, 23, 23, 23, 23, 23, 23, 24, 24, 24, 24, 24, 24, 25, 25, 25, 25, 25, 25, 25, 26, 26, 26, 26, 26, 26, 26, 26, 27, 27, 27, 27, 27, 27, 27, 27, 27, 27, 28, 28, 28, 28, 28, 28, 28, 28, 28, 28, 29, 29, 29, 29, 29, 29, 29, 29, 29, 29, 29, 29, 30, 30, 30, 30, 30, 30, 30, 30, 30, 30, 30, 30, 30, 30, 31, 31, 31, 31, 31, 31, 31, 31, 31, 31, 31, 31, 31, 31, 31};

__device__ __forceinline__ float xhalf_max(float v) { const auto r = __builtin_amdgcn_permlane32_swap(__float_as_uint(v), __float_as_uint(v), false, false); return fmaxf(__uint_as_float(r[0]), __uint_as_float(r[1])); }
__device__ __forceinline__ float xhalf_sum(float v) { const auto r = __builtin_amdgcn_permlane32_swap(__float_as_uint(v), __float_as_uint(v), false, false); return __uint_as_float(r[0]) + __uint_as_float(r[1]); }
#ifndef PROBE
#define PROBE -1
#endif
constexpr int CW_DIAG = 8;
#ifdef STAMP
#define STAMP_DECL unsigned _st_acc = 0u, _st_t0 = 0u, _st_n = 0u
#define STAMP_BEGIN(id) do { if (STAMP == (id)) _st_t0 = (unsigned)__builtin_amdgcn_s_memtime(); } while (0)
#define STAMP_END(id) do { if (STAMP == (id)) { _st_acc += (unsigned)__builtin_amdgcn_s_memtime() - _st_t0; ++_st_n; } } while (0)
#define STAMP_PUBLISH(ctl, wg, scale) do { if ((int)blockIdx.x == (wg) && threadIdx.x == 0 && _st_n) __hip_atomic_store((unsigned*)((ctl) + CW_DIAG), __float_as_uint((float)_st_acc / (float)_st_n * (scale)), RLX_AGENT); } while (0)
#define STAMP_T0(id, t0) unsigned t0 = 0u; do { if (STAMP == (id)) t0 = (unsigned)__builtin_amdgcn_s_memtime(); } while (0)
#define STAMP_END_PUB(id, t0, ctl, wg, scale) do { if (STAMP == (id)) { const unsigned _dt = (unsigned)__builtin_amdgcn_s_memtime() - t0; if ((int)blockIdx.x == (wg) && threadIdx.x == 0) __hip_atomic_store((unsigned*)((ctl) + CW_DIAG), __float_as_uint((float)_dt * (scale)), RLX_AGENT); } } while (0)
#else
#define STAMP_DECL
#define STAMP_BEGIN(id)
#define STAMP_END(id)
#define STAMP_PUBLISH(ctl, wg, scale)
#define STAMP_T0(id, t0)
#define STAMP_END_PUB(id, t0, ctl, wg, scale)
#endif
namespace pg8 {
#define PG8_LAS __attribute__((address_space(3)))
constexpr int BM = 256, BK = 64, HALF = 128, HTB = HALF * BK * 2  , STAGE_BYTES = 8 * HTB, NXCD = 8, WGM = 8;
__host__ __device__ __forceinline__ int lds_byte(int r, int c) { const int st = (r >> 4) * 2 + (c >> 5), rr = r & 15, cc = c & 31, ob = rr * 64 + cc * 2; return st * 1024 + (ob ^ (((ob >> 9) & 1) << 5)); }
__host__ __device__ __forceinline__ void stage_rc(int b, int& R, int& C) { const int st = b / 1024, sb = b % 1024, swz = sb ^ (((sb >> 9) & 1) << 5); R = (st >> 1) * 16 + swz / 64; C = (st & 1) * 32 + (swz % 64) / 2; }
__host__ __device__ __forceinline__ int perm32(int rho) { const int n = rho >> 4, i = rho & 15; return 8 * (i >> 2) + 4 * n + (i & 3); }

struct Unit { int arow0, brow0, pm, pn, aux, cnt; const int* gather; };
struct Gemm { const bf16* A; const bf16* Bt; int lda, ldb, K; };

struct StaticOrder {
    int nM, nN, nwg, G, c;
    __device__ void init(int M, int N, int G_, int c_) { nM = M / BM; nN = N / BM; nwg = nM * nN; G = G_; c = c_; }
    __device__ bool next(int i, Unit& u) const {
        const long L = (long)i * G + c; if (L >= nwg) return false;
        int wgid = (int)L; { const int q = nwg / NXCD, r = nwg % NXCD, xcd = wgid % NXCD, off = wgid / NXCD; wgid = (xcd < r ? xcd * (q + 1) : r * (q + 1) + (xcd - r) * q) + off; }
        const int nig = WGM * nN, gid = wgid / nig, fm = gid * WGM, gsz = (nM - fm) < WGM ? (nM - fm) : WGM;
        u.pm = fm + ((wgid % nig) % gsz); u.pn = (wgid % nig) / gsz; u.arow0 = u.pm * BM; u.brow0 = u.pn * BM; u.aux = 0; u.cnt = BM; u.gather = nullptr; return true;
    }
};
__device__ __forceinline__ unsigned cvt_pk_bf16(float lo, float hi) { unsigned r; asm volatile("v_cvt_pk_bf16_f32 %0, %1, %2" : "=v"(r) : "v"(lo), "v"(hi)); return r; }

template <class Epi, class Sched, bool GATHER = false, int SID = 0>
__device__ __forceinline__ void gemm_phase(PG8_LAS unsigned char* lds, const Gemm g, const Sched& S, const Epi& E, gu32* sctl = nullptr) {
    const int tid = threadIdx.x, wid = __builtin_amdgcn_readfirstlane(tid >> 6), lane = tid & 63, wr = wid >> 2, wc = wid & 3, fr = lane & 15, fq = lane >> 4;
    const int K = g.K, nt = K / BK;
    unsigned voffA[2], voffB[2];
#pragma unroll
    for (int i = 0; i < 2; ++i) { int R, C; stage_rc(tid * 16 + i * 8192, R, C); const int Rb = Epi::PERM ? ((R & ~31) + perm32(R & 31)) : R;
        voffA[i] = GATHER ? (unsigned)(C * 2) : (unsigned)(R * g.lda + C) * 2u; voffB[i] = (unsigned)(Rb * g.ldb + C) * 2u; }
    const size_t kstep = (size_t)(BK * 2);
    const size_t hstepA = (size_t)HALF * g.lda * 2, hstepB = (size_t)HALF * g.ldb * 2;
    const unsigned ldsw = (unsigned)wid * 1024u;
    const int aoff = lds_byte(wr * 64 + fr, fq * 8), boff = lds_byte(wc * 32 + fr, fq * 8);
#define PG8_SA(b, h) (((b) * 2 + (h)) * HTB)
#define PG8_SB(b, h) ((4 + (b) * 2 + (h)) * HTB)
#define PG8_STAGE(bufoff, gbase, voff) do { _Pragma("unroll") for (int _i = 0; _i < 2; ++_i) \
        __builtin_amdgcn_global_load_lds((const unsigned*)((const char*)(gbase) + (voff)[_i]), (PG8_LAS unsigned*)(lds + (bufoff) + ldsw + _i * 8192), 16, 0, 0); } while (0)
#define PG8_STAGE_A(bufoff, P, O, h, ko) do { _Pragma("unroll") for (int _i = 0; _i < 2; ++_i) { \
        const char* _p; if constexpr (GATHER) { const unsigned _t = _i ? ((O)[h] >> 16) : ((O)[h] & 0xffffu); _p = (const char*)(P) + (ko) + (size_t)(_t * (unsigned)(g.lda * 2) + voffA[_i]); } \
        else _p = (const char*)(P) + (ko) + (size_t)(h) * hstepA + voffA[_i]; \
        __builtin_amdgcn_global_load_lds((const unsigned*)_p, (PG8_LAS unsigned*)(lds + (bufoff) + ldsw + _i * 8192), 16, 0, 0); } } while (0)
#define PG8_LDA(dst, b, h) do { _Pragma("unroll") for (int m = 0; m < 4; ++m) _Pragma("unroll") for (int k = 0; k < 2; ++k) dst[m][k] = *(const PG8_LAS bf16x8*)(lds + PG8_SA(b, h) + aoff + m * 2048 + k * 1024); } while (0)
#define PG8_LDB(dst, b, h) do { _Pragma("unroll") for (int n = 0; n < 2; ++n) _Pragma("unroll") for (int k = 0; k < 2; ++k) dst[n][k] = *(const PG8_LAS bf16x8*)(lds + PG8_SB(b, h) + boff + n * 2048 + k * 1024); } while (0)
#define PG8_MMA(ai, bj, At, Bt) do { __builtin_amdgcn_s_setprio(1); _Pragma("unroll") for (int m = 0; m < 4; ++m) _Pragma("unroll") for (int n = 0; n < 2; ++n) _Pragma("unroll") for (int k = 0; k < 2; ++k) \
        acc[ai][bj][m][n] = __builtin_amdgcn_mfma_f32_16x16x32_bf16(Bt[n][k], At[m][k], acc[ai][bj][m][n], 0, 0, 0); __builtin_amdgcn_s_setprio(0); } while (0)
#define PG8_WAIT_V(n) asm volatile("s_waitcnt vmcnt(" #n ")" ::: "memory")
#define PG8_WAIT_L(n) asm volatile("s_waitcnt lgkmcnt(" #n ")" ::: "memory")
#define PG8_BAR __builtin_amdgcn_s_barrier()
#define PG8_SCHED __builtin_amdgcn_sched_barrier(0)
    Unit cur, nxt; int ui = 0;
    if (!S.next(0, cur)) return;
    f32x4 acc[2][2][4][2];
#pragma unroll
    for (int a = 0; a < 2; ++a)
#pragma unroll
        for (int b = 0; b < 2; ++b)
#pragma unroll
            for (int m = 0; m < 4; ++m)
#pragma unroll
                for (int n = 0; n < 2; ++n) acc[a][b][m][n] = (f32x4){0.f, 0.f, 0.f, 0.f};
    bf16x8 At[4][2], B0[2][2], B1[2][2];
    unsigned OA[2], ON[2];
    const char* cA; const char* cB;
#define PG8_SETUP(u, P, O) do { \
        if constexpr (GATHER) { P = (const char*)g.A; _Pragma("unroll") for (int _h = 0; _h < 2; ++_h) { unsigned _pk = 0u; _Pragma("unroll") for (int _i = 0; _i < 2; ++_i) { \
            int _R, _C; stage_rc(tid * 16 + _i * 8192, _R, _C); const int _r = _h * HALF + _R; const unsigned _t = (_r < (u).cnt) ? (unsigned)((u).gather[_r] >> 1) : 0u; _pk |= _t << (16 * _i); } O[_h] = _pk; } } \
        else { P = (const char*)g.A + (size_t)(u).arow0 * g.lda * 2; } } while (0)
    PG8_SETUP(cur, cA, OA);
    cB = (const char*)g.Bt + (size_t)cur.brow0 * g.ldb * 2;
    PG8_STAGE(PG8_SB(0, 0), cB, voffB); PG8_STAGE(PG8_SB(0, 1), cB + hstepB, voffB); PG8_STAGE_A(PG8_SA(0, 0), cA, OA, 0, 0); PG8_STAGE_A(PG8_SA(0, 1), cA, OA, 1, 0);
    if (wr == 1) PG8_BAR;
    PG8_WAIT_V(2); PG8_BAR;
    PG8_STAGE(PG8_SB(1, 0), cB + kstep, voffB); PG8_STAGE_A(PG8_SA(1, 0), cA, OA, 0, kstep); PG8_STAGE(PG8_SB(1, 1), cB + hstepB + kstep, voffB);
    PG8_WAIT_V(6); PG8_BAR;
    for (;;) {
        STAMP_T0(SID * 10 + 1, _tu);
        const bool has_next = S.next(ui + 1, nxt);
        const char* nA = cA; const char* nB = cB;
        if constexpr (GATHER) { ON[0] = OA[0]; ON[1] = OA[1]; }
        if (has_next) { PG8_SETUP(nxt, nA, ON); nB = (const char*)g.Bt + (size_t)nxt.brow0 * g.ldb * 2; }
        for (int t = 0; t < nt; t += 2) {
            const bool last = (t == nt - 2);
            const size_t k1 = (size_t)(t + 1) * kstep;
            const char* a2 = last ? nA : cA; const char* b2 = last ? nB : cB + (size_t)(t + 2) * kstep;
            const size_t k2 = last ? 0 : (size_t)(t + 2) * kstep, k3 = k2 + kstep;
            const char* b3 = b2 + kstep;
            unsigned O2[2];
            if constexpr (GATHER) { O2[0] = last ? ON[0] : OA[0]; O2[1] = last ? ON[1] : OA[1]; }
            PG8_LDB(B0, 0, 0); PG8_LDB(B1, 0, 1); PG8_SCHED; PG8_LDA(At, 0, 0); PG8_STAGE_A(PG8_SA(1, 1), cA, OA, 1, k1);
            PG8_WAIT_V(8); PG8_WAIT_L(0); PG8_BAR; PG8_MMA(0, 0, At, B0); PG8_MMA(0, 1, At, B1); PG8_BAR; PG8_SCHED;
            PG8_LDA(At, 0, 1); PG8_STAGE(PG8_SB(0, 0), b2, voffB); PG8_STAGE(PG8_SB(0, 1), b2 + hstepB, voffB); PG8_STAGE_A(PG8_SA(0, 0), a2, O2, 0, k2);
            PG8_WAIT_V(8); PG8_WAIT_L(0); PG8_BAR; PG8_MMA(1, 0, At, B0); PG8_MMA(1, 1, At, B1); PG8_BAR; PG8_SCHED;
            PG8_LDB(B0, 1, 0); PG8_LDB(B1, 1, 1); PG8_SCHED; PG8_LDA(At, 1, 0); PG8_STAGE_A(PG8_SA(0, 1), a2, O2, 1, k2);
            PG8_WAIT_V(8); PG8_WAIT_L(0); PG8_BAR; PG8_MMA(0, 0, At, B0); PG8_MMA(0, 1, At, B1); PG8_BAR; PG8_SCHED;
            PG8_LDA(At, 1, 1); PG8_STAGE(PG8_SB(1, 0), b3, voffB); PG8_STAGE(PG8_SB(1, 1), b3 + hstepB, voffB); PG8_STAGE_A(PG8_SA(1, 0), a2, O2, 0, k3);
            PG8_WAIT_V(8); PG8_WAIT_L(0); PG8_BAR; PG8_MMA(1, 0, At, B0); PG8_MMA(1, 1, At, B1); PG8_BAR; PG8_SCHED;
        }
        STAMP_T0(SID * 10 + 3, _ta);
        if (wr == 0) PG8_BAR;
        STAMP_END_PUB(SID * 10 + 3, _ta, sctl, 37, (float)(STAMP_SCALE)); STAMP_T0(SID * 10 + 4, _tb);
        E(acc, cur, wr, wc, fr, fq);
        asm volatile("" ::: "memory"); STAMP_END_PUB(SID * 10 + 4, _tb, sctl, 37, (float)(STAMP_SCALE)); STAMP_END_PUB(SID * 10 + 1, _tu, sctl, 37, (float)(STAMP_SCALE));
        if (!has_next) break;
#pragma unroll
        for (int a = 0; a < 2; ++a)
#pragma unroll
            for (int b = 0; b < 2; ++b)
#pragma unroll
                for (int m = 0; m < 4; ++m)
#pragma unroll
                    for (int n = 0; n < 2; ++n) acc[a][b][m][n] = (f32x4){0.f, 0.f, 0.f, 0.f};
        cur = nxt; cA = nA; cB = nB; ++ui;
        if constexpr (GATHER) { OA[0] = ON[0]; OA[1] = ON[1]; }
        if (wr == 1) PG8_BAR;
    }
    PG8_WAIT_V(0);
    PG8_BAR;
#undef PG8_SA
#undef PG8_SB
#undef PG8_STAGE
#undef PG8_STAGE_A
#undef PG8_LDA
#undef PG8_LDB
#undef PG8_MMA
#undef PG8_WAIT_V
#undef PG8_WAIT_L
#undef PG8_BAR
#undef PG8_SCHED
#undef PG8_SETUP
}

struct EpiStoreBf16 {
    static constexpr bool PERM = true;
    bf16* O; int ldc;
    __device__ __forceinline__ void operator()(const f32x4 (&acc)[2][2][4][2], const Unit& u, int wr, int wc, int fr, int fq) const {
        const int row0 = u.pm * BM + wr * 64 + fr, col0 = u.pn * BM + wc * 32 + 8 * fq;
#pragma unroll
        for (int ai = 0; ai < 2; ++ai)
#pragma unroll
            for (int m = 0; m < 4; ++m) { bf16* rowp = O + (size_t)(row0 + ai * HALF + m * 16) * ldc + col0;
#pragma unroll
                for (int bj = 0; bj < 2; ++bj) { const f32x4 v0 = acc[ai][bj][m][0], v1 = acc[ai][bj][m][1];
                    v4u w; w.x = cvt_pk_bf16(v0[0], v0[1]); w.y = cvt_pk_bf16(v0[2], v0[3]); w.z = cvt_pk_bf16(v1[0], v1[1]); w.w = cvt_pk_bf16(v1[2], v1[3]);
                    *(v4u*)(rowp + bj * HALF) = w; } }
    }
};

struct EpiPre {
    static constexpr bool PERM = true;
    const bf16* base; bf16* out; int ldc;
    __device__ __forceinline__ void operator()(const f32x4 (&acc)[2][2][4][2], const Unit& u, int wr, int wc, int fr, int fq) const {
        const int row0 = u.pm * BM + wr * 64 + fr, col0 = u.pn * BM + wc * 32 + 8 * fq;
#pragma unroll
        for (int ai = 0; ai < 2; ++ai)
#pragma unroll
            for (int m = 0; m < 4; ++m) { const size_t off = (size_t)(row0 + ai * HALF + m * 16) * ldc + col0;
#pragma unroll
                for (int bj = 0; bj < 2; ++bj) { const v4u bs = *(const v4u*)(base + off + bj * HALF); const f32x4 v0 = acc[ai][bj][m][0], v1 = acc[ai][bj][m][1]; v4u w;
                    w.x = cvt_pk_bf16(fmaf(__uint_as_float(bs.x << 16), ALPHA, v0[0]), fmaf(__uint_as_float(bs.x & 0xffff0000u), ALPHA, v0[1]));
                    w.y = cvt_pk_bf16(fmaf(__uint_as_float(bs.y << 16), ALPHA, v0[2]), fmaf(__uint_as_float(bs.y & 0xffff0000u), ALPHA, v0[3]));
                    w.z = cvt_pk_bf16(fmaf(__uint_as_float(bs.z << 16), ALPHA, v1[0]), fmaf(__uint_as_float(bs.z & 0xffff0000u), ALPHA, v1[1]));
                    w.w = cvt_pk_bf16(fmaf(__uint_as_float(bs.w << 16), ALPHA, v1[2]), fmaf(__uint_as_float(bs.w & 0xffff0000u), ALPHA, v1[3]));
                    *(v4u*)(out + off + bj * HALF) = w; } }
    }
};
struct EpiS5U {
    static constexpr bool PERM = true;
    bf16* UA;
    __device__ __forceinline__ void operator()(const f32x4 (&acc)[2][2][4][2], const Unit& u, int wr, int wc, int fr, int fq) const {
#pragma unroll
        for (int ai = 0; ai < 2; ++ai)
#pragma unroll
            for (int m = 0; m < 4; ++m) { const int tok = u.pm * BM + ai * HALF + wr * 64 + m * 16 + fr; const int b = tok >> 11, l = tok & 2047, ch = l >> 4, tl = l & 15;
#pragma unroll
                for (int bj = 0; bj < 2; ++bj) { const int c0 = u.pn * BM + bj * HALF + wc * 32 + 8 * fq; const int g = c0 >> 4, cc = c0 & 15;
                    const f32x4 v0 = acc[ai][bj][m][0], v1 = acc[ai][bj][m][1];
                    v4u w; w.x = cvt_pk_bf16(v0[0], v0[1]); w.y = cvt_pk_bf16(v0[2], v0[3]); w.z = cvt_pk_bf16(v1[0], v1[1]); w.w = cvt_pk_bf16(v1[2], v1[3]);
                    *(v4u*)(UA + ((size_t)(g * 2048 + b * 128 + ch)) * 384 + tl * 16 + cc) = w; } }
    }
};
struct EpiS5Z {
    static constexpr bool PERM = false;
    float* Z;
    __device__ __forceinline__ void operator()(const f32x4 (&acc)[2][2][4][2], const Unit& u, int wr, int wc, int fr, int fq) const {
#pragma unroll
        for (int ai = 0; ai < 2; ++ai)
#pragma unroll
            for (int m = 0; m < 4; ++m) { float* rowp = Z + (size_t)(u.arow0 + ai * HALF + wr * 64 + m * 16 + fr) * 128 + wc * 32 + 4 * fq;
#pragma unroll
                for (int n = 0; n < 2; ++n) *(f32x4*)(rowp + n * 16) = acc[ai][0][m][n]; }
    }
};
__device__ __forceinline__ float gelu_tanh(float y) { const float z = 0.7978845608028654f * (y + 0.044715f * y * y * y); return y / (1.f + __expf(-2.f * z)); }
struct EpiS5Y {
    static constexpr bool PERM = true;
    bf16* G;
    __device__ __forceinline__ void operator()(const f32x4 (&acc)[2][2][4][2], const Unit& u, int wr, int wc, int fr, int fq) const {
        const int g = u.aux;
#pragma unroll
        for (int ai = 0; ai < 2; ++ai)
#pragma unroll
            for (int m = 0; m < 4; ++m) { const int row = u.pm * BM + ai * HALF + wr * 64 + m * 16 + fr; const int b = row >> 7, ch = row & 127;
#pragma unroll
                for (int bj = 0; bj < 2; ++bj) { const int c0 = bj * HALF + wc * 32 + 8 * fq; const int tl = c0 >> 4, cc = c0 & 15;
                    const f32x4 v0 = acc[ai][bj][m][0], v1 = acc[ai][bj][m][1];
                    v4u w; w.x = cvt_pk_bf16(gelu_tanh(v0[0]), gelu_tanh(v0[1])); w.y = cvt_pk_bf16(gelu_tanh(v0[2]), gelu_tanh(v0[3]));
                    w.z = cvt_pk_bf16(gelu_tanh(v1[0]), gelu_tanh(v1[1])); w.w = cvt_pk_bf16(gelu_tanh(v1[2]), gelu_tanh(v1[3]));
                    *(v4u*)(G + ((size_t)(b * 2048 + ch * 16 + tl)) * D + g * 16 + cc) = w; } }
    }
};
template <int ACT> struct EpiGated {
    static constexpr bool PERM = true;
    bf16* O; int ldc;
    __device__ __forceinline__ void operator()(const f32x4 (&acc)[2][2][4][2], const Unit& u, int wr, int wc, int fr, int fq) const {
        const int col0 = u.pn * HALF + wc * 32 + 8 * fq;
#pragma unroll
        for (int ai = 0; ai < 2; ++ai)
#pragma unroll
            for (int m = 0; m < 4; ++m) { const int row = u.pm * BM + ai * HALF + wr * 64 + m * 16 + fr; float r[8];
#pragma unroll
                for (int n = 0; n < 2; ++n)
#pragma unroll
                    for (int j = 0; j < 4; ++j) { const float v = acc[ai][0][m][n][j], gt = acc[ai][1][m][n][j];
                        r[n * 4 + j] = ACT == 0 ? v / (1.f + __expf(-gt)) : v / (1.f + __expf(-v)) * gt; }
                v4u w; w.x = cvt_pk_bf16(r[0], r[1]); w.y = cvt_pk_bf16(r[2], r[3]); w.z = cvt_pk_bf16(r[4], r[5]); w.w = cvt_pk_bf16(r[6], r[7]);
                *(v4u*)(O + (size_t)row * ldc + col0) = w; }
    }
};
struct S5Order {
    int G, c;
    __device__ bool next(int i, Unit& u) const { const int L = i * G + c; if (L >= 512) return false; const int g = L >> 3, rt = L & 7;
        u.arow0 = g * 2048 + rt * BM; u.brow0 = g * BM; u.pm = rt; u.pn = 0; u.aux = g; u.cnt = BM; u.gather = nullptr; return true; }
};

struct MoeOrder {
    int cnt[NEXP]; const int* list; int G, c;
    __device__ bool next(int i, Unit& u) const { const int L = i * G + c, rt = L >> 2, pn = L & 3; int acc = 0, se = -1, loc = 0, sc = 0;
#pragma unroll
        for (int e = 0; e < NEXP; ++e) { const int ce = cnt[e], nt = (ce + 255) >> 8; if (rt >= acc && rt < acc + nt) { se = e; loc = rt - acc; sc = ce; } acc += nt; }
        if (se < 0) return false;
        u.arow0 = rt * BM; u.brow0 = se * 1024 + pn * BM; u.pm = rt; u.pn = pn; u.aux = se; const int rem = sc - loc * BM; u.cnt = rem < BM ? rem : BM; u.gather = list + se * NTOK + loc * BM; return true; }
};
struct EpiMoeDown {
    static constexpr bool PERM = true;
    const float* tokw; bf16* CB;
    __device__ __forceinline__ void operator()(const f32x4 (&acc)[2][2][4][2], const Unit& u, int wr, int wc, int fr, int fq) const {
        const int col0 = u.pn * BM + wc * 32 + 8 * fq;
#pragma unroll
        for (int ai = 0; ai < 2; ++ai)
#pragma unroll
            for (int m = 0; m < 4; ++m) { const int r = ai * HALF + wr * 64 + m * 16 + fr;
                if (r < u.cnt) { const int ent = u.gather[r]; const int tok = ent >> 1, k = ent & 1; const float w = tokw[ent];
                    bf16* rowp = CB + ((size_t)k * NTOK + tok) * D + col0;
#pragma unroll
                    for (int bj = 0; bj < 2; ++bj) { const f32x4 v0 = acc[ai][bj][m][0] * w, v1 = acc[ai][bj][m][1] * w;
                        v4u o; o.x = cvt_pk_bf16(v0[0], v0[1]); o.y = cvt_pk_bf16(v0[2], v0[3]); o.z = cvt_pk_bf16(v1[0], v1[1]); o.w = cvt_pk_bf16(v1[2], v1[3]);
                        *(v4u*)(rowp + bj * HALF) = o; } } }
    }
};
}
#define XB_TMO      128
#define XB_XCNT(j)  (256  + 64 * (j))
#define XB_XSUB(j)  (1280 + 64 * (j))
#define XB_XGEN(j)  (2304 + 64 * (j))
#define XB_TOP      3328
#define XB_TOPGEN   3392
#define XCD_BAR_WORDS 3456
#define XB_SPIN_CAP (1u << 18)
__device__ __forceinline__ unsigned xb_ld(unsigned* p)              { return __hip_atomic_load(p, __ATOMIC_RELAXED, __HIP_MEMORY_SCOPE_AGENT); }
__device__ __forceinline__ unsigned xb_add(unsigned* p, unsigned v) { return __hip_atomic_fetch_add(p, v, __ATOMIC_RELAXED, __HIP_MEMORY_SCOPE_AGENT); }
__device__ __forceinline__ unsigned xb_xcc_id() { return (unsigned)__builtin_amdgcn_s_getreg((3 << 11) | 20) & 0xFu; }
#define XB_SPIN(cond, bar) do { unsigned _sp = 0; while (cond) { __builtin_amdgcn_s_sleep(1); \
    if ((++_sp & 255u) == 0u) { if (xb_ld(&(bar)[XB_TMO])) break; if (_sp > XB_SPIN_CAP) { atomicAdd(&(bar)[XB_TMO], 1u); break; } } } } while (0)
struct XcdBarrier { unsigned* bar; unsigned x; volatile LAS unsigned* st; };
__device__ __forceinline__ XcdBarrier xcd_barrier_post(unsigned* bar, volatile LAS unsigned* st) {
    XcdBarrier b; b.bar = bar; b.x = xb_xcc_id(); b.st = st;
    if (threadIdx.x == 0) (void)xb_add(&bar[XB_XCNT(b.x)], 1u);
    return b;
}
__device__ __forceinline__ void xcd_barrier_complete(unsigned* bar, unsigned x, unsigned& nloc, unsigned& nx) {
    const unsigned G = gridDim.x * gridDim.y * gridDim.z;
    unsigned sum, cnt, mine, sp = 0u;
    for (;;) {
        sum = 0u; cnt = 0u; mine = 0u;
#pragma unroll
        for (unsigned j = 0; j < 16; ++j) { const unsigned c = xb_ld(&bar[XB_XCNT(j)]); sum += c; cnt += (c > 0u) ? 1u : 0u; mine = (j == x) ? c : mine; }
        if (sum == G) break;
        __builtin_amdgcn_s_sleep(1);
        if ((++sp & 255u) == 0u) { if (xb_ld(&bar[XB_TMO])) break; if (sp > XB_SPIN_CAP) { atomicAdd(&bar[XB_TMO], 1u); break; } }
    }
    nloc = mine > 0u ? mine : 1u; nx = cnt > 0u ? cnt : 1u;
}
__device__ __forceinline__ void xcd_barrier(const XcdBarrier& b) {
    asm volatile("s_waitcnt vmcnt(0)" ::: "memory");
    __syncthreads();
    if (threadIdx.x == 0) {
        unsigned* bar = b.bar;
        __builtin_amdgcn_s_waitcnt(0);
        unsigned nloc = b.st[0], nx = b.st[1];
        if (nloc == 0u) { xcd_barrier_complete(bar, b.x, nloc, nx); b.st[0] = nloc; b.st[1] = nx; }
        const unsigned old = xb_add(&bar[XB_XSUB(b.x)], 1u);
        const unsigned gen = old / nloc;
        if (old + 1u == (gen + 1u) * nloc) {
            __builtin_amdgcn_fence(__ATOMIC_RELEASE, "agent");
            asm volatile("s_waitcnt vmcnt(0)" ::: "memory");
            const unsigned og = xb_add(&bar[XB_TOP], 1u);
            const unsigned tg = og / nx;
            if (og + 1u == (tg + 1u) * nx) xb_add(&bar[XB_TOPGEN], 1u);
            else XB_SPIN(xb_ld(&bar[XB_TOPGEN]) == tg, bar);
            __builtin_amdgcn_fence(__ATOMIC_ACQUIRE, "agent");
            xb_add(&bar[XB_XGEN(b.x)], 1u);
            asm volatile("s_waitcnt vmcnt(0)" ::: "memory");
        } else {
            XB_SPIN(xb_ld(&bar[XB_XGEN(b.x)]) == gen, bar);
            __builtin_amdgcn_fence(__ATOMIC_ACQUIRE, "agent");
            asm volatile("s_waitcnt vmcnt(0)" ::: "memory");
        }
    }
    __syncthreads();
}

constexpr int NWAVES = 8;
constexpr size_t MiB = 1u << 20;
constexpr size_t WS_CTL = 0, CTL_ZERO_BYTES = 1 * MiB;
constexpr size_t WS_WIN = 2 * MiB, WS_WOUT = 8 * MiB, WS_S5IN = 10 * MiB, WS_GLU = 12 * MiB, WS_S5OUT = 16 * MiB, WS_PG = 18 * MiB, WS_MQ = 26 * MiB;
constexpr size_t WS_WGU = 40 * MiB, WS_WD = 104 * MiB;
constexpr size_t WS_XB = 136 * MiB, WS_H = 200 * MiB, WS_MASK = 376 * MiB, WS_O = 384 * MiB, WS_F1 = 448 * MiB, WS_END = 512 * MiB;
constexpr int CW_TMO = 0, CW_CODE = 1, CW_CNT = 2048  , CW_BAR = 4096;
constexpr size_t WS_TOKW = 512 * 1024  , WS_LIST = 38 * MiB  ;
constexpr size_t WS_HMID = 200 * MiB  , WS_CB = 268 * MiB  ;
constexpr int RING_OFF = 0, RING_BYTES = 131072, LDS_BYTES = 147456, LDSCTL_OFF = LDS_BYTES - 512, MISC_OFF = LDSCTL_OFF + 320;

struct Frame {
    LAS unsigned char* lds; volatile LAS unsigned* MISC; gu32* ctl;
    int tid, lane, wave, vcu, G;
};
struct Args { const float* in[30]; float* out; unsigned char* ws; int ph_lo, ph_hi, li, pad; };

__device__ __forceinline__ void tr_item(const float* __restrict__ W, int ldw, bf16* WT, int ldt, int k0, int c0, int nc, int r0, LAS float* scr, int lane) {
    f32x4 v[8];
#pragma unroll
    for (int i = 0; i < 8; ++i) { const int idx = lane + 64 * i, kk = idx >> 3, c4 = (idx & 7) * 4; v[i] = (c4 < nc) ? *(const GAS f32x4*)(W + (size_t)(k0 + kk) * ldw + c0 + c4) : (f32x4){0.f, 0.f, 0.f, 0.f}; }
#pragma unroll
    for (int i = 0; i < 8; ++i) { const int idx = lane + 64 * i, kk = idx >> 3, c4 = (idx & 7) * 4; LAS float* s = scr + kk * 33 + c4; s[0] = v[i].x; s[1] = v[i].y; s[2] = v[i].z; s[3] = v[i].w; }
    LDS_WAIT(); asm volatile("" ::: "memory");
    const int c = lane & 7;
#pragma unroll
    for (int j = 0; j < 4; ++j) { const int n = (lane >> 3) + 8 * j; const LAS float* s = scr + (8 * c) * 33 + n;
        v4u o; o.x = pk2(s[0 * 33], s[1 * 33]); o.y = pk2(s[2 * 33], s[3 * 33]); o.z = pk2(s[4 * 33], s[5 * 33]); o.w = pk2(s[6 * 33], s[7 * 33]);
        if (n < nc) *(GAS v4u*)(WT + (size_t)(r0 + n) * ldt + k0 + 8 * c) = o; }
    LDS_WAIT(); asm volatile("" ::: "memory");
}

struct TrDesc { const float* W; int ldw; bf16* WT; int ldt, k0, c0, nc, r0; };
__device__ __forceinline__ void tr_load(const TrDesc& d, f32x4 (&v)[8], int lane) {
#pragma unroll
    for (int i = 0; i < 8; ++i) { const int idx = lane + 64 * i, kk = idx >> 3, c4 = (idx & 7) * 4; v[i] = (c4 < d.nc) ? __builtin_nontemporal_load((const GAS f32x4*)(d.W + (size_t)(d.k0 + kk) * d.ldw + d.c0 + c4)) : (f32x4){0.f, 0.f, 0.f, 0.f}; }
}
__device__ __forceinline__ void tr_store(const TrDesc& d, const f32x4 (&v)[8], LAS float* scr, int lane) {
#pragma unroll
    for (int i = 0; i < 8; ++i) { const int idx = lane + 64 * i, kk = idx >> 3, c4 = (idx & 7) * 4; LAS float* s = scr + kk * 33 + c4; s[0] = v[i].x; s[1] = v[i].y; s[2] = v[i].z; s[3] = v[i].w; }
    LDS_WAIT(); asm volatile("" ::: "memory");
    const int c = lane & 7;
#pragma unroll
    for (int j = 0; j < 4; ++j) { const int n = (lane >> 3) + 8 * j; const LAS float* s = scr + (8 * c) * 33 + n;
        v4u o; o.x = pk2(s[0 * 33], s[1 * 33]); o.y = pk2(s[2 * 33], s[3 * 33]); o.z = pk2(s[4 * 33], s[5 * 33]); o.w = pk2(s[6 * 33], s[7 * 33]);
        if (n < d.nc) *(GAS v4u*)(d.WT + (size_t)(d.r0 + n) * d.ldt + d.k0 + 8 * c) = o; }
    LDS_WAIT(); asm volatile("" ::: "memory");
}
__device__ __forceinline__ int tr_seg_items(int K, int ncols) { return (K / 64) * ((ncols + 31) / 32); }
__device__ __forceinline__ void tr_seg(const float* W, int ldw, int K, int c0, int ncols, bf16* WT, int ldt, int r0, int it, LAS float* scr, int lane) {
    const int nblk = (ncols + 31) / 32, kb = it / nblk, nb = it % nblk; const int rem = ncols - nb * 32;
    tr_item(W, ldw, WT, ldt, kb * 64, c0 + nb * 32, rem < 32 ? rem : 32, r0 + nb * 32, scr, lane);
}
constexpr size_t WS_UPD = WS_F1, WS_DEC = WS_LIST;
constexpr size_t OUT_SPREV = 16 * MiB, OUT_OI = 48 * MiB;
constexpr int GP = 72;
#define MFMA32(a, b, c) __builtin_amdgcn_mfma_f32_32x32x16_bf16((a), (b), (c), 0, 0, 0)
__device__ __forceinline__ int crow(int reg, int h) { return (reg & 3) + 8 * (reg >> 2) + 4 * h; }
__device__ __forceinline__ f32x16 mma_tile64(const LAS bf16* A, const LAS bf16* Bt, int lane) {
    const int r = lane & 31, h = lane >> 5; f32x16 acc;
#pragma unroll
    for (int i = 0; i < 16; ++i) acc[i] = 0.f;
#pragma unroll
    for (int kk = 0; kk < 4; ++kk) { const bf16x8 a = *(const LAS bf16x8*)(A + r * GP + kk * 16 + 8 * h), b = *(const LAS bf16x8*)(Bt + r * GP + kk * 16 + 8 * h); acc = MFMA32(a, b, acc); }
    return acc;
}
constexpr int GLA1_HALF = 71168;
__device__ __forceinline__ void gla1_pair(Frame& F, const Args& a, int unit0) {
    const int hw = F.wave >> 2, wl = F.wave & 3, lt = F.tid & 255, lane = F.lane, unit = unit0 + hw;
    const int b = unit >> 7, n = (unit >> 2) & 31, h = unit & 3;
    const size_t tok0 = (size_t)b * SEQ + n * 64;
    const bf16* H = (const bf16*)(a.ws + WS_H);
    LAS unsigned char* L = F.lds + RING_OFF + hw * GLA1_HALF;
    LAS float* CUM = (LAS float*)L;
    LAS bf16* P = (LAS bf16*)L;
    LAS bf16* QD = (LAS bf16*)(L + 16640);
    LAS bf16* KI = (LAS bf16*)(L + 25856);
    LAS bf16* KET = (LAS bf16*)(L + 35072);
    LAS bf16* VT = (LAS bf16*)(L + 44288);
    LAS float* GW = (LAS float*)(L + 62720);
    LAS float* GB = (LAS float*)(L + 66816);
    LAS float* BG = (LAS float*)(L + 67072);
    const float* gw2 = a.in[3]; const float* gb = a.in[4];
#pragma unroll
    for (int k = 0; k < 4; ++k) { const int i = lt + 256 * k; GW[i] = gw2[(i >> 6) * 256 + h * 64 + (i & 63)]; BG[i] = bf2f(H[(tok0 + (i >> 4)) * HP + HC_BG + (i & 15)]); }
    if (lt < 64) GB[lt] = gb[h * 64 + lt];
    v4u qv[2], kv[2], vv[4];
#pragma unroll
    for (int k = 0; k < 2; ++k) { const int idx = lt + 256 * k, t = idx >> 3, d8 = (idx & 7) * 8; qv[k] = *(const GAS v4u*)(H + (tok0 + t) * HP + HC_BQ + h * 64 + d8); kv[k] = *(const GAS v4u*)(H + (tok0 + t) * HP + HC_BK + h * 64 + d8); }
#pragma unroll
    for (int k = 0; k < 4; ++k) { const int idx = lt + 256 * k, j = idx & 63, e8 = (idx >> 6) * 8; vv[k] = *(const GAS v4u*)(H + (tok0 + j) * HP + HC_BV + h * 128 + e8); }
    __syncthreads();
#pragma unroll 4
    for (int k = 0; k < 16; ++k) { const int idx = lt + 256 * k, t = idx >> 6, d = idx & 63; float z = GB[d];
#pragma unroll
        for (int r = 0; r < 16; ++r) z = fmaf(BG[t * 16 + r], GW[r * 64 + d], z);
        const float ls = -(fmaxf(-z, 0.f) + __logf(1.f + __expf(-fabsf(z)))); CUM[t * 65 + d] = ls * (1.f / 16.f); }
    __syncthreads();
    LAS float* OFF = GW;
    { const int seg = lt >> 6, d = lt & 63; float run = 0.f;
#pragma unroll
      for (int k = 0; k < 16; ++k) { const int t = 16 * seg + k; run += CUM[t * 65 + d]; CUM[t * 65 + d] = run; } }
    __syncthreads();
    { const int seg = lt >> 6, d = lt & 63; float off = 0.f;
#pragma unroll
      for (int s2 = 0; s2 < 3; ++s2) if (s2 < seg) off += CUM[(16 * s2 + 15) * 65 + d];
      OFF[seg * 64 + d] = off; }
    __syncthreads();
    bf16* QG = (bf16*)a.out;
#pragma unroll
    for (int k = 0; k < 2; ++k) { const int idx = lt + 256 * k, t = idx >> 3, d8 = (idx & 7) * 8; unsigned qo[4], ko[4]; const unsigned qw[4] = {qv[k].x, qv[k].y, qv[k].z, qv[k].w}, kw[4] = {kv[k].x, kv[k].y, kv[k].z, kv[k].w};
#pragma unroll
        for (int p2 = 0; p2 < 4; ++p2) { float qd[2], ki[2];
#pragma unroll
            for (int s = 0; s < 2; ++s) { const int d = d8 + 2 * p2 + s; const float c = CUM[t * 65 + d] + OFF[(t >> 4) * 64 + d], last = CUM[63 * 65 + d] + OFF[3 * 64 + d];
                const float q = (s ? __uint_as_float(qw[p2] & 0xffff0000u) : __uint_as_float(qw[p2] << 16)) * 0.125f, kk = s ? __uint_as_float(kw[p2] & 0xffff0000u) : __uint_as_float(kw[p2] << 16);
                qd[s] = q * __expf(c); ki[s] = kk * __expf(-c); KET[d * GP + t] = (bf16)f2bf(kk * __expf(last - c)); }
            qo[p2] = cvt2bf(qd[0], qd[1]); ko[p2] = cvt2bf(ki[0], ki[1]); }
        const v4u qq = (v4u){qo[0], qo[1], qo[2], qo[3]}; *(LAS v4u*)(QD + t * GP + d8) = qq; *(GAS v4u*)(QG + (tok0 + t) * 256 + h * 64 + d8) = qq; *(LAS v4u*)(KI + t * GP + d8) = (v4u){ko[0], ko[1], ko[2], ko[3]}; }
    if (lt < 64) ((float*)(a.ws + WS_DEC))[unit * 64 + lt] = __expf(CUM[63 * 65 + lt] + OFF[3 * 64 + lt]);
#pragma unroll
    for (int k = 0; k < 4; ++k) { const int idx = lt + 256 * k, j = idx & 63, e8 = (idx >> 6) * 8; const v4u v = vv[k];
        VT[(e8 + 0) * GP + j] = (bf16)(v.x & 0xffff); VT[(e8 + 1) * GP + j] = (bf16)(v.x >> 16); VT[(e8 + 2) * GP + j] = (bf16)(v.y & 0xffff); VT[(e8 + 3) * GP + j] = (bf16)(v.y >> 16);
        VT[(e8 + 4) * GP + j] = (bf16)(v.z & 0xffff); VT[(e8 + 5) * GP + j] = (bf16)(v.z >> 16); VT[(e8 + 6) * GP + j] = (bf16)(v.w & 0xffff); VT[(e8 + 7) * GP + j] = (bf16)(v.w >> 16); }
    __syncthreads();
    { const int ti = wl >> 1, tj = wl & 1, nn = lane & 31, hh = lane >> 5;
        if (tj <= ti) { const f32x16 c = mma_tile64(QD + 32 * ti * GP, KI + 32 * tj * GP, lane);
#pragma unroll
            for (int i = 0; i < 16; ++i) { const int qi = 32 * ti + crow(i, hh), kj = 32 * tj + nn; P[qi * GP + kj] = (bf16)f2bf(kj <= qi ? c[i] : 0.f); } }
        else {
#pragma unroll
            for (int i = 0; i < 16; ++i) P[(32 * ti + crow(i, hh)) * GP + 32 * tj + nn] = (bf16)0; } }
    __syncthreads();
    bf16* oi = (bf16*)((unsigned char*)a.out + OUT_OI); float* up = (float*)(a.ws + WS_UPD) + (size_t)unit * 8192;
#pragma unroll
    for (int k = 0; k < 2; ++k) { const int tile = wl * 2 + k, nn = lane & 31, hh = lane >> 5;
      { const int ti = tile >> 2, te = tile & 3;
        const f32x16 c = mma_tile64(P + 32 * ti * GP, VT + 32 * te * GP, lane);
#pragma unroll
        for (int i = 0; i < 16; ++i) oi[(tok0 + 32 * ti + crow(i, hh)) * 512 + h * 128 + 32 * te + nn] = (bf16)f2bf(c[i]); }
      { const int te = tile >> 1, td = tile & 1;
        const f32x16 c = mma_tile64(VT + 32 * te * GP, KET + 32 * td * GP, lane);
#pragma unroll
        for (int i = 0; i < 16; ++i) up[(32 * te + crow(i, hh)) * 64 + 32 * td + nn] = c[i]; } }
    __syncthreads();
}
__device__ __forceinline__ void gla2_scan(Frame& F, const Args& a) {
    const float* UPD = (const float*)(a.ws + WS_UPD); const float* DEC = (const float*)(a.ws + WS_DEC); bf16* SP = (bf16*)((unsigned char*)a.out + OUT_SPREV);
    for (int x = F.vcu * (NWAVES * 64) + F.tid; x < BATCH * 4 * 128 * 16; x += F.G * NWAVES * 64) {
        const int d4 = (x & 15) * 4, e = (x >> 4) & 127, bh = x >> 11, b = bh >> 2, h = bh & 3; f32x4 S = (f32x4){0.f, 0.f, 0.f, 0.f};
        for (int n0 = 0; n0 < 32; n0 += 8) { f32x4 u[8], dc[8];
#pragma unroll
            for (int k = 0; k < 8; ++k) { const int unit = b * 128 + (n0 + k) * 4 + h; u[k] = *(const GAS f32x4*)(UPD + (size_t)unit * 8192 + e * 64 + d4); dc[k] = *(const GAS f32x4*)(DEC + unit * 64 + d4); }
#pragma unroll
            for (int k = 0; k < 8; ++k) { const int unit = b * 128 + (n0 + k) * 4 + h; v2u o; o.x = pk2(S.x, S.y); o.y = pk2(S.z, S.w); *(GAS v2u*)(SP + (size_t)unit * 8192 + e * 64 + d4) = o; S = dc[k] * S + u[k]; } } }
}
constexpr int GLA3_HALF = 61440;
__device__ __forceinline__ void gla3_pair(Frame& F, const Args& a, int unit0) {
    const int hw = F.wave >> 2, wl = F.wave & 3, lt = F.tid & 255, lane = F.lane, unit = unit0 + hw;
    const int b = unit >> 7, n = (unit >> 2) & 31, h = unit & 3;
    const size_t tok0 = (size_t)b * SEQ + n * 64;
    const bf16* H = (const bf16*)(a.ws + WS_H); const bf16* SP = (const bf16*)((const unsigned char*)a.out + OUT_SPREV) + (size_t)unit * 8192; const bf16* oi = (const bf16*)((const unsigned char*)a.out + OUT_OI);
    LAS unsigned char* L = F.lds + RING_OFF + hw * GLA3_HALF;
    LAS bf16* QD = (LAS bf16*)L;
    LAS bf16* ST = (LAS bf16*)(L + 9216);
    LAS float* OF = (LAS float*)(L + 27648);
    const int nn = lane & 31, hh = lane >> 5;
    v4u qreg[2], sreg[4]; bf16 oiv[2][16]; unsigned short brv[16][2];
#pragma unroll
    for (int k = 0; k < 2; ++k) { const int idx = lt + 256 * k, t = idx >> 3, d8 = (idx & 7) * 8; qreg[k] = *(const GAS v4u*)((const bf16*)a.out + (tok0 + t) * 256 + h * 64 + d8); }
#pragma unroll
    for (int k = 0; k < 4; ++k) { const int idx = lt + 256 * k, e = idx >> 3, d8 = (idx & 7) * 8; sreg[k] = *(const GAS v4u*)(SP + e * 64 + d8); }
#pragma unroll
    for (int k = 0; k < 2; ++k) { const int tile = wl * 2 + k, ti = tile >> 2, te = tile & 3;
#pragma unroll
        for (int i = 0; i < 16; ++i) oiv[k][i] = oi[(tok0 + 32 * ti + crow(i, hh)) * 512 + h * 128 + 32 * te + nn]; }
#pragma unroll
    for (int rr = 0; rr < 16; ++rr) { const bf16* br = H + (tok0 + wl * 16 + rr) * HP + HC_BR + h * 128; brv[rr][0] = br[lane]; brv[rr][1] = br[lane + 64]; }
    const float* ng = a.in[5]; const float ng0 = ng[h * 128 + lane], ng1 = ng[h * 128 + lane + 64];
#pragma unroll
    for (int k = 0; k < 2; ++k) { const int idx = lt + 256 * k, t = idx >> 3, d8 = (idx & 7) * 8; *(LAS v4u*)(QD + t * GP + d8) = qreg[k]; }
#pragma unroll
    for (int k = 0; k < 4; ++k) { const int idx = lt + 256 * k, e = idx >> 3, d8 = (idx & 7) * 8; *(LAS v4u*)(ST + e * GP + d8) = sreg[k]; }
    __syncthreads();
#pragma unroll
    for (int k = 0; k < 2; ++k) { const int tile = wl * 2 + k, ti = tile >> 2, te = tile & 3;
      const f32x16 c = mma_tile64(QD + 32 * ti * GP, ST + 32 * te * GP, lane);
#pragma unroll
      for (int i = 0; i < 16; ++i) { const int r = 32 * ti + crow(i, hh), e = 32 * te + nn; OF[r * 132 + e] = c[i] + bf2f(oiv[k][i]); } }
    __syncthreads();
    bf16* O = (bf16*)(a.ws + WS_O);
#pragma unroll
    for (int rr = 0; rr < 16; ++rr) { const int r = wl * 16 + rr; const float x0 = OF[r * 132 + lane], x1 = OF[r * 132 + lane + 64];
        const float mean = wsum(x0 + x1) * (1.f / 128.f), d0 = x0 - mean, d1 = x1 - mean, var = wsum(d0 * d0 + d1 * d1) * (1.f / 128.f), rs = 1.f / sqrtf(var + LN_EPS);
        const float r0 = bf2f(brv[rr][0]), r1 = bf2f(brv[rr][1]);
        bf16* o = O + (tok0 + r) * D + 512 + h * 128;
        o[lane] = (bf16)f2bf(d0 * rs * ng0 * (r0 / (1.f + __expf(-r0)))); o[lane + 64] = (bf16)f2bf(d1 * rs * ng1 * (r1 / (1.f + __expf(-r1)))); }
    __syncthreads();
}
constexpr int SCP = 2048 + 16;
__device__ __forceinline__ unsigned fkey(float f) { const unsigned u = __float_as_uint(f); return (u & 0x80000000u) ? ~u : (u | 0x80000000u); }
__device__ __forceinline__ int wave_sum_dpp(int x) {
    x += __builtin_amdgcn_update_dpp(0, x, 0xB1, 0xF, 0xF, true);
    x += __builtin_amdgcn_update_dpp(0, x, 0x4E, 0xF, 0xF, true);
    x += __builtin_amdgcn_update_dpp(0, x, 0x141, 0xF, 0xF, true);
    x += __builtin_amdgcn_update_dpp(0, x, 0x140, 0xF, 0xF, true);
    x += __builtin_amdgcn_update_dpp(0, x, 0x142, 0xA, 0xF, false);
    x += __builtin_amdgcn_update_dpp(0, x, 0x143, 0xC, 0xF, false);
    return __builtin_amdgcn_readlane(x, 63);
}
#define CNT4(OP, a0, a1, a2, a3, k0, k1, k2, k3, c) do { unsigned long long _m0, _m1, _m2, _m3; \
    asm volatile("v_cmp_" OP "_u32_e64 %4, %8, %12\n\tv_cmp_" OP "_u32_e64 %5, %9, %12\n\tv_cmp_" OP "_u32_e64 %6, %10, %12\n\tv_cmp_" OP "_u32_e64 %7, %11, %12\n\t" \
                 "v_addc_co_u32_e64 %0, %4, 0, %0, %4\n\tv_addc_co_u32_e64 %1, %5, 0, %1, %5\n\tv_addc_co_u32_e64 %2, %6, 0, %2, %6\n\tv_addc_co_u32_e64 %3, %7, 0, %3, %7" \
                 : "+v"(a0), "+v"(a1), "+v"(a2), "+v"(a3), "=&s"(_m0), "=&s"(_m1), "=&s"(_m2), "=&s"(_m3) : "v"(k0), "v"(k1), "v"(k2), "v"(k3), "v"(c)); } while (0)
template <int NCH> __device__ __forceinline__ unsigned topk_search(const unsigned (&key)[32], bool& exact) {
    unsigned K = 0u; exact = false;
#pragma unroll 1
    for (int bit = 31; bit >= 0; --bit) { const unsigned cand = K | (1u << bit); int a0 = 0, a1 = 0, a2 = 0, a3 = 0;
#pragma unroll
        for (int c = 0; c < NCH; ++c) CNT4("ge", a0, a1, a2, a3, key[4 * c], key[4 * c + 1], key[4 * c + 2], key[4 * c + 3], cand);
        const int cnt = wave_sum_dpp((a0 + a1) + (a2 + a3));
        if (cnt >= 256) { K = cand; if (cnt == 256) { exact = true; break; } } }
    return K;
}
template <int NCH> __device__ __forceinline__ int count_gt(const unsigned (&key)[32], unsigned K) { int a0 = 0, a1 = 0, a2 = 0, a3 = 0;
#pragma unroll
    for (int c = 0; c < NCH; ++c) CNT4("gt", a0, a1, a2, a3, key[4 * c], key[4 * c + 1], key[4 * c + 2], key[4 * c + 3], K);
    return wave_sum_dpp((a0 + a1) + (a2 + a3)); }
struct Dsa1Ops { bf16x8 af[4][2]; float wq[4][4]; };
__device__ __forceinline__ void dsa1_load(Frame& F, const Args& a, int b, int qt, Dsa1Ops& o) {
    const int lane = F.lane, fr = lane & 15, fq = lane >> 4, t0 = qt * 16;
    const bf16* H = (const bf16*)(a.ws + WS_H) + (size_t)b * SEQ * HP;
#pragma unroll
    for (int qg = 0; qg < 4; ++qg) {
#pragma unroll
        for (int kk = 0; kk < 2; ++kk) o.af[qg][kk] = *(const GAS bf16x8*)(H + (size_t)(t0 + qg * 4 + (fr >> 2)) * HP + HC_IQ + (fr & 3) * 64 + kk * 32 + fq * 8);
        const v2u wv = *(const GAS v2u*)(H + (size_t)(t0 + qg * 4 + fq) * HP + HC_IW);
        o.wq[qg][0] = __uint_as_float(wv.x << 16); o.wq[qg][1] = __uint_as_float(wv.x & 0xffff0000u); o.wq[qg][2] = __uint_as_float(wv.y << 16); o.wq[qg][3] = __uint_as_float(wv.y & 0xffff0000u); }
}
__device__ __forceinline__ void dsa1_unit(Frame& F, const Args& a, int b, int qt, Dsa1Ops& cur, int nb, int nqt) {
    const int lane = F.lane, w = F.wave, fr = lane & 15, fq = lane >> 4, t0 = qt * 16;
    const bf16* H = (const bf16*)(a.ws + WS_H) + (size_t)b * SEQ * HP;
    LAS float* SC = (LAS float*)(F.lds + RING_OFF);
    const int nkb = qt + 1, nmine = (nkb - w + 7) >> 3;
    STAMP_T0(210, _t210);
    LAS unsigned* SK = (LAS unsigned*)SC;
    bf16x8 bA[4][2], bB[4][2];
#define DSA1_LOADB(dst, i0) do { _Pragma("unroll") for (int u = 0; u < 4; ++u) if ((i0) + u < nmine) { const int kb = w + 8 * ((i0) + u); \
        _Pragma("unroll") for (int kk = 0; kk < 2; ++kk) dst[u][kk] = *(const GAS bf16x8*)(H + (size_t)(kb * 16 + fr) * HP + HC_IK + kk * 32 + fq * 8); } } while (0)
#define DSA1_MMAB(src, i0) do { _Pragma("unroll") for (int u = 0; u < 4; ++u) if ((i0) + u < nmine) { const int kb = w + 8 * ((i0) + u), s = kb * 16 + fr; \
        _Pragma("unroll") for (int qg = 0; qg < 4; ++qg) { f32x4 c = (f32x4){0.f, 0.f, 0.f, 0.f}; \
            c = __builtin_amdgcn_mfma_f32_16x16x32_bf16(cur.af[qg][0], src[u][0], c, 0, 0, 0); c = __builtin_amdgcn_mfma_f32_16x16x32_bf16(cur.af[qg][1], src[u][1], c, 0, 0, 0); \
            float sc = 0.f; _Pragma("unroll") for (int i = 0; i < 4; ++i) sc += cur.wq[qg][i] * fmaxf(c[i], 0.f); \
            SK[(qg * 4 + fq) * SCP + s] = (s <= t0 + qg * 4 + fq) ? fkey(sc) : 0u; } } } while (0)
    DSA1_LOADB(bA, 0);
#pragma unroll 1
    for (int i0 = 0; i0 < nmine; i0 += 8) {
        DSA1_LOADB(bB, i0 + 4); DSA1_MMAB(bA, i0);
        DSA1_LOADB(bA, i0 + 8); DSA1_MMAB(bB, i0 + 4);
    }
#undef DSA1_LOADB
#undef DSA1_MMAB
    __syncthreads();
    STAMP_END_PUB(210, _t210, F.ctl, 37, (float)(STAMP_SCALE)); STAMP_T0(211, _t211);
    if (nb >= 0) dsa1_load(F, a, nb, nqt, cur);
    unsigned long long* MASK = (unsigned long long*)(a.ws + WS_MASK);
    for (int _rp = 0; _rp < (PROBE == 23 ? 2 : 1); ++_rp)
#pragma unroll 1
    for (int rr = 0; rr < 2; ++rr) { const int r = w + 8 * rr, t = t0 + r, jmax = t >> 6, nch = (jmax >> 2) + 1;
        STAMP_T0(212, _t212);
        unsigned key[32];
#pragma unroll
        for (int c = 0; c < 8; ++c) {
            if (c < nch) {
#pragma unroll
                for (int jj = 0; jj < 4; ++jj) { const int s = (c * 4 + jj) * 64 + lane; const unsigned kv = SK[r * SCP + s]; key[c * 4 + jj] = (s <= t) ? kv : 0u; } }
            else {
#pragma unroll
                for (int jj = 0; jj < 4; ++jj) key[c * 4 + jj] = 0u; } }
        STAMP_END_PUB(212, _t212, F.ctl, 37, (float)(STAMP_SCALE));
        unsigned long long mine = 0ull;
        if (t < 256) {
#pragma unroll
            for (int j = 0; j < 4; ++j) { const unsigned long long bm = __ballot(j * 64 + lane <= t); if (lane == j) mine = bm; }
        } else {
            unsigned K; bool exact; int cgt = 0;
            STAMP_T0(213, _t213);
            switch (nch) {
                case 1: K = topk_search<1>(key, exact); if (!exact) cgt = count_gt<1>(key, K); break;
                case 2: K = topk_search<2>(key, exact); if (!exact) cgt = count_gt<2>(key, K); break;
                case 3: K = topk_search<3>(key, exact); if (!exact) cgt = count_gt<3>(key, K); break;
                case 4: K = topk_search<4>(key, exact); if (!exact) cgt = count_gt<4>(key, K); break;
                case 5: K = topk_search<5>(key, exact); if (!exact) cgt = count_gt<5>(key, K); break;
                case 6: K = topk_search<6>(key, exact); if (!exact) cgt = count_gt<6>(key, K); break;
                case 7: K = topk_search<7>(key, exact); if (!exact) cgt = count_gt<7>(key, K); break;
                default: K = topk_search<8>(key, exact); if (!exact) cgt = count_gt<8>(key, K); break;
            }
            STAMP_END_PUB(213, _t213, F.ctl, 37, (float)(STAMP_SCALE)); STAMP_T0(214, _t214);
            const int quota = 256 - cgt; int taken = 0; unsigned mlo = 0u, mhi = 0u;
#pragma unroll
            for (int j = 0; j < 32; ++j) if (j <= jmax) {
                unsigned long long bm;
                if (exact) bm = __ballot(key[j] >= K);
                else { const unsigned long long eq = __ballot(key[j] == K); const int pre = __builtin_amdgcn_mbcnt_hi((unsigned)(eq >> 32), __builtin_amdgcn_mbcnt_lo((unsigned)eq, 0u));
                       bm = __ballot(key[j] > K || (key[j] == K && taken + pre < quota)); taken += __builtin_popcountll(eq); }
                asm volatile("v_writelane_b32 %0, %2, %4\n\tv_writelane_b32 %1, %3, %4" : "+v"(mlo), "+v"(mhi) : "s"((unsigned)bm), "s"((unsigned)(bm >> 32)), "n"(j)); }
            mine = ((unsigned long long)mhi << 32) | mlo;
            STAMP_END_PUB(214, _t214, F.ctl, 37, (float)(STAMP_SCALE));
        }
        if (lane < 32) MASK[((size_t)b * SEQ + t) * 32 + lane] = mine; }
    STAMP_END_PUB(211, _t211, F.ctl, 37, (float)(STAMP_SCALE));
    __syncthreads();
}

constexpr float LOG2E = 1.4426950408889634f, SCL2 = 0.125f * 1.4426950408889634f;
__device__ __forceinline__ bf16x8 pack_step(const f32x16& x, int s) {
    v4u p;
    asm volatile("v_cvt_pk_bf16_f32 %0, %4, %5\n\tv_cvt_pk_bf16_f32 %1, %6, %7\n\tv_cvt_pk_bf16_f32 %2, %8, %9\n\tv_cvt_pk_bf16_f32 %3, %10, %11\n\ts_nop 1"
                 : "=&v"(p[0]), "=&v"(p[1]), "=&v"(p[2]), "=&v"(p[3])
                 : "v"(x[8 * s]), "v"(x[8 * s + 1]), "v"(x[8 * s + 2]), "v"(x[8 * s + 3]), "v"(x[8 * s + 4]), "v"(x[8 * s + 5]), "v"(x[8 * s + 6]), "v"(x[8 * s + 7]));
    return __builtin_bit_cast(bf16x8, p);
}
__device__ __forceinline__ void dsa2_unit(Frame& F, const Args& a, int b, int g, int qb) {
    const int tid = F.tid, lane = F.lane, w = F.wave, n = lane & 31, h = lane >> 5, hl = w >> 1, hh = g * 4 + hl, t0 = qb * 64, tq0 = t0 + 32 * (w & 1);
    const bf16* H = (const bf16*)(a.ws + WS_H) + (size_t)b * SEQ * HP;
    const unsigned long long* MW = (const unsigned long long*)(a.ws + WS_MASK) + ((size_t)b * SEQ + tq0 + n) * 32;
    LAS unsigned char* L = F.lds + RING_OFF;
    LAS float* BT = (LAS float*)(L + 55296);
    LAS bf16* OS = (LAS bf16*)(L + 57344 + w * 4608);
    const float* relb = a.in[1];
    BT[tid] = relb[T5B[tid & 127] * 8 + g * 4 + (tid >> 7)] * LOG2E;
    const float B31 = relb[31 * 8 + hh] * LOG2E;
    bf16x8 Qf[4];
#pragma unroll
    for (int kk = 0; kk < 4; ++kk) Qf[kk] = *(const GAS bf16x8*)(H + (size_t)(tq0 + n) * HP + HC_AQ + hh * 64 + kk * 16 + 8 * h);
    f32x16 O[2];
#pragma unroll
    for (int i = 0; i < 16; ++i) { O[0][i] = 0.f; O[1][i] = 0.f; }
    float m = -1e30f, lsum = 0.f;
    const int krow = tid >> 3, kc8 = (tid & 7) * 8, vrow = tid & 63, vc8 = (tid >> 6) * 8, nt = qb + 1;
    v4u kreg, vreg;
#define DSA_LOADT(kt) do { kreg = *(const GAS v4u*)(H + (size_t)((kt) * 64 + krow) * HP + HC_AK + g * 64 + kc8); vreg = *(const GAS v4u*)(H + (size_t)((kt) * 64 + vrow) * HP + HC_AV + g * 64 + vc8); } while (0)
#define DSA_WRITET(bu) do { LAS bf16* _ks = (LAS bf16*)(L + (bu) * 18432); LAS bf16* _vt = (LAS bf16*)(L + (bu) * 18432 + 9216); *(LAS v4u*)(_ks + krow * GP + kc8) = kreg; \
        _vt[(vc8 + 0) * GP + vrow] = (bf16)(vreg.x & 0xffff); _vt[(vc8 + 1) * GP + vrow] = (bf16)(vreg.x >> 16); _vt[(vc8 + 2) * GP + vrow] = (bf16)(vreg.y & 0xffff); _vt[(vc8 + 3) * GP + vrow] = (bf16)(vreg.y >> 16); \
        _vt[(vc8 + 4) * GP + vrow] = (bf16)(vreg.z & 0xffff); _vt[(vc8 + 5) * GP + vrow] = (bf16)(vreg.z >> 16); _vt[(vc8 + 6) * GP + vrow] = (bf16)(vreg.w & 0xffff); _vt[(vc8 + 7) * GP + vrow] = (bf16)(vreg.w >> 16); } while (0)
#define DSA_QK(Sd, bu) do { const LAS bf16* _ks = (const LAS bf16*)(L + (bu) * 18432); _Pragma("unroll") for (int sb = 0; sb < 2; ++sb) { _Pragma("unroll") for (int i = 0; i < 16; ++i) Sd[sb][i] = 0.f; \
        _Pragma("unroll") for (int kk = 0; kk < 4; ++kk) { const bf16x8 ka = *(const LAS bf16x8*)(_ks + (32 * sb + n) * GP + kk * 16 + 8 * h); Sd[sb] = MFMA32(ka, Qf[kk], Sd[sb]); } } } while (0)
    DSA_LOADT(0); DSA_WRITET(0);
    if (nt > 1) { DSA_LOADT(1); DSA_WRITET(1); }
    if (nt > 2) DSA_LOADT(2);
    unsigned long long mw = MW[0];
    __syncthreads();
#define DSA_MASK(p, wsh, pos) do { int _t; asm volatile("v_bfe_i32 %1, %2, %3, 1\n\tv_and_b32 %0, %0, %1" : "+v"(p), "=&v"(_t) : "v"(wsh), "n"(pos)); } while (0)
#define DSA_TILE(Sc, Sn, kt) do { STAMP_BEGIN(1); STAMP_BEGIN(2); \
        const int s1 = slot == 2 ? 0 : slot + 1, s2 = s1 == 2 ? 0 : s1 + 1; \
        if ((kt) + 2 < nt) DSA_WRITET(s2); \
        if ((kt) + 3 < nt) DSA_LOADT((kt) + 3); \
        const unsigned long long mwn = ((kt) + 1 < nt) ? MW[(kt) + 1] : 0ull; \
        if ((kt) + 1 < nt) DSA_QK(Sn, s1); \
        STAMP_END(2); STAMP_BEGIN(3); \
        const LAS bf16* VT = (const LAS bf16*)(L + slot * 18432 + 9216); \
        const unsigned wsh0 = (unsigned)mw >> (4 * h), wsh1 = (unsigned)(mw >> 32) >> (4 * h); \
        float mx = -1e30f; \
        if ((kt) < qb - 2) {     \
            _Pragma("unroll") for (int sb = 0; sb < 2; ++sb) _Pragma("unroll") for (int i = 0; i < 16; ++i) { Sc[sb][i] = fmaf(Sc[sb][i], SCL2, B31); mx = fmaxf(mx, Sc[sb][i]); } \
        } else { const int dbase = tq0 + n - (kt) * 64 - 4 * h; \
            _Pragma("unroll") for (int sb = 0; sb < 2; ++sb) _Pragma("unroll") for (int i = 0; i < 16; ++i) { int dist = dbase - (32 * sb + (i & 3) + 8 * (i >> 2)); dist = dist < 0 ? 0 : (dist > 127 ? 127 : dist); \
                Sc[sb][i] = fmaf(Sc[sb][i], SCL2, BT[hl * 128 + dist]); mx = fmaxf(mx, Sc[sb][i]); } } \
        mx = xhalf_max(mx); \
        const float mn = fmaxf(m, mx); \
        if (__any(mn > m)) { const float al = __builtin_amdgcn_exp2f(m - mn); _Pragma("unroll") for (int i = 0; i < 16; ++i) { O[0][i] *= al; O[1][i] *= al; } lsum *= al; } \
        m = mn; \
        _Pragma("unroll") for (int i = 0; i < 16; ++i) { float p0 = __builtin_amdgcn_exp2f(Sc[0][i] - m), p1 = __builtin_amdgcn_exp2f(Sc[1][i] - m); \
            DSA_MASK(p0, wsh0, (i & 3) + 8 * (i >> 2)); DSA_MASK(p1, wsh1, (i & 3) + 8 * (i >> 2)); Sc[0][i] = p0; Sc[1][i] = p1; lsum += p0 + p1; } \
        STAMP_END(3); STAMP_BEGIN(4); \
        _Pragma("unroll") for (int sb = 0; sb < 2; ++sb) _Pragma("unroll") for (int s = 0; s < 2; ++s) { const bf16x8 pf = pack_step(Sc[sb], s); \
            _Pragma("unroll") for (int db = 0; db < 2; ++db) { const LAS bf16* vp = VT + (32 * db + n) * GP + 32 * sb + 16 * s + 4 * h; \
                const bf16x4 lo = *(const LAS bf16x4*)vp, hi = *(const LAS bf16x4*)(vp + 8); \
                const bf16x8 vf = __builtin_shufflevector(lo, hi, 0, 1, 2, 3, 4, 5, 6, 7); O[db] = MFMA32(vf, pf, O[db]); } } \
        mw = mwn; slot = s1; STAMP_END(4); STAMP_BEGIN(5); \
        asm volatile("s_waitcnt lgkmcnt(0)" ::: "memory"); __builtin_amdgcn_s_barrier(); asm volatile("" ::: "memory"); STAMP_END(5); STAMP_END(1); } while (0)
    STAMP_DECL;
    f32x16 SA[2], SB[2];
    DSA_QK(SA, 0);
    int slot = 0;
#pragma unroll 1
    for (int kt = 0; kt < nt; kt += 2) {
        DSA_TILE(SA, SB, kt);
        if (kt + 1 < nt) DSA_TILE(SB, SA, kt + 1);
    }
#undef DSA_TILE
#undef DSA_MASK
    STAMP_PUBLISH(F.ctl, 37, 1.0f / 100000.f);
#undef DSA_LOADT
#undef DSA_WRITET
#undef DSA_QK
    const float lt = xhalf_sum(lsum), inv = 1.f / lt;
#pragma unroll
    for (int db = 0; db < 2; ++db)
#pragma unroll
        for (int i = 0; i < 16; ++i) OS[n * GP + 32 * db + crow(i, h)] = (bf16)f2bf(O[db][i] * inv);
    asm volatile("s_waitcnt lgkmcnt(0)" ::: "memory");
    bf16* Og = (bf16*)(a.ws + WS_O) + ((size_t)b * SEQ + tq0) * D + hh * 64;
#pragma unroll
    for (int k = 0; k < 4; ++k) { const int idx = lane + 64 * k, row = idx >> 3, c8 = (idx & 7) * 8; *(GAS v4u*)(Og + (size_t)row * D + c8) = *(const LAS v4u*)(OS + row * GP + c8); }
    __syncthreads();
}
#define CONV_MOE 1
__device__ __forceinline__ void s5_build_group(Frame& F, const Args& a, int g, int part, LAS unsigned char* base) {
    LAS f32x2* AP = (LAS f32x2*)base;
    LAS f32x2* BB = (LAS f32x2*)(base + 8704);
    LAS f32x2* CC = (LAS f32x2*)(base + 8704 + 8192);
    LAS float* KT = (LAS float*)(base + 8704 + 16384);
    const float* lam_re = a.in[8]; const float* lam_im = a.in[9]; const float* log_dt = a.in[10];
    const float* b_re = a.in[11]; const float* b_im = a.in[12]; const float* c_re = a.in[13]; const float* c_im = a.in[14]; const float* dsk = a.in[15];
    const int tid = F.tid;
    if (tid < 64) { const int p = tid;
        const float lr = fminf(lam_re[g * 64 + p], -1e-4f), li = lam_im[g * 64 + p], dt = expf(log_dt[g]);
        const float mag = expf(lr * dt), are = mag * cosf(li * dt), aim = mag * sinf(li * dt);
        const float den = lr * lr + li * li, nr = are - 1.f, cre = (nr * lr + aim * li) / den, cim = (aim * lr - nr * li) / den;
        float pr = 1.f, pi = 0.f;
        for (int m = 0; m <= 16; ++m) { AP[m * 64 + p] = (f32x2){pr, pi}; const float t = pr * are - pi * aim; pi = pr * aim + pi * are; pr = t; }
        for (int c = 0; c < 16; ++c) { const float br = b_re[(g * 64 + p) * 16 + c], bi = b_im[(g * 64 + p) * 16 + c]; BB[p * 16 + c] = (f32x2){cre * br - cim * bi, cre * bi + cim * br}; }
    }
    for (int e = tid; e < 1024; e += NWAVES * 64) CC[e] = (f32x2){c_re[g * 1024 + e], c_im[g * 1024 + e]};
    __syncthreads();
    for (int e = tid; e < 4096; e += NWAVES * 64) { const int m = e >> 8, c = (e >> 4) & 15, c2 = e & 15; float acc = 0.f;
        for (int p = 0; p < 64; ++p) { const f32x2 cc = CC[c * 64 + p], ap = AP[m * 64 + p], bb = BB[p * 16 + c2];
            const float tr = cc.x * ap.x - cc.y * ap.y, ti = cc.x * ap.y + cc.y * ap.x; acc += tr * bb.x - ti * bb.y; }
        KT[e] = acc; }
    __syncthreads();
    bf16* MQ = (bf16*)(a.ws + WS_MQ) + (size_t)g * 256 * 384; bf16* PG = (bf16*)(a.ws + WS_PG) + (size_t)g * 256 * 256;
    for (int v = tid; v < 64 * 48; v += NWAVES * 64) { const int row = 64 * part + v / 48, cv = v % 48, j = row >> 4, c = row & 15, col0 = cv * 8; float val[8];
        if (col0 < 256) { const int i = col0 >> 4, c20 = col0 & 15;
#pragma unroll
            for (int q = 0; q < 8; ++q) { float t = (i <= j) ? KT[((j - i) << 8) + (c << 4) + c20 + q] : 0.f; if (i == j && c == c20 + q) t += dsk[g * 16 + c]; val[q] = t; } }
        else { const int p0 = (col0 - 256) & 63; const bool im = (col0 - 256) >= 64;
#pragma unroll
            for (int q = 0; q < 8; ++q) { const f32x2 cc = CC[c * 64 + p0 + q], ap = AP[(j + 1) * 64 + p0 + q]; val[q] = im ? -(cc.x * ap.y + cc.y * ap.x) : (cc.x * ap.x - cc.y * ap.y); } }
        v4u o; o.x = pk2(val[0], val[1]); o.y = pk2(val[2], val[3]); o.z = pk2(val[4], val[5]); o.w = pk2(val[6], val[7]);
        *(GAS v4u*)(MQ + (size_t)row * 384 + col0) = o; }
    for (int v = tid; v < 64 * 32; v += NWAVES * 64) { const int row = 64 * part + (v >> 5), col0 = (v & 31) * 8, i = col0 >> 4, c20 = col0 & 15; float val[8];
        if (row < 128) { const int p = row & 63; const bool im = row >= 64; const f32x2 ap = AP[(15 - i) * 64 + p];
#pragma unroll
            for (int q = 0; q < 8; ++q) { const f32x2 bb = BB[p * 16 + c20 + q]; val[q] = im ? (ap.x * bb.y + ap.y * bb.x) : (ap.x * bb.x - ap.y * bb.y); } }
        else {
#pragma unroll
            for (int q = 0; q < 8; ++q) val[q] = 0.f; }
        v4u o; o.x = pk2(val[0], val[1]); o.y = pk2(val[2], val[3]); o.z = pk2(val[4], val[5]); o.w = pk2(val[6], val[7]);
        *(GAS v4u*)(PG + (size_t)row * 256 + col0) = o; }
    __syncthreads();
}
__device__ __forceinline__ void s5_scan_local(Frame& F, const Args& a) {
    const float* lam_re = a.in[8]; const float* lam_im = a.in[9]; const float* log_dt = a.in[10];
    bf16* UA = (bf16*)(a.ws + WS_H); const float* Z = (const float*)(a.ws + WS_H + 96 * MiB);
    const int p = F.lane, nun = (512 - F.vcu + F.G - 1) / F.G;
    for (int q = F.wave; q < 2 * nun; q += NWAVES) { const int L = (q >> 1) * F.G + F.vcu, g = L >> 3, b = 2 * (L & 7) + (q & 1);
        const float lr = fminf(lam_re[g * 64 + p], -1e-4f), li = lam_im[g * 64 + p], dt = expf(log_dt[g]);
        const float mag = expf(lr * dt); float ar = mag * cosf(li * dt), ai = mag * sinf(li * dt);
#pragma unroll
        for (int k = 0; k < 4; ++k) { const float t = ar * ar - ai * ai; ai = 2.f * ar * ai; ar = t; }
        float sr = 0.f, si = 0.f;
        const float* zp = Z + ((size_t)(g * 2048 + b * 128)) * 128 + p; bf16* up = UA + ((size_t)(g * 2048 + b * 128)) * 384 + 256 + p;
        for (int n0 = 0; n0 < 128; n0 += 16) { float zr[16], zi[16];
#pragma unroll
            for (int k = 0; k < 16; ++k) { zr[k] = zp[(size_t)(n0 + k) * 128]; zi[k] = zp[(size_t)(n0 + k) * 128 + 64]; }
#pragma unroll
            for (int k = 0; k < 16; ++k) { up[(size_t)(n0 + k) * 384] = (bf16)f2bf(sr); up[(size_t)(n0 + k) * 384 + 64] = (bf16)f2bf(si);
                const float t = ar * sr - ai * si + zr[k]; si = ar * si + ai * sr + zi[k]; sr = t; } } }
}
template <int COMB, bool ROUTE, bool F32OUT>
__device__ __forceinline__ void ln_phase(Frame& F, const bf16* src, const bf16* cb, const float* gamma, const float* beta, float* dst, bf16* dstb,
                                         const float* rc, const float* rbc, const float* rf, const float* rbf, unsigned* cnt, int* list, float* tokw) {
    const int gw = F.vcu * NWAVES + F.wave, NGW = F.G * NWAVES, lane = F.lane;
    f32x4 gv[4], bv[4];
#pragma unroll
    for (int j = 0; j < 4; ++j) { gv[j] = ((const GAS f32x4*)gamma)[lane + 64 * j]; bv[j] = ((const GAS f32x4*)beta)[lane + 64 * j]; }
    volatile LAS unsigned* RT = (volatile LAS unsigned*)(F.lds + RING_OFF);
    int lrow = F.wave * 16;
    f32x4 rcv[16];
    LAS f32x4* RF = (LAS f32x4*)(F.lds + RING_OFF + 4096);
    if (ROUTE) { if (F.tid < 16) RT[F.tid] = 0u;
#pragma unroll
        for (int j = 0; j < 4; ++j)
#pragma unroll
            for (int q = 0; q < 4; ++q) rcv[j * 4 + q] = *(const GAS f32x4*)(rc + (size_t)(256 * j + 4 * lane + q) * 4);
        for (int i = F.tid; i < 4096; i += NWAVES * 64) RF[i] = ((const GAS f32x4*)rf)[i];
        __syncthreads(); }
    v2u nx[4], na[4], nb[4];
    { const GAS v2u* xr = (const GAS v2u*)(src + (size_t)gw * D) + lane;
#pragma unroll
      for (int j = 0; j < 4; ++j) nx[j] = xr[64 * j];
      if (COMB == 1) { const GAS v2u* c0 = (const GAS v2u*)(cb + (size_t)gw * D) + lane; const GAS v2u* c1 = (const GAS v2u*)(cb + ((size_t)NTOK + gw) * D) + lane;
#pragma unroll
          for (int j = 0; j < 4; ++j) { na[j] = c0[64 * j]; nb[j] = c1[64 * j]; } }
      if (COMB == 2) { const GAS v2u* c0 = (const GAS v2u*)(cb + (size_t)gw * D) + lane;
#pragma unroll
          for (int j = 0; j < 4; ++j) na[j] = c0[64 * j]; } }
    for (int row = gw; row < NTOK; row += NGW) {
        f32x4 v[4]; float s = 0.f;
#pragma unroll
        for (int j = 0; j < 4; ++j) { v[j].x = __uint_as_float(nx[j].x << 16); v[j].y = __uint_as_float(nx[j].x & 0xffff0000u); v[j].z = __uint_as_float(nx[j].y << 16); v[j].w = __uint_as_float(nx[j].y & 0xffff0000u); }
        if (COMB == 2) {
#pragma unroll
            for (int j = 0; j < 4; ++j) { const v2u a = na[j];
                v[j].x = fmaf(__uint_as_float(a.x << 16), ALPHA, v[j].x); v[j].y = fmaf(__uint_as_float(a.x & 0xffff0000u), ALPHA, v[j].y);
                v[j].z = fmaf(__uint_as_float(a.y << 16), ALPHA, v[j].z); v[j].w = fmaf(__uint_as_float(a.y & 0xffff0000u), ALPHA, v[j].w); } }
        if (COMB == 1) {
#pragma unroll
            for (int j = 0; j < 4; ++j) { const v2u a = na[j], b = nb[j];
                v[j].x = v[j].x * ALPHA + (__uint_as_float(a.x << 16) + __uint_as_float(b.x << 16)); v[j].y = v[j].y * ALPHA + (__uint_as_float(a.x & 0xffff0000u) + __uint_as_float(b.x & 0xffff0000u));
                v[j].z = v[j].z * ALPHA + (__uint_as_float(a.y << 16) + __uint_as_float(b.y << 16)); v[j].w = v[j].w * ALPHA + (__uint_as_float(a.y & 0xffff0000u) + __uint_as_float(b.y & 0xffff0000u)); } }
        if (row + NGW < NTOK) { const int nr = row + NGW; const GAS v2u* xr = (const GAS v2u*)(src + (size_t)nr * D) + lane;
#pragma unroll
            for (int j = 0; j < 4; ++j) nx[j] = xr[64 * j];
            if (COMB == 1) { const GAS v2u* c0 = (const GAS v2u*)(cb + (size_t)nr * D) + lane; const GAS v2u* c1 = (const GAS v2u*)(cb + ((size_t)NTOK + nr) * D) + lane;
#pragma unroll
                for (int j = 0; j < 4; ++j) { na[j] = c0[64 * j]; nb[j] = c1[64 * j]; } }
            if (COMB == 2) { const GAS v2u* c0 = (const GAS v2u*)(cb + (size_t)nr * D) + lane;
#pragma unroll
                for (int j = 0; j < 4; ++j) na[j] = c0[64 * j]; } }
#pragma unroll
        for (int j = 0; j < 4; ++j) s += (v[j].x + v[j].y) + (v[j].z + v[j].w);
        const float mean = wsum(s) * (1.f / D); float s2 = 0.f;
#pragma unroll
        for (int j = 0; j < 4; ++j) { v[j] = v[j] - mean; s2 += (v[j].x * v[j].x + v[j].y * v[j].y) + (v[j].z * v[j].z + v[j].w * v[j].w); }
        const float rstd = 1.f / sqrtf(wsum(s2) * (1.f / D) + LN_EPS);
        GAS v2u* ob = (GAS v2u*)(dstb + (size_t)row * D) + lane;
#pragma unroll
        for (int j = 0; j < 4; ++j) { v[j] = v[j] * rstd * gv[j] + bv[j]; v2u w; w.x = cvt2bf(v[j].x, v[j].y); w.y = cvt2bf(v[j].z, v[j].w); if (dstb) ob[64 * j] = w;
            if (F32OUT) { f32x4 ov = v[j];
#ifdef STAMP
                ov = ov * (1.f + __uint_as_float(__hip_atomic_load((unsigned*)(F.ctl + CW_DIAG), RLX_AGENT)));
#endif
                ((GAS f32x4*)(dst + (size_t)row * D) + lane)[64 * j] = ov; } }
        if (ROUTE) {
            float gl[4] = {0.f, 0.f, 0.f, 0.f};
#pragma unroll
            for (int j = 0; j < 4; ++j)
#pragma unroll
                for (int q = 0; q < 4; ++q) { const f32x4 r = rcv[j * 4 + q]; const float xv = v[j][q];
                    gl[0] = fmaf(xv, r.x, gl[0]); gl[1] = fmaf(xv, r.y, gl[1]); gl[2] = fmaf(xv, r.z, gl[2]); gl[3] = fmaf(xv, r.w, gl[3]); }
#pragma unroll
            for (int g = 0; g < 4; ++g) gl[g] = wsum(gl[g]) + rbc[g];
            int gs = 0; float gm = gl[0];
#pragma unroll
            for (int g = 1; g < 4; ++g) if (gl[g] > gm) { gm = gl[g]; gs = g; }
            float se = 0.f;
#pragma unroll
            for (int g = 0; g < 4; ++g) se += expf(gl[g] - gm);
            const float gwt = 1.f / se;
            float fl[4] = {0.f, 0.f, 0.f, 0.f}; const LAS f32x4* rfg = RF + gs * D;
#pragma unroll
            for (int j = 0; j < 4; ++j)
#pragma unroll
                for (int q = 0; q < 4; ++q) { const f32x4 r = rfg[256 * j + 4 * lane + q]; const float xv = v[j][q];
                    fl[0] = fmaf(xv, r.x, fl[0]); fl[1] = fmaf(xv, r.y, fl[1]); fl[2] = fmaf(xv, r.z, fl[2]); fl[3] = fmaf(xv, r.w, fl[3]); }
#pragma unroll
            for (int e = 0; e < 4; ++e) fl[e] = wsum(fl[e]) + rbf[gs * 4 + e];
            int i1 = 0; float v1 = fl[0];
#pragma unroll
            for (int e = 1; e < 4; ++e) if (fl[e] > v1) { v1 = fl[e]; i1 = e; }
            int i2 = -1; float v2 = -INFINITY;
#pragma unroll
            for (int e = 0; e < 4; ++e) if (e != i1 && fl[e] > v2) { v2 = fl[e]; i2 = e; }
            const float e2 = expf(v2 - v1), w1 = gwt / (1.f + e2), w2 = gwt * e2 / (1.f + e2);
            if (lane == 0) { const int ea = gs * 4 + i1, eb = gs * 4 + i2;
                const unsigned pa = __hip_atomic_fetch_add((LAS unsigned*)RT + ea, 1u, __ATOMIC_RELAXED, __HIP_MEMORY_SCOPE_WORKGROUP), pb = __hip_atomic_fetch_add((LAS unsigned*)RT + eb, 1u, __ATOMIC_RELAXED, __HIP_MEMORY_SCOPE_WORKGROUP);
                RT[64 + lrow] = (unsigned)ea | ((unsigned)eb << 8) | (pa << 16); RT[64 + 128 + lrow] = pb; tokw[row * 2] = w1; tokw[row * 2 + 1] = w2; }
            ++lrow;
        }
    }
    if (ROUTE) {
        __syncthreads();
        if (F.tid < 16) RT[32 + F.tid] = __hip_atomic_fetch_add(cnt + 64 * F.tid, RT[F.tid], RLX_AGENT);
        __syncthreads();
        if (F.tid < 128) { const int lr = F.tid, rw = lr >> 4, it = lr & 15, row = F.vcu * NWAVES + rw + it * NGW;
            if (row < NTOK) { const unsigned e = RT[64 + lr], pb = RT[64 + 128 + lr]; const int ea = e & 255, eb = (e >> 8) & 255; const unsigned pa = e >> 16;
                list[ea * NTOK + RT[32 + ea] + pa] = row * 2; list[eb * NTOK + RT[32 + eb] + pb] = row * 2 + 1; } }
        __syncthreads();
    }
}

__device__ __forceinline__ void moe_convert(const Args& a, int layer, int part  , int wk, int nw, LAS float* scr, int lane) {
    unsigned char* ws = a.ws;
    constexpr int PER = 64, NU = NEXP * 2 * 4 * PER, PERD = 256, ND = NEXP * PERD;
    auto desc = [&](int it) { TrDesc d;
        if (it < NU) { int j = it / PER; const int r = it % PER, pn = j & 3; j >>= 2; const int which = j & 1; j >>= 1; const int le = layer * NEXP + j, kb = r >> 2, nb = r & 3;
            d.W = a.in[27 + which] + (size_t)le * D * MOE_F; d.ldw = MOE_F; d.WT = (bf16*)(ws + WS_WGU) + (size_t)le * 1024 * D; d.ldt = D; d.k0 = kb * 64; d.c0 = pn * 128 + nb * 32; d.nc = 32; d.r0 = pn * 256 + which * 128 + nb * 32; }
        else { const int q = it - NU, le = layer * NEXP + q / PERD, r = q % PERD, kb = r >> 5, nb = r & 31;
            d.W = a.in[29] + (size_t)le * MOE_F * D; d.ldw = D; d.WT = (bf16*)(ws + WS_WD) + (size_t)le * D * MOE_F; d.ldt = MOE_F; d.k0 = kb * 64; d.c0 = nb * 32; d.nc = 32; d.r0 = nb * 32; }
        return d; };
    const int lo = part == 1 ? NU : 0, hi = part == 0 ? NU : NU + ND;
    f32x4 va[8], vb[8]; int it = lo + wk;
    if (it < hi) { TrDesc d0 = desc(it); tr_load(d0, va, lane); }
    for (; it < hi; it += 2 * nw) {
        const TrDesc d0 = desc(it); const bool h1 = it + nw < hi, h2 = it + 2 * nw < hi;
        if (h1) { const TrDesc d1 = desc(it + nw); tr_load(d1, vb, lane); }
        tr_store(d0, va, scr, lane);
        if (h2) { const TrDesc d2 = desc(it + 2 * nw); tr_load(d2, va, lane); }
        if (h1) { const TrDesc d1 = desc(it + nw); tr_store(d1, vb, scr, lane); }
    }
}
__device__ __forceinline__ void p0_prologue(Frame& F, const Args& a) {
    for (int u = F.vcu; u < 256; u += F.G) s5_build_group(F, a, u >> 2, u & 3, F.lds + RING_OFF);
    LAS float* scr = (LAS float*)(F.lds + RING_OFF + F.wave * 16384);
    const int gw = F.vcu * NWAVES + F.wave, NGW = F.G * NWAVES, lane = F.lane;
    unsigned char* ws = a.ws;
    { const float* x = a.in[0]; bf16* xb = (bf16*)(ws + WS_XB); const size_t n8 = (size_t)NTOK * D / 8, st = (size_t)NGW * 64;
      for (size_t i = (size_t)gw * 64 + lane; i < n8; i += 4 * st) { f32x4 v0[4], v1[4];
#pragma unroll
          for (int u = 0; u < 4; ++u) if (i + u * st < n8) { v0[u] = __builtin_nontemporal_load((const GAS f32x4*)(x + (i + u * st) * 8)); v1[u] = __builtin_nontemporal_load((const GAS f32x4*)(x + (i + u * st) * 8 + 4)); }
#pragma unroll
          for (int u = 0; u < 4; ++u) if (i + u * st < n8) { v4u o; o.x = pk2(v0[u].x, v0[u].y); o.y = pk2(v0[u].z, v0[u].w); o.z = pk2(v1[u].x, v1[u].y); o.w = pk2(v1[u].z, v1[u].w);
              *(GAS v4u*)(xb + (i + u * st) * 8) = o; } } }
    { const float* W = a.in[2]; bf16* WT = (bf16*)(ws + WS_WIN);
      const int n0 = tr_seg_items(D, 1088), n1 = tr_seg_items(D, 4), n2 = tr_seg_items(D, 16), n3 = tr_seg_items(D, 1024), n4 = tr_seg_items(D, 512);
      for (int it = gw; it < n0; it += NGW) tr_seg(W, ABP, D, 0, 1088, WT, D, 0, it, scr, lane);
      for (int it = gw; it < n1; it += NGW) tr_seg(W, ABP, D, 1088, 4, WT, D, HC_IW, it, scr, lane);
      for (int it = gw; it < n2; it += NGW) tr_seg(W, ABP, D, 2116, 16, WT, D, HC_BG, it, scr, lane);
      for (int it = gw; it < n3; it += NGW) tr_seg(W, ABP, D, 1092, 1024, WT, D, HC_BQ, it, scr, lane);
      for (int it = gw; it < n4; it += NGW) tr_seg(W, ABP, D, 2132, 512, WT, D, HC_BR, it, scr, lane);
      for (int i = gw * 64 + lane; i < 172 * (D / 8); i += NGW * 64) { const int rr = i / (D / 8), cc = i % (D / 8); const int row = rr < 4 ? 1092 + rr : 1112 + (rr - 4);
          *(GAS v4u*)(WT + (size_t)row * D + cc * 8) = (v4u){0u, 0u, 0u, 0u}; } }
    { const int n = tr_seg_items(D, D);
      for (int it = gw; it < n; it += NGW) tr_seg(a.in[6], D, D, 0, D, (bf16*)(ws + WS_WOUT), D, 0, it, scr, lane);
      for (int it = gw; it < n; it += NGW) tr_seg(a.in[7], D, D, 0, D, (bf16*)(ws + WS_S5IN), D, 0, it, scr, lane);
      for (int it = gw; it < n; it += NGW) tr_seg(a.in[18], D, D, 0, D, (bf16*)(ws + WS_S5OUT), D, 0, it, scr, lane); }
    { const int n = 2 * 8 * tr_seg_items(D, 128);
      for (int it = gw; it < n; it += NGW) { const int per = tr_seg_items(D, 128), j = it / per, which = j & 1, pn = j >> 1;
          tr_seg(a.in[16 + which], D, D, pn * 128, 128, (bf16*)(ws + WS_GLU), D, pn * 256 + which * 128, it % per, scr, lane); } }
    __syncthreads();
}


#define MOE_PHASES(L, PU, PD, PL, LG, LB) \
    if (IN(PU)) { \
        pg8::Gemm g{(const bf16*)(ws + WS_XB), (const bf16*)(ws + WS_WGU) + (size_t)(L) * NEXP * 1024 * D, D, D, D}; \
        pg8::MoeOrder S; S.list = (const int*)(ws + WS_LIST); S.G = F.G; S.c = F.vcu;     _Pragma("unroll") for (int _e = 0; _e < NEXP; ++_e) S.cnt[_e] = __builtin_amdgcn_readfirstlane((int)__hip_atomic_load((unsigned*)(F.ctl + CW_CNT + 1024 * (L)) + 64 * _e, RLX_AGENT)); \
        pg8::EpiGated<1> E{(bf16*)(ws + WS_HMID), MOE_F}; \
        RP(PU) pg8::gemm_phase<pg8::EpiGated<1>, pg8::MoeOrder, true, PU>(F.lds + RING_OFF, g, S, E, F.ctl); \
        if ((L) == 0) { int _T = 0; _Pragma("unroll") for (int _e = 0; _e < NEXP; ++_e) _T += (S.cnt[_e] + 255) >> 8; const int _n5 = 4 * _T - 4 * F.G;     \
            const bool _all = _n5 < 0 || _n5 >= F.G; const int _wk = _all ? F.vcu * NWAVES + F.wave : (F.vcu - _n5) * NWAVES + F.wave, _nw = _all ? F.G * NWAVES : (F.G - _n5) * NWAVES; \
            if (_all || F.vcu >= _n5) { LAS float* _scr = (LAS float*)(F.lds + RING_OFF + F.wave * 16384); moe_convert(args, 0, 1, _wk, _nw, _scr, F.lane); moe_convert(args, 1, 2, _wk, _nw, _scr, F.lane); } } \
        if (BOTH(PU)) GRID_BAR(); } \
    if (IN(PD)) { \
        pg8::Gemm g{(const bf16*)(ws + WS_HMID), (const bf16*)(ws + WS_WD) + (size_t)(L) * NEXP * D * MOE_F, MOE_F, MOE_F, MOE_F}; \
        pg8::MoeOrder S; S.list = (const int*)(ws + WS_LIST); S.G = F.G; S.c = F.vcu;     _Pragma("unroll") for (int _e = 0; _e < NEXP; ++_e) S.cnt[_e] = __builtin_amdgcn_readfirstlane((int)__hip_atomic_load((unsigned*)(F.ctl + CW_CNT + 1024 * (L)) + 64 * _e, RLX_AGENT)); \
        pg8::EpiMoeDown E{(const float*)(ws + WS_TOKW), (bf16*)(ws + WS_CB)}; \
        RP(PD) pg8::gemm_phase<pg8::EpiMoeDown, pg8::MoeOrder, false, PD>(F.lds + RING_OFF, g, S, E, F.ctl); \
        if (BOTH(PD)) GRID_BAR(); } \
    if (IN(PL)) { \
        if ((L) == 0) ln_phase<1, false, false>(F, (const bf16*)(ws + WS_XB), (const bf16*)(ws + WS_CB), LG, LB, nullptr, (bf16*)(ws + WS_XB), nullptr, nullptr, nullptr, nullptr, nullptr, nullptr, nullptr); \
        else ln_phase<1, false, true>(F, (const bf16*)(ws + WS_XB), (const bf16*)(ws + WS_CB), LG, LB, args.out, nullptr, nullptr, nullptr, nullptr, nullptr, nullptr, nullptr, nullptr); \
        if (BOTH(PL)) GRID_BAR(); }

__global__ void __launch_bounds__(NWAVES * 64, 2) mk_fwd(Args args) {
    extern __shared__ __attribute__((aligned(16))) unsigned char lds[];
    Frame F;
    F.lds = (LAS unsigned char*)lds; F.MISC = (volatile LAS unsigned*)(F.lds + MISC_OFF);
    F.tid = threadIdx.x; F.lane = F.tid & 63; F.wave = __builtin_amdgcn_readfirstlane(F.tid >> 6);
    F.G = gridDim.x; { const int bx = blockIdx.x; F.vcu = (F.G % 8 == 0) ? (bx % 8) * (F.G / 8) + bx / 8 : bx; }
    unsigned char* ws = args.ws;
    F.ctl = (gu32*)(ws + WS_CTL);
    for (int u = F.tid; u < (LDS_BYTES - LDSCTL_OFF) / 4; u += NWAVES * 64) ((LAS unsigned*)(F.lds + LDSCTL_OFF))[u] = 0u;
    __syncthreads();
    XcdBarrier bar = xcd_barrier_post((unsigned*)(F.ctl + CW_BAR) + args.li * XCD_BAR_WORDS, F.MISC + 8);
    const int lo = args.ph_lo, hi = args.ph_hi;
#define IN(k) (lo <= (k) && (k) < hi)
#define BOTH(k) (IN(k) && IN((k) + 1))
#ifdef STAMP
    int _bi = 0;
#define STAMP_BAR() do { if (STAMP >= 1000 && blockIdx.x == 37 && threadIdx.x == 0) { const unsigned _now = (unsigned)__builtin_amdgcn_s_memtime(); \
        if (_bi == STAMP - 1000) __hip_atomic_store((unsigned*)(F.ctl + CW_DIAG), __float_as_uint((float)(_now - F.MISC[20]) * (float)(STAMP_SCALE)), RLX_AGENT); \
        if (_bi + 1 == STAMP - 1000) F.MISC[20] = _now; } ++_bi; } while (0)
#define GRID_BAR() do { xcd_barrier(bar); STAMP_BAR(); } while (0)
    if (STAMP == 1000 && blockIdx.x == 37 && threadIdx.x == 0) F.MISC[20] = (unsigned)__builtin_amdgcn_s_memtime();
#else
#define GRID_BAR() xcd_barrier(bar)
#endif
#define RP(k) for (int _rp = 0; _rp < ((PROBE == (k)) ? 2 : 1); ++_rp)
    if (IN(0)) { RP(0) p0_prologue(F, args); if (BOTH(0)) GRID_BAR(); }
    if (IN(1)) {
        pg8::Gemm g{(const bf16*)(ws + WS_XB), (const bf16*)(ws + WS_WIN), D, D, D}; pg8::StaticOrder S; S.init(NTOK, HP, F.G, (int)blockIdx.x);
        pg8::EpiStoreBf16 E{(bf16*)(ws + WS_H), HP};
        RP(1) pg8::gemm_phase<pg8::EpiStoreBf16, pg8::StaticOrder, false, 1>(F.lds + RING_OFF, g, S, E, F.ctl);
        { const int units = (NTOK / 256) * (HP / 256), rem = units % F.G;
          if ((int)blockIdx.x >= rem) moe_convert(args, 0, 0, ((int)blockIdx.x - rem) * NWAVES + F.wave, (F.G - rem) * NWAVES, (LAS float*)(F.lds + RING_OFF + F.wave * 16384), F.lane); }
        if (BOTH(1)) GRID_BAR();
    }


    if (IN(2)) {
        STAMP_DECL; STAMP_BEGIN(200);
        RP(20) { Dsa1Ops ops; { const int x = F.vcu; if (x < 2048) dsa1_load(F, args, x >> 7, x & 127, ops); }
          for (int k = 0, x = F.vcu; x < 2048; ++k, x += F.G) { const int b = x >> 7, qb = x & 127, xn = x + F.G;
              const int nb = xn < 2048 ? (xn >> 7) : -1, nq = xn & 127; dsa1_unit(F, args, b, (k & 1) ? 127 - qb : qb, ops, nb, ((k + 1) & 1) ? 127 - nq : nq); } }
        STAMP_END(200); STAMP_BEGIN(201);
        RP(21) for (int u = F.vcu; u < 1024; u += F.G) gla1_pair(F, args, 2 * u);
        STAMP_END(201); STAMP_PUBLISH(F.ctl, 37, (float)(STAMP_SCALE));
        if (BOTH(2)) GRID_BAR(); }
    if (IN(3)) {
        RP(30) gla2_scan(F, args);
        RP(31) for (int v = F.vcu; v < 256; v += F.G) { const int bg = v >> 3, s = v & 7;
#pragma unroll 1
            for (int k = 0; k < 4; ++k) { const int qb = k == 0 ? s : (k == 1 ? 15 - s : (k == 2 ? 16 + s : 31 - s)); dsa2_unit(F, args, bg >> 1, bg & 1, qb); } }
        if (BOTH(3)) GRID_BAR(); }
    if (IN(4)) { RP(4) for (int u = F.vcu; u < 1024; u += F.G) gla3_pair(F, args, 2 * u); if (BOTH(4)) GRID_BAR(); }
    if (IN(5)) {
        pg8::Gemm g{(const bf16*)(ws + WS_O), (const bf16*)(ws + WS_WOUT), D, D, D}; pg8::StaticOrder S; S.init(NTOK, D, F.G, (int)blockIdx.x);
        pg8::EpiStoreBf16 E{(bf16*)(ws + WS_H), D};
        RP(5) pg8::gemm_phase<pg8::EpiStoreBf16, pg8::StaticOrder, false, 5>(F.lds + RING_OFF, g, S, E, F.ctl);
        if (BOTH(5)) GRID_BAR();
    }
    if (IN(6)) {
        ln_phase<2, true, false>(F, (const bf16*)(ws + WS_H), (const bf16*)(ws + WS_XB), args.in[19], args.in[20], nullptr, (bf16*)(ws + WS_XB), args.in[23], args.in[24], args.in[25], args.in[26],
                          (unsigned*)(F.ctl + CW_CNT), (int*)(ws + WS_LIST), (float*)(ws + WS_TOKW));
        if (BOTH(6)) GRID_BAR(); }
    MOE_PHASES(0, 7, 8, 9, args.in[21], args.in[22])
    if (IN(10)) {
        pg8::Gemm g{(const bf16*)(ws + WS_XB), (const bf16*)(ws + WS_S5IN), D, D, D}; pg8::StaticOrder S; S.init(NTOK, D, F.G, (int)blockIdx.x);
        pg8::EpiS5U E{(bf16*)(ws + WS_H)};
        RP(10) pg8::gemm_phase<pg8::EpiS5U, pg8::StaticOrder, false>(F.lds + RING_OFF, g, S, E);
        if (BOTH(10)) GRID_BAR();
    }
    if (IN(11)) {
        { pg8::Gemm g{(const bf16*)(ws + WS_H), (const bf16*)(ws + WS_PG), 384, 256, 256}; pg8::S5Order S{F.G, F.vcu};
          pg8::EpiS5Z E{(float*)(ws + WS_H + 96 * MiB)};
          pg8::gemm_phase<pg8::EpiS5Z, pg8::S5Order, false>(F.lds + RING_OFF, g, S, E); }
        VM_WAIT(); __syncthreads();
        s5_scan_local(F, args);
        VM_WAIT(); __syncthreads();
        { pg8::Gemm g{(const bf16*)(ws + WS_H), (const bf16*)(ws + WS_MQ), 384, 384, 384}; pg8::S5Order S{F.G, F.vcu};
          pg8::EpiS5Y E{(bf16*)(ws + WS_O)};
          pg8::gemm_phase<pg8::EpiS5Y, pg8::S5Order, false>(F.lds + RING_OFF, g, S, E); }
        if (IN(14)) GRID_BAR();
    }
    if (IN(14)) {
        pg8::Gemm g{(const bf16*)(ws + WS_O), (const bf16*)(ws + WS_GLU), D, D, D}; pg8::StaticOrder S; S.init(NTOK, 2 * D, F.G, (int)blockIdx.x);
        pg8::EpiGated<0> E{(bf16*)(ws + WS_F1), D};
        RP(14) pg8::gemm_phase<pg8::EpiGated<0>, pg8::StaticOrder, false, 14>(F.lds + RING_OFF, g, S, E, F.ctl);
        if (BOTH(14)) GRID_BAR();
    }
    if (IN(15)) {
        pg8::Gemm g{(const bf16*)(ws + WS_F1), (const bf16*)(ws + WS_S5OUT), D, D, D}; pg8::StaticOrder S; S.init(NTOK, D, F.G, (int)blockIdx.x);
        pg8::EpiStoreBf16 E{(bf16*)(ws + WS_H), D};
        pg8::gemm_phase<pg8::EpiStoreBf16, pg8::StaticOrder, false>(F.lds + RING_OFF, g, S, E);
        if (BOTH(15)) GRID_BAR();
    }
    if (IN(16)) {
        ln_phase<2, true, false>(F, (const bf16*)(ws + WS_H), (const bf16*)(ws + WS_XB), args.in[19] + D, args.in[20] + D, nullptr, (bf16*)(ws + WS_XB), args.in[23] + D * 4, args.in[24] + 4, args.in[25] + 4 * D * 4, args.in[26] + 16,
                          (unsigned*)(F.ctl + CW_CNT + 1024), (int*)(ws + WS_LIST), (float*)(ws + WS_TOKW));
        if (BOTH(16)) GRID_BAR(); }
    MOE_PHASES(1, 17, 18, 19, args.in[21] + D, args.in[22] + D)
#ifdef STAMP
    STAMP_BAR();
#endif
#undef IN
#undef BOTH
}
static int g_grid = 0;
extern "C" void kernel_launch(void* const* d_in, const int* in_sizes, int n_in, void* d_out, int out_size, void* d_ws, size_t ws_size, hipStream_t stream) {
    if (g_grid == 0) {
        if (n_in != 30 || out_size != NTOK * D || ws_size < WS_END) { fprintf(stderr, "kernel_launch: unexpected problem (n_in %d out %d ws %zu)\n", n_in, out_size, ws_size); g_grid = -1; return; }
        int dev = 0, cus = 0, per_cu = 0;
        if (hipGetDevice(&dev) != hipSuccess || hipDeviceGetAttribute(&cus, hipDeviceAttributeMultiprocessorCount, dev) != hipSuccess) { g_grid = -1; return; }
        if (hipFuncSetAttribute((const void*)mk_fwd, hipFuncAttributeMaxDynamicSharedMemorySize, LDS_BYTES) != hipSuccess) { fprintf(stderr, "kernel_launch: hipFuncSetAttribute failed\n"); g_grid = -1; return; }
        if (hipOccupancyMaxActiveBlocksPerMultiprocessor(&per_cu, (const void*)mk_fwd, NWAVES * 64, LDS_BYTES) != hipSuccess || per_cu < 1) fprintf(stderr, "kernel_launch: occupancy query says %d\n", per_cu);
        (void)hipGetLastError();
        if (cus < 256) { fprintf(stderr, "kernel_launch: built for a 256-CU MI355X (one workgroup per CU); found %d CUs\n", cus); g_grid = -1; return; }
        g_grid = 256;
    }
    if (g_grid < 0) return;
    (void)hipMemsetAsync((char*)d_ws + WS_CTL, 0, CTL_ZERO_BYTES, stream);
    Args a{};
    for (int i = 0; i < 30; ++i) a.in[i] = (const float*)d_in[i];
    a.out = (float*)d_out; a.ws = (unsigned char*)d_ws; a.ph_lo = 0; a.ph_hi = 20; a.li = 0; a.pad = 0;
    hipLaunchKernelGGL(mk_fwd, dim3(g_grid), dim3(NWAVES * 64), LDS_BYTES, stream, a);
}
```

```cpp
#include <hip/hip_runtime.h>
#include <math.h>
#include <stdio.h>
#include <stdint.h>

#define GAS __attribute__((address_space(1)))
#define LAS __attribute__((address_space(3)))
typedef unsigned short bf16;
typedef unsigned v4u __attribute__((ext_vector_type(4)));
typedef unsigned v2u __attribute__((ext_vector_type(2)));
typedef float f32x4 __attribute__((ext_vector_type(4)));
typedef float f32x2 __attribute__((ext_vector_type(2)));
typedef float f32x16 __attribute__((ext_vector_type(16)));
typedef short bf16x8 __attribute__((ext_vector_type(8)));
typedef short bf16x4 __attribute__((ext_vector_type(4)));
typedef GAS unsigned gu32;
#define RLX_AGENT __ATOMIC_RELAXED, __HIP_MEMORY_SCOPE_AGENT
#define LDS_WAIT() asm volatile("s_waitcnt lgkmcnt(0)" ::: "memory")
#define VM_WAIT() asm volatile("s_waitcnt vmcnt(0)" ::: "memory")

constexpr int D = 1024, BATCH = 16, SEQ = 2048, NTOK = BATCH * SEQ;
constexpr int ABP = 2644;
constexpr int HP = 2816;
constexpr int HC_AQ = 0, HC_AK = 512, HC_AV = 640, HC_IQ = 768, HC_IK = 1024, HC_IW = 1088, HC_BG = 1096, HC_BQ = 1280, HC_BK = 1536, HC_BV = 1792, HC_BR = 2304;
constexpr float ALPHA = 1.4142135623730951f;
constexpr float LN_EPS = 1e-5f;
constexpr int NEXP = 16, MOE_F = 512;
constexpr int MAXSLOT = 65536 + NEXP * 256;

__device__ __forceinline__ float bf2f(bf16 v) { return __uint_as_float(((unsigned)v) << 16); }
__device__ __forceinline__ unsigned f2bf(float f) { unsigned u = __float_as_uint(f); return (u + 0x7fffu + ((u >> 16) & 1u)) >> 16; }
__device__ __forceinline__ unsigned cvt2bf(float lo, float hi) { unsigned r; asm volatile("v_cvt_pk_bf16_f32 %0, %1, %2" : "=v"(r) : "v"(lo), "v"(hi)); return r; }
__device__ __forceinline__ unsigned pk2(float lo, float hi) { return f2bf(lo) | (f2bf(hi) << 16); }
__device__ __forceinline__ float wsum(float v) {
#define WS_DPP(ctrl, rm, bc) v += __int_as_float(__builtin_amdgcn_update_dpp(0, __float_as_int(v), ctrl, rm, 0xF, bc))
    WS_DPP(0xB1, 0xF, true); WS_DPP(0x4E, 0xF, true); WS_DPP(0x141, 0xF, true); WS_DPP(0x140, 0xF, true); WS_DPP(0x142, 0xA, false); WS_DPP(0x143, 0xC, false);
#undef WS_DPP
    return __int_as_float(__builtin_amdgcn_readlane(__float_as_int(v), 63));
}
__device__ const unsigned char T5B[128] = {0, 1, 2, 3, 4, 5, 6, 7, 8, 9, 10, 11, 12, 13, 14, 15, 16, 16, 16, 17, 17, 18, 18, 18, 19, 19, 19, 20, 20, 20, 20, 21, 21, 21, 21, 22, 22, 22, 22, 22, 23, 23, 23, 23, 23, 23, 24, 24, 24, 24, 24, 24, 25, 25, 25, 25, 25, 25, 25, 26, 26, 26, 26, 26, 26, 26, 26, 27, 27, 27, 27, 27, 27, 27, 27, 27, 27, 28, 28, 28, 28, 28, 28, 28, 28, 28, 28, 29, 29, 29, 29, 29, 29, 29, 29, 29, 29, 29, 29, 30, 30, 30, 30, 30, 30, 30, 30, 30, 30, 30, 30, 30, 30, 31, 31, 31, 31, 31, 31, 31, 31, 31, 31, 31, 31, 31, 31, 31};

__device__ __forceinline__ float xhalf_max(float v) { const auto r = __builtin_amdgcn_permlane32_swap(__float_as_uint(v), __float_as_uint(v), false, false); return fmaxf(__uint_as_float(r[0]), __uint_as_float(r[1])); }
__device__ __forceinline__ float xhalf_sum(float v) { const auto r = __builtin_amdgcn_permlane32_swap(__float_as_uint(v), __float_as_uint(v), false, false); return __uint_as_float(r[0]) + __uint_as_float(r[1]); }
#ifndef PROBE
#define PROBE -1
#endif
constexpr int CW_DIAG = 8;
#ifdef STAMP
#define STAMP_DECL unsigned _st_acc = 0u, _st_t0 = 0u, _st_n = 0u
#define STAMP_BEGIN(id) do { if (STAMP == (id)) _st_t0 = (unsigned)__builtin_amdgcn_s_memtime(); } while (0)
#define STAMP_END(id) do { if (STAMP == (id)) { _st_acc += (unsigned)__builtin_amdgcn_s_memtime() - _st_t0; ++_st_n; } } while (0)
#define STAMP_PUBLISH(ctl, wg, scale) do { if ((int)blockIdx.x == (wg) && threadIdx.x == 0 && _st_n) __hip_atomic_store((unsigned*)((ctl) + CW_DIAG), __float_as_uint((float)_st_acc / (float)_st_n * (scale)), RLX_AGENT); } while (0)
#define STAMP_T0(id, t0) unsigned t0 = 0u; do { if (STAMP == (id)) t0 = (unsigned)__builtin_amdgcn_s_memtime(); } while (0)
#define STAMP_END_PUB(id, t0, ctl, wg, scale) do { if (STAMP == (id)) { const unsigned _dt = (unsigned)__builtin_amdgcn_s_memtime() - t0; if ((int)blockIdx.x == (wg) && threadIdx.x == 0) __hip_atomic_store((unsigned*)((ctl) + CW_DIAG), __float_as_uint((float)_dt * (scale)), RLX_AGENT); } } while (0)
#else
#define STAMP_DECL
#define STAMP_BEGIN(id)
#define STAMP_END(id)
#define STAMP_PUBLISH(ctl, wg, scale)
#define STAMP_T0(id, t0)
#define STAMP_END_PUB(id, t0, ctl, wg, scale)
#endif
namespace pg8 {
#define PG8_LAS __attribute__((address_space(3)))
constexpr int BM = 256, BK = 64, HALF = 128, HTB = HALF * BK * 2  , STAGE_BYTES = 8 * HTB, NXCD = 8, WGM = 8;
__host__ __device__ __forceinline__ int lds_byte(int r, int c) { const int st = (r >> 4) * 2 + (c >> 5), rr = r & 15, cc = c & 31, ob = rr * 64 + cc * 2; return st * 1024 + (ob ^ (((ob >> 9) & 1) << 5)); }
__host__ __device__ __forceinline__ void stage_rc(int b, int& R, int& C) { const int st = b / 1024, sb = b % 1024, swz = sb ^ (((sb >> 9) & 1) << 5); R = (st >> 1) * 16 + swz / 64; C = (st & 1) * 32 + (swz % 64) / 2; }
__host__ __device__ __forceinline__ int perm32(int rho) { const int n = rho >> 4, i = rho & 15; return 8 * (i >> 2) + 4 * n + (i & 3); }

struct Unit { int arow0, brow0, pm, pn, aux, cnt; const int* gather; };
struct Gemm { const bf16* A; const bf16* Bt; int lda, ldb, K; };

struct StaticOrder {
    int nM, nN, nwg, G, c;
    __device__ void init(int M, int N, int G_, int c_) { nM = M / BM; nN = N / BM; nwg = nM * nN; G = G_; c = c_; }
    __device__ bool next(int i, Unit& u) const {
        const long L = (long)i * G + c; if (L >= nwg) return false;
        int wgid = (int)L; { const int q = nwg / NXCD, r = nwg % NXCD, xcd = wgid % NXCD, off = wgid / NXCD; wgid = (xcd < r ? xcd * (q + 1) : r * (q + 1) + (xcd - r) * q) + off; }
        const int nig = WGM * nN, gid = wgid / nig, fm = gid * WGM, gsz = (nM - fm) < WGM ? (nM - fm) : WGM;
        u.pm = fm + ((wgid % nig) % gsz); u.pn = (wgid % nig) / gsz; u.arow0 = u.pm * BM; u.brow0 = u.pn * BM; u.aux = 0; u.cnt = BM; u.gather = nullptr; return true;
    }
};
__device__ __forceinline__ unsigned cvt_pk_bf16(float lo, float hi) { unsigned r; asm volatile("v_cvt_pk_bf16_f32 %0, %1, %2" : "=v"(r) : "v"(lo), "v"(hi)); return r; }

template <class Epi, class Sched, bool GATHER = false, int SID = 0, bool GA = false>
__device__ __forceinline__ void gemm_phase(PG8_LAS unsigned char* lds, const Gemm g, const Sched& S, const Epi& E, gu32* sctl = nullptr) {
    const int tid = threadIdx.x, wid = __builtin_amdgcn_readfirstlane(tid >> 6), lane = tid & 63, wr = wid >> 2, wc = wid & 3, fr = lane & 15, fq = lane >> 4;
    const int K = g.K, nt = K / BK;
    unsigned voffA[2], voffB[2];
#pragma unroll
    for (int i = 0; i < 2; ++i) { int R, C; stage_rc(tid * 16 + i * 8192, R, C); const int Rb = Epi::PERM ? ((R & ~31) + perm32(R & 31)) : R;
        voffA[i] = GATHER ? (unsigned)(C * 2) : (GA ? (unsigned)(R * 32 + (C >> 4) * (NTOK * 32) + (C & 15) * 2) : (unsigned)(R * g.lda + C) * 2u); voffB[i] = (unsigned)(Rb * g.ldb + C) * 2u; }
    const size_t kstep = (size_t)(BK * 2), kstepA = GA ? (size_t)4 * NTOK * 32 : kstep;
    const size_t hstepA = GA ? (size_t)HALF * 32 : (size_t)HALF * g.lda * 2, hstepB = (size_t)HALF * g.ldb * 2;
    const unsigned ldsw = (unsigned)wid * 1024u;
    const int aoff = lds_byte(wr * 64 + fr, fq * 8), boff = lds_byte(wc * 32 + fr, fq * 8);
#define PG8_SA(b, h) (((b) * 2 + (h)) * HTB)
#define PG8_SB(b, h) ((4 + (b) * 2 + (h)) * HTB)
#define PG8_STAGE(bufoff, gbase, voff) do { _Pragma("unroll") for (int _i = 0; _i < 2; ++_i) \
        __builtin_amdgcn_global_load_lds((const unsigned*)((const char*)(gbase) + (voff)[_i]), (PG8_LAS unsigned*)(lds + (bufoff) + ldsw + _i * 8192), 16, 0, 0); } while (0)
#define PG8_STAGE_A(bufoff, P, O, h, ko) do { _Pragma("unroll") for (int _i = 0; _i < 2; ++_i) { \
        const char* _p; if constexpr (GATHER) { const unsigned _t = _i ? ((O)[h] >> 16) : ((O)[h] & 0xffffu); _p = (const char*)(P) + (ko) + (size_t)(_t * (unsigned)(g.lda * 2) + voffA[_i]); } \
        else _p = (const char*)(P) + (ko) + (size_t)(h) * hstepA + voffA[_i]; \
        __builtin_amdgcn_global_load_lds((const unsigned*)_p, (PG8_LAS unsigned*)(lds + (bufoff) + ldsw + _i * 8192), 16, 0, 0); } } while (0)
#define PG8_LDA(dst, b, h) do { _Pragma("unroll") for (int m = 0; m < 4; ++m) _Pragma("unroll") for (int k = 0; k < 2; ++k) dst[m][k] = *(const PG8_LAS bf16x8*)(lds + PG8_SA(b, h) + aoff + m * 2048 + k * 1024); } while (0)
#define PG8_LDB(dst, b, h) do { _Pragma("unroll") for (int n = 0; n < 2; ++n) _Pragma("unroll") for (int k = 0; k < 2; ++k) dst[n][k] = *(const PG8_LAS bf16x8*)(lds + PG8_SB(b, h) + boff + n * 2048 + k * 1024); } while (0)
#define PG8_MMA(ai, bj, At, Bt) do { __builtin_amdgcn_s_setprio(1); _Pragma("unroll") for (int m = 0; m < 4; ++m) _Pragma("unroll") for (int n = 0; n < 2; ++n) _Pragma("unroll") for (int k = 0; k < 2; ++k) \
        acc[ai][bj][m][n] = __builtin_amdgcn_mfma_f32_16x16x32_bf16(Bt[n][k], At[m][k], acc[ai][bj][m][n], 0, 0, 0); __builtin_amdgcn_s_setprio(0); } while (0)
#define PG8_WAIT_V(n) asm volatile("s_waitcnt vmcnt(" #n ")" ::: "memory")
#define PG8_WAIT_L(n) asm volatile("s_waitcnt lgkmcnt(" #n ")" ::: "memory")
#define PG8_BAR __builtin_amdgcn_s_barrier()
#define PG8_SCHED __builtin_amdgcn_sched_barrier(0)
    Unit cur, nxt; int ui = 0;
    if (!S.next(0, cur)) return;
    f32x4 acc[2][2][4][2];
#pragma unroll
    for (int a = 0; a < 2; ++a)
#pragma unroll
        for (int b = 0; b < 2; ++b)
#pragma unroll
            for (int m = 0; m < 4; ++m)
#pragma unroll
                for (int n = 0; n < 2; ++n) acc[a][b][m][n] = (f32x4){0.f, 0.f, 0.f, 0.f};
    bf16x8 At[4][2], B0[2][2], B1[2][2];
    unsigned OA[2], ON[2];
    const char* cA; const char* cB;
#define PG8_SETUP(u, P, O) do { \
        if constexpr (GATHER) { P = (const char*)g.A; _Pragma("unroll") for (int _h = 0; _h < 2; ++_h) { unsigned _pk = 0u; _Pragma("unroll") for (int _i = 0; _i < 2; ++_i) { \
            int _R, _C; stage_rc(tid * 16 + _i * 8192, _R, _C); const int _r = _h * HALF + _R; const unsigned _t = (_r < (u).cnt) ? (unsigned)((u).gather[_r] >> 1) : 0u; _pk |= _t << (16 * _i); } O[_h] = _pk; } } \
        else { P = (const char*)g.A + (GA ? (size_t)(u).arow0 * 32 : (size_t)(u).arow0 * g.lda * 2); } } while (0)
    PG8_SETUP(cur, cA, OA);
    cB = (const char*)g.Bt + (size_t)cur.brow0 * g.ldb * 2;
    PG8_STAGE(PG8_SB(0, 0), cB, voffB); PG8_STAGE(PG8_SB(0, 1), cB + hstepB, voffB); PG8_STAGE_A(PG8_SA(0, 0), cA, OA, 0, 0); PG8_STAGE_A(PG8_SA(0, 1), cA, OA, 1, 0);
    if (wr == 1) PG8_BAR;
    PG8_WAIT_V(2); PG8_BAR;
    PG8_STAGE(PG8_SB(1, 0), cB + kstep, voffB); PG8_STAGE_A(PG8_SA(1, 0), cA, OA, 0, kstepA); PG8_STAGE(PG8_SB(1, 1), cB + hstepB + kstep, voffB);
    PG8_WAIT_V(6); PG8_BAR;
    for (;;) {
        STAMP_T0(SID * 10 + 1, _tu);
        const bool has_next = S.next(ui + 1, nxt);
        const char* nA = cA; const char* nB = cB;
        if constexpr (GATHER) { ON[0] = OA[0]; ON[1] = OA[1]; }
        if (has_next) { PG8_SETUP(nxt, nA, ON); nB = (const char*)g.Bt + (size_t)nxt.brow0 * g.ldb * 2; }
        STAMP_T0(SID * 10 + 2, _tk);
#ifdef STAMP
        unsigned _d5 = 0u;
#endif
        for (int t = 0; t < nt; t += 2) {
            const bool last = (t == nt - 2);
            STAMP_T0(SID * 10 + 5, _ti0); STAMP_T0(SID * 10 + 6, _ti1);
            const size_t k1 = (size_t)(t + 1) * kstepA;
            const char* a2 = last ? nA : cA; const char* b2 = last ? nB : cB + (size_t)(t + 2) * kstep;
            const size_t k2 = last ? 0 : (size_t)(t + 2) * kstepA, k3 = k2 + kstepA;
            const char* b3 = b2 + kstep;
            unsigned O2[2];
            if constexpr (GATHER) { O2[0] = last ? ON[0] : OA[0]; O2[1] = last ? ON[1] : OA[1]; }
            PG8_LDB(B0, 0, 0); PG8_LDB(B1, 0, 1); PG8_SCHED; PG8_LDA(At, 0, 0); PG8_STAGE_A(PG8_SA(1, 1), cA, OA, 1, k1);
            PG8_WAIT_V(8); PG8_WAIT_L(0); PG8_BAR; PG8_MMA(0, 0, At, B0); PG8_MMA(0, 1, At, B1); PG8_BAR; PG8_SCHED;
            PG8_LDA(At, 0, 1); PG8_STAGE(PG8_SB(0, 0), b2, voffB); PG8_STAGE(PG8_SB(0, 1), b2 + hstepB, voffB); PG8_STAGE_A(PG8_SA(0, 0), a2, O2, 0, k2);
            PG8_WAIT_V(8); PG8_WAIT_L(0); PG8_BAR; PG8_MMA(1, 0, At, B0); PG8_MMA(1, 1, At, B1); PG8_BAR; PG8_SCHED;
            PG8_LDB(B0, 1, 0); PG8_LDB(B1, 1, 1); PG8_SCHED; PG8_LDA(At, 1, 0); PG8_STAGE_A(PG8_SA(0, 1), a2, O2, 1, k2);
            PG8_WAIT_V(8); PG8_WAIT_L(0); PG8_BAR; PG8_MMA(0, 0, At, B0); PG8_MMA(0, 1, At, B1); PG8_BAR; PG8_SCHED;
            PG8_LDA(At, 1, 1); PG8_STAGE(PG8_SB(1, 0), b3, voffB); PG8_STAGE(PG8_SB(1, 1), b3 + hstepB, voffB); PG8_STAGE_A(PG8_SA(1, 0), a2, O2, 0, k3);
            PG8_WAIT_V(8); PG8_WAIT_L(0); PG8_BAR; PG8_MMA(1, 0, At, B0); PG8_MMA(1, 1, At, B1); PG8_BAR; PG8_SCHED;
#ifdef STAMP
            if (STAMP == SID * 10 + 5 && t == 0) _d5 = (unsigned)__builtin_amdgcn_s_memtime() - _ti0;
            if (STAMP == SID * 10 + 6 && last) _d5 = (unsigned)__builtin_amdgcn_s_memtime() - _ti1;
#endif
        }
        STAMP_END_PUB(SID * 10 + 2, _tk, sctl, 37, (float)(STAMP_SCALE));
#ifdef STAMP
        if ((STAMP == SID * 10 + 5 || STAMP == SID * 10 + 6) && blockIdx.x == 37 && threadIdx.x == 0) __hip_atomic_store((unsigned*)(sctl + CW_DIAG), __float_as_uint((float)_d5 * (float)(STAMP_SCALE)), RLX_AGENT);
#endif
        STAMP_T0(SID * 10 + 3, _ta);
        if (wr == 0) PG8_BAR;
        STAMP_END_PUB(SID * 10 + 3, _ta, sctl, 37, (float)(STAMP_SCALE)); STAMP_T0(SID * 10 + 4, _tb);
        E(acc, cur, wr, wc, fr, fq);
        asm volatile("" ::: "memory"); STAMP_END_PUB(SID * 10 + 4, _tb, sctl, 37, (float)(STAMP_SCALE)); STAMP_END_PUB(SID * 10 + 1, _tu, sctl, 37, (float)(STAMP_SCALE));
        if (!has_next) break;
#pragma unroll
        for (int a = 0; a < 2; ++a)
#pragma unroll
            for (int b = 0; b < 2; ++b)
#pragma unroll
                for (int m = 0; m < 4; ++m)
#pragma unroll
                    for (int n = 0; n < 2; ++n) acc[a][b][m][n] = (f32x4){0.f, 0.f, 0.f, 0.f};
        cur = nxt; cA = nA; cB = nB; ++ui;
        if constexpr (GATHER) { OA[0] = ON[0]; OA[1] = ON[1]; }
        if (wr == 1) PG8_BAR;
    }
    PG8_WAIT_V(0);
    PG8_BAR;
#undef PG8_SA
#undef PG8_SB
#undef PG8_STAGE
#undef PG8_STAGE_A
#undef PG8_LDA
#undef PG8_LDB
#undef PG8_MMA
#undef PG8_WAIT_V
#undef PG8_WAIT_L
#undef PG8_BAR
#undef PG8_SCHED
#undef PG8_SETUP
}

struct EpiStoreBf16 {
    static constexpr bool PERM = true;
    bf16* O; int ldc;
    __device__ __forceinline__ void operator()(const f32x4 (&acc)[2][2][4][2], const Unit& u, int wr, int wc, int fr, int fq) const {
        const int row0 = u.pm * BM + wr * 64 + fr, col0 = u.pn * BM + wc * 32 + 8 * fq;
#pragma unroll
        for (int ai = 0; ai < 2; ++ai)
#pragma unroll
            for (int m = 0; m < 4; ++m) { bf16* rowp = O + (size_t)(row0 + ai * HALF + m * 16) * ldc + col0;
#pragma unroll
                for (int bj = 0; bj < 2; ++bj) { const f32x4 v0 = acc[ai][bj][m][0], v1 = acc[ai][bj][m][1];
                    v4u w; w.x = cvt_pk_bf16(v0[0], v0[1]); w.y = cvt_pk_bf16(v0[2], v0[3]); w.z = cvt_pk_bf16(v1[0], v1[1]); w.w = cvt_pk_bf16(v1[2], v1[3]);
                    *(v4u*)(rowp + bj * HALF) = w; } }
    }
};

struct EpiPre {
    static constexpr bool PERM = true;
    const bf16* base; bf16* out; int ldc;
    __device__ __forceinline__ void operator()(const f32x4 (&acc)[2][2][4][2], const Unit& u, int wr, int wc, int fr, int fq) const {
        const int row0 = u.pm * BM + wr * 64 + fr, col0 = u.pn * BM + wc * 32 + 8 * fq;
#pragma unroll
        for (int ai = 0; ai < 2; ++ai)
#pragma unroll
            for (int m = 0; m < 4; ++m) { const size_t off = (size_t)(row0 + ai * HALF + m * 16) * ldc + col0;
#pragma unroll
                for (int bj = 0; bj < 2; ++bj) { const v4u bs = *(const v4u*)(base + off + bj * HALF); const f32x4 v0 = acc[ai][bj][m][0], v1 = acc[ai][bj][m][1]; v4u w;
                    w.x = cvt_pk_bf16(fmaf(__uint_as_float(bs.x << 16), ALPHA, v0[0]), fmaf(__uint_as_float(bs.x & 0xffff0000u), ALPHA, v0[1]));
                    w.y = cvt_pk_bf16(fmaf(__uint_as_float(bs.y << 16), ALPHA, v0[2]), fmaf(__uint_as_float(bs.y & 0xffff0000u), ALPHA, v0[3]));
                    w.z = cvt_pk_bf16(fmaf(__uint_as_float(bs.z << 16), ALPHA, v1[0]), fmaf(__uint_as_float(bs.z & 0xffff0000u), ALPHA, v1[1]));
                    w.w = cvt_pk_bf16(fmaf(__uint_as_float(bs.w << 16), ALPHA, v1[2]), fmaf(__uint_as_float(bs.w & 0xffff0000u), ALPHA, v1[3]));
                    *(v4u*)(out + off + bj * HALF) = w; } }
    }
};
struct EpiS5U {
    static constexpr bool PERM = true;
    bf16* UA;
    __device__ __forceinline__ void operator()(const f32x4 (&acc)[2][2][4][2], const Unit& u, int wr, int wc, int fr, int fq) const {
#pragma unroll
        for (int ai = 0; ai < 2; ++ai)
#pragma unroll
            for (int m = 0; m < 4; ++m) { const int tok = u.pm * BM + ai * HALF + wr * 64 + m * 16 + fr; const int b = tok >> 11, l = tok & 2047, ch = l >> 4, tl = l & 15;
#pragma unroll
                for (int bj = 0; bj < 2; ++bj) { const int c0 = u.pn * BM + bj * HALF + wc * 32 + 8 * fq; const int g = c0 >> 4, cc = c0 & 15;
                    const f32x4 v0 = acc[ai][bj][m][0], v1 = acc[ai][bj][m][1];
                    v4u w; w.x = cvt_pk_bf16(v0[0], v0[1]); w.y = cvt_pk_bf16(v0[2], v0[3]); w.z = cvt_pk_bf16(v1[0], v1[1]); w.w = cvt_pk_bf16(v1[2], v1[3]);
                    *(v4u*)(UA + ((size_t)(g * 2048 + b * 128 + ch)) * 384 + tl * 16 + cc) = w; } }
    }
};
struct EpiS5Z {
    static constexpr bool PERM = false;
    float* Z;
    __device__ __forceinline__ void operator()(const f32x4 (&acc)[2][2][4][2], const Unit& u, int wr, int wc, int fr, int fq) const {
#pragma unroll
        for (int ai = 0; ai < 2; ++ai)
#pragma unroll
            for (int m = 0; m < 4; ++m) { float* rowp = Z + (size_t)(u.arow0 + ai * HALF + wr * 64 + m * 16 + fr) * 128 + wc * 32 + 4 * fq;
#pragma unroll
                for (int n = 0; n < 2; ++n) *(f32x4*)(rowp + n * 16) = acc[ai][0][m][n]; }
    }
};
__device__ __forceinline__ float gelu_tanh(float y) { const float z = 0.7978845608028654f * (y + 0.044715f * y * y * y); return y / (1.f + __expf(-2.f * z)); }
struct EpiS5Y {
    static constexpr bool PERM = true;
    bf16* G;
    __device__ __forceinline__ void operator()(const f32x4 (&acc)[2][2][4][2], const Unit& u, int wr, int wc, int fr, int fq) const {
        const int g = u.aux;
#pragma unroll
        for (int ai = 0; ai < 2; ++ai)
#pragma unroll
            for (int m = 0; m < 4; ++m) { const int row = u.pm * BM + ai * HALF + wr * 64 + m * 16 + fr; const int b = row >> 7, ch = row & 127;
#pragma unroll
                for (int bj = 0; bj < 2; ++bj) { const int c0 = bj * HALF + wc * 32 + 8 * fq; const int tl = c0 >> 4, cc = c0 & 15;
                    const f32x4 v0 = acc[ai][bj][m][0], v1 = acc[ai][bj][m][1];
                    v4u w; w.x = cvt_pk_bf16(gelu_tanh(v0[0]), gelu_tanh(v0[1])); w.y = cvt_pk_bf16(gelu_tanh(v0[2]), gelu_tanh(v0[3]));
                    w.z = cvt_pk_bf16(gelu_tanh(v1[0]), gelu_tanh(v1[1])); w.w = cvt_pk_bf16(gelu_tanh(v1[2]), gelu_tanh(v1[3]));
                    *(v4u*)(G + ((size_t)g * NTOK + (b * 2048 + ch * 16 + tl)) * 16 + cc) = w; } }
    }
};
template <int ACT> struct EpiGated {
    static constexpr bool PERM = true;
    bf16* O; int ldc;
    __device__ __forceinline__ void operator()(const f32x4 (&acc)[2][2][4][2], const Unit& u, int wr, int wc, int fr, int fq) const {
        const int col0 = u.pn * HALF + wc * 32 + 8 * fq;
#pragma unroll
        for (int ai = 0; ai < 2; ++ai)
#pragma unroll
            for (int m = 0; m < 4; ++m) { const int row = u.pm * BM + ai * HALF + wr * 64 + m * 16 + fr; float r[8];
#pragma unroll
                for (int n = 0; n < 2; ++n)
#pragma unroll
                    for (int j = 0; j < 4; ++j) { const float v = acc[ai][0][m][n][j], gt = acc[ai][1][m][n][j];
                        r[n * 4 + j] = ACT == 0 ? v / (1.f + __expf(-gt)) : v / (1.f + __expf(-v)) * gt; }
                v4u w; w.x = cvt_pk_bf16(r[0], r[1]); w.y = cvt_pk_bf16(r[2], r[3]); w.z = cvt_pk_bf16(r[4], r[5]); w.w = cvt_pk_bf16(r[6], r[7]);
                *(v4u*)(O + (size_t)row * ldc + col0) = w; }
    }
};
struct S5Order {
    int G, c;
    __device__ bool next(int i, Unit& u) const { const int L = i * G + c; if (L >= 512) return false; const int g = L >> 3, rt = L & 7;
        u.arow0 = g * 2048 + rt * BM; u.brow0 = g * BM; u.pm = rt; u.pn = 0; u.aux = g; u.cnt = BM; u.gather = nullptr; return true; }
};

struct MoeOrder {
    int cnt[NEXP]; const int* list; int G, c;
    __device__ bool next(int i, Unit& u) const { const int L = i * G + c, rt = L >> 2, pn = L & 3; int acc = 0, se = -1, loc = 0, sc = 0;
#pragma unroll
        for (int e = 0; e < NEXP; ++e) { const int ce = cnt[e], nt = (ce + 255) >> 8; if (rt >= acc && rt < acc + nt) { se = e; loc = rt - acc; sc = ce; } acc += nt; }
        if (se < 0) return false;
        u.arow0 = rt * BM; u.brow0 = se * 1024 + pn * BM; u.pm = rt; u.pn = pn; u.aux = se; const int rem = sc - loc * BM; u.cnt = rem < BM ? rem : BM; u.gather = list + se * NTOK + loc * BM; return true; }
};
struct EpiMoeDown {
    static constexpr bool PERM = true;
    const float* tokw; bf16* CB;
    __device__ __forceinline__ void operator()(const f32x4 (&acc)[2][2][4][2], const Unit& u, int wr, int wc, int fr, int fq) const {
        const int col0 = u.pn * BM + wc * 32 + 8 * fq;
#pragma unroll
        for (int ai = 0; ai < 2; ++ai)
#pragma unroll
            for (int m = 0; m < 4; ++m) { const int r = ai * HALF + wr * 64 + m * 16 + fr;
                if (r < u.cnt) { const int ent = u.gather[r]; const int tok = ent >> 1, k = ent & 1; const float w = tokw[ent];
                    bf16* rowp = CB + ((size_t)k * NTOK + tok) * D + col0;
#pragma unroll
                    for (int bj = 0; bj < 2; ++bj) { const f32x4 v0 = acc[ai][bj][m][0] * w, v1 = acc[ai][bj][m][1] * w;
                        v4u o; o.x = cvt_pk_bf16(v0[0], v0[1]); o.y = cvt_pk_bf16(v0[2], v0[3]); o.z = cvt_pk_bf16(v1[0], v1[1]); o.w = cvt_pk_bf16(v1[2], v1[3]);
                        *(v4u*)(rowp + bj * HALF) = o; } } }
    }
};
}
#define XB_TMO      128
#define XB_XCNT(j)  (256  + 64 * (j))
#define XB_XSUB(j)  (1280 + 64 * (j))
#define XB_XGEN(j)  (2304 + 64 * (j))
#define XB_TOP      3328
#define XB_TOPGEN   3392
#define XCD_BAR_WORDS 3456
#define XB_SPIN_CAP (1u << 18)
__device__ __forceinline__ unsigned xb_ld(unsigned* p)              { return __hip_atomic_load(p, __ATOMIC_RELAXED, __HIP_MEMORY_SCOPE_AGENT); }
__device__ __forceinline__ unsigned xb_add(unsigned* p, unsigned v) { return __hip_atomic_fetch_add(p, v, __ATOMIC_RELAXED, __HIP_MEMORY_SCOPE_AGENT); }
__device__ __forceinline__ unsigned xb_xcc_id() { return (unsigned)__builtin_amdgcn_s_getreg((3 << 11) | 20) & 0xFu; }
#define XB_SPIN(cond, bar) do { unsigned _sp = 0; while (cond) { __builtin_amdgcn_s_sleep(1); \
    if ((++_sp & 255u) == 0u) { if (xb_ld(&(bar)[XB_TMO])) break; if (_sp > XB_SPIN_CAP) { atomicAdd(&(bar)[XB_TMO], 1u); break; } } } } while (0)
struct XcdBarrier { unsigned* bar; unsigned x; volatile LAS unsigned* st; };
__device__ __forceinline__ XcdBarrier xcd_barrier_post(unsigned* bar, volatile LAS unsigned* st) {
    XcdBarrier b; b.bar = bar; b.x = xb_xcc_id(); b.st = st;
    if (threadIdx.x == 0) (void)xb_add(&bar[XB_XCNT(b.x)], 1u);
    return b;
}
__device__ __forceinline__ void xcd_barrier_complete(unsigned* bar, unsigned x, unsigned& nloc, unsigned& nx) {
    const unsigned G = gridDim.x * gridDim.y * gridDim.z;
    unsigned sum, cnt, mine, sp = 0u;
    for (;;) {
        sum = 0u; cnt = 0u; mine = 0u;
#pragma unroll
        for (unsigned j = 0; j < 16; ++j) { const unsigned c = xb_ld(&bar[XB_XCNT(j)]); sum += c; cnt += (c > 0u) ? 1u : 0u; mine = (j == x) ? c : mine; }
        if (sum == G) break;
        __builtin_amdgcn_s_sleep(1);
        if ((++sp & 255u) == 0u) { if (xb_ld(&bar[XB_TMO])) break; if (sp > XB_SPIN_CAP) { atomicAdd(&bar[XB_TMO], 1u); break; } }
    }
    nloc = mine > 0u ? mine : 1u; nx = cnt > 0u ? cnt : 1u;
}
__device__ __forceinline__ void xcd_barrier(const XcdBarrier& b) {
    asm volatile("s_waitcnt vmcnt(0)" ::: "memory");
    __syncthreads();
    if (threadIdx.x == 0) {
        unsigned* bar = b.bar;
        __builtin_amdgcn_s_waitcnt(0);
        unsigned nloc = b.st[0], nx = b.st[1];
        if (nloc == 0u) { xcd_barrier_complete(bar, b.x, nloc, nx); b.st[0] = nloc; b.st[1] = nx; }
        const unsigned old = xb_add(&bar[XB_XSUB(b.x)], 1u);
        const unsigned gen = old / nloc;
        if (old + 1u == (gen + 1u) * nloc) {
            __builtin_amdgcn_fence(__ATOMIC_RELEASE, "agent");
            asm volatile("s_waitcnt vmcnt(0)" ::: "memory");
            const unsigned og = xb_add(&bar[XB_TOP], 1u);
            const unsigned tg = og / nx;
            if (og + 1u == (tg + 1u) * nx) xb_add(&bar[XB_TOPGEN], 1u);
            else XB_SPIN(xb_ld(&bar[XB_TOPGEN]) == tg, bar);
            __builtin_amdgcn_fence(__ATOMIC_ACQUIRE, "agent");
            xb_add(&bar[XB_XGEN(b.x)], 1u);
            asm volatile("s_waitcnt vmcnt(0)" ::: "memory");
        } else {
            XB_SPIN(xb_ld(&bar[XB_XGEN(b.x)]) == gen, bar);
            __builtin_amdgcn_fence(__ATOMIC_ACQUIRE, "agent");
            asm volatile("s_waitcnt vmcnt(0)" ::: "memory");
        }
    }
    __syncthreads();
}

constexpr int NWAVES = 8;
constexpr size_t MiB = 1u << 20;
constexpr size_t WS_CTL = 0, CTL_ZERO_BYTES = 1 * MiB;
constexpr size_t WS_WIN = 2 * MiB, WS_WOUT = 8 * MiB, WS_S5IN = 10 * MiB, WS_GLU = 12 * MiB, WS_S5OUT = 16 * MiB, WS_PG = 18 * MiB, WS_MQ = 26 * MiB;
constexpr size_t WS_WGU = 40 * MiB, WS_WD = 104 * MiB;
constexpr size_t WS_XB = 136 * MiB, WS_H = 200 * MiB, WS_MASK = 376 * MiB, WS_O = 384 * MiB, WS_F1 = 448 * MiB, WS_END = 512 * MiB;
constexpr int CW_TMO = 0, CW_CODE = 1, CW_CNT = 2048  , CW_BAR = 4096;
constexpr size_t WS_TOKPOS = 768 * 1024  ;
constexpr size_t WS_TOKW = 512 * 1024  , WS_LIST = 38 * MiB  ;
constexpr size_t WS_HMID = 200 * MiB  , WS_CB = 268 * MiB  ;
constexpr int RING_OFF = 0, RING_BYTES = 131072, LDS_BYTES = 147456, LDSCTL_OFF = LDS_BYTES - 512, MISC_OFF = LDSCTL_OFF + 320;

struct Frame {
    LAS unsigned char* lds; volatile LAS unsigned* MISC; gu32* ctl;
    int tid, lane, wave, vcu, G;
};
struct Args { const float* in[30]; float* out; unsigned char* ws; int ph_lo, ph_hi, li, pad; };

__device__ __forceinline__ void tr_item(const float* __restrict__ W, int ldw, bf16* WT, int ldt, int k0, int c0, int nc, int r0, LAS float* scr, int lane) {
    f32x4 v[8];
#pragma unroll
    for (int i = 0; i < 8; ++i) { const int idx = lane + 64 * i, kk = idx >> 3, c4 = (idx & 7) * 4; v[i] = (c4 < nc) ? *(const GAS f32x4*)(W + (size_t)(k0 + kk) * ldw + c0 + c4) : (f32x4){0.f, 0.f, 0.f, 0.f}; }
#pragma unroll
    for (int i = 0; i < 8; ++i) { const int idx = lane + 64 * i, kk = idx >> 3, c4 = (idx & 7) * 4; LAS float* s = scr + kk * 33 + c4; s[0] = v[i].x; s[1] = v[i].y; s[2] = v[i].z; s[3] = v[i].w; }
    LDS_WAIT(); asm volatile("" ::: "memory");
    const int c = lane & 7;
#pragma unroll
    for (int j = 0; j < 4; ++j) { const int n = (lane >> 3) + 8 * j; const LAS float* s = scr + (8 * c) * 33 + n;
        v4u o; o.x = pk2(s[0 * 33], s[1 * 33]); o.y = pk2(s[2 * 33], s[3 * 33]); o.z = pk2(s[4 * 33], s[5 * 33]); o.w = pk2(s[6 * 33], s[7 * 33]);
        if (n < nc) *(GAS v4u*)(WT + (size_t)(r0 + n) * ldt + k0 + 8 * c) = o; }
    LDS_WAIT(); asm volatile("" ::: "memory");
}

struct TrDesc { const float* W; int ldw; bf16* WT; int ldt, k0, c0, nc, r0; };
__device__ __forceinline__ void tr_load(const TrDesc& d, f32x4 (&v)[8], int lane) {
#pragma unroll
    for (int i = 0; i < 8; ++i) { const int idx = lane + 64 * i, kk = idx >> 3, c4 = (idx & 7) * 4; v[i] = (c4 < d.nc) ? __builtin_nontemporal_load((const GAS f32x4*)(d.W + (size_t)(d.k0 + kk) * d.ldw + d.c0 + c4)) : (f32x4){0.f, 0.f, 0.f, 0.f}; }
}
__device__ __forceinline__ void tr_store(const TrDesc& d, const f32x4 (&v)[8], LAS float* scr, int lane) {
#pragma unroll
    for (int i = 0; i < 8; ++i) { const int idx = lane + 64 * i, kk = idx >> 3, c4 = (idx & 7) * 4; LAS float* s = scr + kk * 33 + c4; s[0] = v[i].x; s[1] = v[i].y; s[2] = v[i].z; s[3] = v[i].w; }
    LDS_WAIT(); asm volatile("" ::: "memory");
    const int c = lane & 7;
#pragma unroll
    for (int j = 0; j < 4; ++j) { const int n = (lane >> 3) + 8 * j; const LAS float* s = scr + (8 * c) * 33 + n;
        v4u o; o.x = pk2(s[0 * 33], s[1 * 33]); o.y = pk2(s[2 * 33], s[3 * 33]); o.z = pk2(s[4 * 33], s[5 * 33]); o.w = pk2(s[6 * 33], s[7 * 33]);
        if (n < d.nc) *(GAS v4u*)(d.WT + (size_t)(d.r0 + n) * d.ldt + d.k0 + 8 * c) = o; }
    LDS_WAIT(); asm volatile("" ::: "memory");
}
__device__ __forceinline__ int tr_seg_items(int K, int ncols) { return (K / 64) * ((ncols + 31) / 32); }
__device__ __forceinline__ void tr_seg(const float* W, int ldw, int K, int c0, int ncols, bf16* WT, int ldt, int r0, int it, LAS float* scr, int lane) {
    const int nblk = (ncols + 31) / 32, kb = it / nblk, nb = it % nblk; const int rem = ncols - nb * 32;
    tr_item(W, ldw, WT, ldt, kb * 64, c0 + nb * 32, rem < 32 ? rem : 32, r0 + nb * 32, scr, lane);
}
constexpr size_t WS_UPD = WS_F1, WS_DEC = WS_LIST;
constexpr size_t OUT_SPREV = 16 * MiB, OUT_OI = 48 * MiB;
constexpr int GP = 72;
#define MFMA32(a, b, c) __builtin_amdgcn_mfma_f32_32x32x16_bf16((a), (b), (c), 0, 0, 0)
__device__ __forceinline__ int crow(int reg, int h) { return (reg & 3) + 8 * (reg >> 2) + 4 * h; }
__device__ __forceinline__ f32x16 mma_tile64(const LAS bf16* A, const LAS bf16* Bt, int lane) {
    const int r = lane & 31, h = lane >> 5; f32x16 acc;
#pragma unroll
    for (int i = 0; i < 16; ++i) acc[i] = 0.f;
#pragma unroll
    for (int kk = 0; kk < 4; ++kk) { const bf16x8 a = *(const LAS bf16x8*)(A + r * GP + kk * 16 + 8 * h), b = *(const LAS bf16x8*)(Bt + r * GP + kk * 16 + 8 * h); acc = MFMA32(a, b, acc); }
    return acc;
}
constexpr int GLA1_HALF = 71168;
__device__ __forceinline__ void gla1_pair(Frame& F, const Args& a, int unit0) {
    const int hw = F.wave >> 2, wl = F.wave & 3, lt = F.tid & 255, lane = F.lane, unit = unit0 + hw;
    const int b = unit >> 7, n = (unit >> 2) & 31, h = unit & 3;
    const size_t tok0 = (size_t)b * SEQ + n * 64;
    const bf16* H = (const bf16*)(a.ws + WS_H);
    LAS unsigned char* L = F.lds + RING_OFF + hw * GLA1_HALF;
    LAS float* CUM = (LAS float*)L;
    LAS bf16* P = (LAS bf16*)L;
    LAS bf16* QD = (LAS bf16*)(L + 16640);
    LAS bf16* KI = (LAS bf16*)(L + 25856);
    LAS bf16* KET = (LAS bf16*)(L + 35072);
    LAS bf16* VT = (LAS bf16*)(L + 44288);
    LAS float* GW = (LAS float*)(L + 62720);
    LAS float* GB = (LAS float*)(L + 66816);
    LAS float* BG = (LAS float*)(L + 67072);
    const float* gw2 = a.in[3]; const float* gb = a.in[4];
#pragma unroll
    for (int k = 0; k < 4; ++k) { const int i = lt + 256 * k; GW[i] = gw2[(i >> 6) * 256 + h * 64 + (i & 63)]; BG[i] = bf2f(H[(tok0 + (i >> 4)) * HP + HC_BG + (i & 15)]); }
    if (lt < 64) GB[lt] = gb[h * 64 + lt];
    v4u qv[2], kv[2], vv[4];
#pragma unroll
    for (int k = 0; k < 2; ++k) { const int idx = lt + 256 * k, t = idx >> 3, d8 = (idx & 7) * 8; qv[k] = *(const GAS v4u*)(H + (tok0 + t) * HP + HC_BQ + h * 64 + d8); kv[k] = *(const GAS v4u*)(H + (tok0 + t) * HP + HC_BK + h * 64 + d8); }
#pragma unroll
    for (int k = 0; k < 4; ++k) { const int idx = lt + 256 * k, j = idx & 63, e8 = (idx >> 6) * 8; vv[k] = *(const GAS v4u*)(H + (tok0 + j) * HP + HC_BV + h * 128 + e8); }
    __syncthreads();
#pragma unroll 4
    for (int k = 0; k < 16; ++k) { const int idx = lt + 256 * k, t = idx >> 6, d = idx & 63; float z = GB[d];
#pragma unroll
        for (int r = 0; r < 16; ++r) z = fmaf(BG[t * 16 + r], GW[r * 64 + d], z);
        const float ls = -(fmaxf(-z, 0.f) + __logf(1.f + __expf(-fabsf(z)))); CUM[t * 65 + d] = ls * (1.f / 16.f); }
    __syncthreads();
    LAS float* OFF = GW;
    { const int seg = lt >> 6, d = lt & 63; float run = 0.f;
#pragma unroll
      for (int k = 0; k < 16; ++k) { const int t = 16 * seg + k; run += CUM[t * 65 + d]; CUM[t * 65 + d] = run; } }
    __syncthreads();
    { const int seg = lt >> 6, d = lt & 63; float off = 0.f;
#pragma unroll
      for (int s2 = 0; s2 < 3; ++s2) if (s2 < seg) off += CUM[(16 * s2 + 15) * 65 + d];
      OFF[seg * 64 + d] = off; }
    __syncthreads();
    bf16* QG = (bf16*)a.out;
#pragma unroll
    for (int k = 0; k < 2; ++k) { const int idx = lt + 256 * k, t = idx >> 3, d8 = (idx & 7) * 8; unsigned qo[4], ko[4]; const unsigned qw[4] = {qv[k].x, qv[k].y, qv[k].z, qv[k].w}, kw[4] = {kv[k].x, kv[k].y, kv[k].z, kv[k].w};
#pragma unroll
        for (int p2 = 0; p2 < 4; ++p2) { float qd[2], ki[2];
#pragma unroll
            for (int s = 0; s < 2; ++s) { const int d = d8 + 2 * p2 + s; const float c = CUM[t * 65 + d] + OFF[(t >> 4) * 64 + d], last = CUM[63 * 65 + d] + OFF[3 * 64 + d];
                const float q = (s ? __uint_as_float(qw[p2] & 0xffff0000u) : __uint_as_float(qw[p2] << 16)) * 0.125f, kk = s ? __uint_as_float(kw[p2] & 0xffff0000u) : __uint_as_float(kw[p2] << 16);
                qd[s] = q * __expf(c); ki[s] = kk * __expf(-c); KET[d * GP + t] = (bf16)f2bf(kk * __expf(last - c)); }
            qo[p2] = cvt2bf(qd[0], qd[1]); ko[p2] = cvt2bf(ki[0], ki[1]); }
        const v4u qq = (v4u){qo[0], qo[1], qo[2], qo[3]}; *(LAS v4u*)(QD + t * GP + d8) = qq; *(GAS v4u*)(QG + (tok0 + t) * 256 + h * 64 + d8) = qq; *(LAS v4u*)(KI + t * GP + d8) = (v4u){ko[0], ko[1], ko[2], ko[3]}; }
    if (lt < 64) ((float*)(a.ws + WS_DEC))[unit * 64 + lt] = __expf(CUM[63 * 65 + lt] + OFF[3 * 64 + lt]);
#pragma unroll
    for (int k = 0; k < 4; ++k) { const int idx = lt + 256 * k, j = idx & 63, e8 = (idx >> 6) * 8; const v4u v = vv[k];
        VT[(e8 + 0) * GP + j] = (bf16)(v.x & 0xffff); VT[(e8 + 1) * GP + j] = (bf16)(v.x >> 16); VT[(e8 + 2) * GP + j] = (bf16)(v.y & 0xffff); VT[(e8 + 3) * GP + j] = (bf16)(v.y >> 16);
        VT[(e8 + 4) * GP + j] = (bf16)(v.z & 0xffff); VT[(e8 + 5) * GP + j] = (bf16)(v.z >> 16); VT[(e8 + 6) * GP + j] = (bf16)(v.w & 0xffff); VT[(e8 + 7) * GP + j] = (bf16)(v.w >> 16); }
    __syncthreads();
    { const int ti = wl >> 1, tj = wl & 1, nn = lane & 31, hh = lane >> 5;
        if (tj <= ti) { const f32x16 c = mma_tile64(QD + 32 * ti * GP, KI + 32 * tj * GP, lane);
#pragma unroll
            for (int i = 0; i < 16; ++i) { const int qi = 32 * ti + crow(i, hh), kj = 32 * tj + nn; P[qi * GP + kj] = (bf16)f2bf(kj <= qi ? c[i] : 0.f); } }
        else {
#pragma unroll
            for (int i = 0; i < 16; ++i) P[(32 * ti + crow(i, hh)) * GP + 32 * tj + nn] = (bf16)0; } }
    __syncthreads();
    bf16* oi = (bf16*)((unsigned char*)a.out + OUT_OI); float* up = (float*)(a.ws + WS_UPD) + (size_t)unit * 8192;
#pragma unroll
    for (int k = 0; k < 2; ++k) { const int tile = wl * 2 + k, nn = lane & 31, hh = lane >> 5;
      { const int ti = tile >> 2, te = tile & 3;
        const f32x16 c = mma_tile64(P + 32 * ti * GP, VT + 32 * te * GP, lane);
#pragma unroll
        for (int i = 0; i < 16; ++i) oi[(tok0 + 32 * ti + crow(i, hh)) * 512 + h * 128 + 32 * te + nn] = (bf16)f2bf(c[i]); }
      { const int te = tile >> 1, td = tile & 1;
        const f32x16 c = mma_tile64(VT + 32 * te * GP, KET + 32 * td * GP, lane);
#pragma unroll
        for (int i = 0; i < 16; ++i) up[(32 * te + crow(i, hh)) * 64 + 32 * td + nn] = c[i]; } }
    __syncthreads();
}
__device__ __forceinline__ void gla2_scan(Frame& F, const Args& a) {
    const float* UPD = (const float*)(a.ws + WS_UPD); const float* DEC = (const float*)(a.ws + WS_DEC); bf16* SP = (bf16*)((unsigned char*)a.out + OUT_SPREV);
    for (int x = F.vcu * (NWAVES * 64) + F.tid; x < BATCH * 4 * 128 * 16; x += F.G * NWAVES * 64) {
        const int d4 = (x & 15) * 4, e = (x >> 4) & 127, bh = x >> 11, b = bh >> 2, h = bh & 3; f32x4 S = (f32x4){0.f, 0.f, 0.f, 0.f};
        for (int n0 = 0; n0 < 32; n0 += 8) { f32x4 u[8], dc[8];
#pragma unroll
            for (int k = 0; k < 8; ++k) { const int unit = b * 128 + (n0 + k) * 4 + h; u[k] = *(const GAS f32x4*)(UPD + (size_t)unit * 8192 + e * 64 + d4); dc[k] = *(const GAS f32x4*)(DEC + unit * 64 + d4); }
#pragma unroll
            for (int k = 0; k < 8; ++k) { const int unit = b * 128 + (n0 + k) * 4 + h; v2u o; o.x = pk2(S.x, S.y); o.y = pk2(S.z, S.w); *(GAS v2u*)(SP + (size_t)unit * 8192 + e * 64 + d4) = o; S = dc[k] * S + u[k]; } } }
}
constexpr int GLA3_HALF = 61440;
__device__ __forceinline__ void gla3_pair(Frame& F, const Args& a, int unit0) {
    const int hw = F.wave >> 2, wl = F.wave & 3, lt = F.tid & 255, lane = F.lane, unit = unit0 + hw;
    const int b = unit >> 7, n = (unit >> 2) & 31, h = unit & 3;
    const size_t tok0 = (size_t)b * SEQ + n * 64;
    const bf16* H = (const bf16*)(a.ws + WS_H); const bf16* SP = (const bf16*)((const unsigned char*)a.out + OUT_SPREV) + (size_t)unit * 8192; const bf16* oi = (const bf16*)((const unsigned char*)a.out + OUT_OI);
    LAS unsigned char* L = F.lds + RING_OFF + hw * GLA3_HALF;
    LAS bf16* QD = (LAS bf16*)L;
    LAS bf16* ST = (LAS bf16*)(L + 9216);
    LAS float* OF = (LAS float*)(L + 27648);
    const int nn = lane & 31, hh = lane >> 5;
    v4u qreg[2], sreg[4]; bf16 oiv[2][16]; unsigned short brv[16][2];
#pragma unroll
    for (int k = 0; k < 2; ++k) { const int idx = lt + 256 * k, t = idx >> 3, d8 = (idx & 7) * 8; qreg[k] = *(const GAS v4u*)((const bf16*)a.out + (tok0 + t) * 256 + h * 64 + d8); }
#pragma unroll
    for (int k = 0; k < 4; ++k) { const int idx = lt + 256 * k, e = idx >> 3, d8 = (idx & 7) * 8; sreg[k] = *(const GAS v4u*)(SP + e * 64 + d8); }
#pragma unroll
    for (int k = 0; k < 2; ++k) { const int tile = wl * 2 + k, ti = tile >> 2, te = tile & 3;
#pragma unroll
        for (int i = 0; i < 16; ++i) oiv[k][i] = oi[(tok0 + 32 * ti + crow(i, hh)) * 512 + h * 128 + 32 * te + nn]; }
#pragma unroll
    for (int rr = 0; rr < 16; ++rr) { const bf16* br = H + (tok0 + wl * 16 + rr) * HP + HC_BR + h * 128; brv[rr][0] = br[lane]; brv[rr][1] = br[lane + 64]; }
    const float* ng = a.in[5]; const float ng0 = ng[h * 128 + lane], ng1 = ng[h * 128 + lane + 64];
#pragma unroll
    for (int k = 0; k < 2; ++k) { const int idx = lt + 256 * k, t = idx >> 3, d8 = (idx & 7) * 8; *(LAS v4u*)(QD + t * GP + d8) = qreg[k]; }
#pragma unroll
    for (int k = 0; k < 4; ++k) { const int idx = lt + 256 * k, e = idx >> 3, d8 = (idx & 7) * 8; *(LAS v4u*)(ST + e * GP + d8) = sreg[k]; }
    __syncthreads();
#pragma unroll
    for (int k = 0; k < 2; ++k) { const int tile = wl * 2 + k, ti = tile >> 2, te = tile & 3;
      const f32x16 c = mma_tile64(QD + 32 * ti * GP, ST + 32 * te * GP, lane);
#pragma unroll
      for (int i = 0; i < 16; ++i) { const int r = 32 * ti + crow(i, hh), e = 32 * te + nn; OF[r * 132 + e] = c[i] + bf2f(oiv[k][i]); } }
    __syncthreads();
    bf16* O = (bf16*)(a.ws + WS_O);
#pragma unroll
    for (int rr = 0; rr < 16; ++rr) { const int r = wl * 16 + rr; const float x0 = OF[r * 132 + lane], x1 = OF[r * 132 + lane + 64];
        const float mean = wsum(x0 + x1) * (1.f / 128.f), d0 = x0 - mean, d1 = x1 - mean, var = wsum(d0 * d0 + d1 * d1) * (1.f / 128.f), rs = 1.f / sqrtf(var + LN_EPS);
        const float r0 = bf2f(brv[rr][0]), r1 = bf2f(brv[rr][1]);
        bf16* o = O + (tok0 + r) * D + 512 + h * 128;
        o[lane] = (bf16)f2bf(d0 * rs * ng0 * (r0 / (1.f + __expf(-r0)))); o[lane + 64] = (bf16)f2bf(d1 * rs * ng1 * (r1 / (1.f + __expf(-r1)))); }
    __syncthreads();
}
constexpr int SCP = 2048 + 16;
__device__ __forceinline__ unsigned fkey(float f) { const unsigned u = __float_as_uint(f); return (u & 0x80000000u) ? ~u : (u | 0x80000000u); }
__device__ __forceinline__ int wave_sum_dpp(int x) {
    x += __builtin_amdgcn_update_dpp(0, x, 0xB1, 0xF, 0xF, true);
    x += __builtin_amdgcn_update_dpp(0, x, 0x4E, 0xF, 0xF, true);
    x += __builtin_amdgcn_update_dpp(0, x, 0x141, 0xF, 0xF, true);
    x += __builtin_amdgcn_update_dpp(0, x, 0x140, 0xF, 0xF, true);
    x += __builtin_amdgcn_update_dpp(0, x, 0x142, 0xA, 0xF, false);
    x += __builtin_amdgcn_update_dpp(0, x, 0x143, 0xC, 0xF, false);
    return __builtin_amdgcn_readlane(x, 63);
}
#define CNT4(OP, a0, a1, a2, a3, k0, k1, k2, k3, c) do { unsigned long long _m0, _m1, _m2, _m3; \
    asm volatile("v_cmp_" OP "_u32_e64 %4, %8, %12\n\tv_cmp_" OP "_u32_e64 %5, %9, %12\n\tv_cmp_" OP "_u32_e64 %6, %10, %12\n\tv_cmp_" OP "_u32_e64 %7, %11, %12\n\t" \
                 "v_addc_co_u32_e64 %0, %4, 0, %0, %4\n\tv_addc_co_u32_e64 %1, %5, 0, %1, %5\n\tv_addc_co_u32_e64 %2, %6, 0, %2, %6\n\tv_addc_co_u32_e64 %3, %7, 0, %3, %7" \
                 : "+v"(a0), "+v"(a1), "+v"(a2), "+v"(a3), "=&s"(_m0), "=&s"(_m1), "=&s"(_m2), "=&s"(_m3) : "v"(k0), "v"(k1), "v"(k2), "v"(k3), "v"(c)); } while (0)
template <int NCH> __device__ __forceinline__ unsigned topk_search(const unsigned (&key)[32], bool& exact) {
    unsigned K = 0u; exact = false;
#pragma unroll 1
    for (int bit = 31; bit >= 0; --bit) { const unsigned cand = K | (1u << bit); int a0 = 0, a1 = 0, a2 = 0, a3 = 0;
#pragma unroll
        for (int c = 0; c < NCH; ++c) CNT4("ge", a0, a1, a2, a3, key[4 * c], key[4 * c + 1], key[4 * c + 2], key[4 * c + 3], cand);
        const int cnt = wave_sum_dpp((a0 + a1) + (a2 + a3));
        if (cnt >= 256) { K = cand; if (cnt == 256) { exact = true; break; } } }
    return K;
}
template <int NCH> __device__ __forceinline__ int count_gt(const unsigned (&key)[32], unsigned K) { int a0 = 0, a1 = 0, a2 = 0, a3 = 0;
#pragma unroll
    for (int c = 0; c < NCH; ++c) CNT4("gt", a0, a1, a2, a3, key[4 * c], key[4 * c + 1], key[4 * c + 2], key[4 * c + 3], K);
    return wave_sum_dpp((a0 + a1) + (a2 + a3)); }
struct Dsa1Ops { bf16x8 af[4][2]; float wq[4][4]; };
__device__ __forceinline__ void dsa1_load(Frame& F, const Args& a, int b, int qt, Dsa1Ops& o) {
    const int lane = F.lane, fr = lane & 15, fq = lane >> 4, t0 = qt * 16;
    const bf16* H = (const bf16*)(a.ws + WS_H) + (size_t)b * SEQ * HP;
#pragma unroll
    for (int qg = 0; qg < 4; ++qg) {
#pragma unroll
        for (int kk = 0; kk < 2; ++kk) o.af[qg][kk] = *(const GAS bf16x8*)(H + (size_t)(t0 + qg * 4 + (fr >> 2)) * HP + HC_IQ + (fr & 3) * 64 + kk * 32 + fq * 8);
        const v2u wv = *(const GAS v2u*)(H + (size_t)(t0 + qg * 4 + fq) * HP + HC_IW);
        o.wq[qg][0] = __uint_as_float(wv.x << 16); o.wq[qg][1] = __uint_as_float(wv.x & 0xffff0000u); o.wq[qg][2] = __uint_as_float(wv.y << 16); o.wq[qg][3] = __uint_as_float(wv.y & 0xffff0000u); }
}
__device__ __forceinline__ void dsa1_unit(Frame& F, const Args& a, int b, int qt, Dsa1Ops& cur, int nb, int nqt) {
    const int lane = F.lane, w = F.wave, fr = lane & 15, fq = lane >> 4, t0 = qt * 16;
    const bf16* H = (const bf16*)(a.ws + WS_H) + (size_t)b * SEQ * HP;
    LAS float* SC = (LAS float*)(F.lds + RING_OFF);
    const int nkb = qt + 1, nmine = (nkb - w + 7) >> 3;
    STAMP_T0(210, _t210);
    LAS unsigned* SK = (LAS unsigned*)SC;
    bf16x8 bA[4][2], bB[4][2];
#define DSA1_LOADB(dst, i0) do { _Pragma("unroll") for (int u = 0; u < 4; ++u) if ((i0) + u < nmine) { const int kb = w + 8 * ((i0) + u); \
        _Pragma("unroll") for (int kk = 0; kk < 2; ++kk) dst[u][kk] = *(const GAS bf16x8*)(H + (size_t)(kb * 16 + fr) * HP + HC_IK + kk * 32 + fq * 8); } } while (0)
#define DSA1_MMAB(src, i0) do { _Pragma("unroll") for (int u = 0; u < 4; ++u) if ((i0) + u < nmine) { const int kb = w + 8 * ((i0) + u), s = kb * 16 + fr; \
        _Pragma("unroll") for (int qg = 0; qg < 4; ++qg) { f32x4 c = (f32x4){0.f, 0.f, 0.f, 0.f}; \
            c = __builtin_amdgcn_mfma_f32_16x16x32_bf16(cur.af[qg][0], src[u][0], c, 0, 0, 0); c = __builtin_amdgcn_mfma_f32_16x16x32_bf16(cur.af[qg][1], src[u][1], c, 0, 0, 0); \
            float sc = 0.f; _Pragma("unroll") for (int i = 0; i < 4; ++i) sc += cur.wq[qg][i] * fmaxf(c[i], 0.f); \
            SK[(qg * 4 + fq) * SCP + s] = (s <= t0 + qg * 4 + fq) ? fkey(sc) : 0u; } } } while (0)
    DSA1_LOADB(bA, 0);
#pragma unroll 1
    for (int i0 = 0; i0 < nmine; i0 += 8) {
        DSA1_LOADB(bB, i0 + 4); DSA1_MMAB(bA, i0);
        DSA1_LOADB(bA, i0 + 8); DSA1_MMAB(bB, i0 + 4);
    }
#undef DSA1_LOADB
#undef DSA1_MMAB
    __syncthreads();
    STAMP_END_PUB(210, _t210, F.ctl, 37, (float)(STAMP_SCALE)); STAMP_T0(211, _t211);
    if (nb >= 0) dsa1_load(F, a, nb, nqt, cur);
    unsigned long long* MASK = (unsigned long long*)(a.ws + WS_MASK);
    for (int _rp = 0; _rp < (PROBE == 23 ? 2 : 1); ++_rp)
#pragma unroll 1
    for (int rr = 0; rr < 2; ++rr) { const int r = w + 8 * rr, t = t0 + r, jmax = t >> 6, nch = (jmax >> 2) + 1;
        STAMP_T0(212, _t212);
        unsigned key[32];
#pragma unroll
        for (int c = 0; c < 8; ++c) {
            if (c < nch) {
#pragma unroll
                for (int jj = 0; jj < 4; ++jj) { const int s = (c * 4 + jj) * 64 + lane; const unsigned kv = SK[r * SCP + s]; key[c * 4 + jj] = (s <= t) ? kv : 0u; } }
            else {
#pragma unroll
                for (int jj = 0; jj < 4; ++jj) key[c * 4 + jj] = 0u; } }
        STAMP_END_PUB(212, _t212, F.ctl, 37, (float)(STAMP_SCALE));
        unsigned long long mine = 0ull;
        if (t < 256) {
#pragma unroll
            for (int j = 0; j < 4; ++j) { const unsigned long long bm = __ballot(j * 64 + lane <= t); if (lane == j) mine = bm; }
        } else {
            unsigned K; bool exact; int cgt = 0;
            STAMP_T0(213, _t213);
            switch (nch) {
                case 1: K = topk_search<1>(key, exact); if (!exact) cgt = count_gt<1>(key, K); break;
                case 2: K = topk_search<2>(key, exact); if (!exact) cgt = count_gt<2>(key, K); break;
                case 3: K = topk_search<3>(key, exact); if (!exact) cgt = count_gt<3>(key, K); break;
                case 4: K = topk_search<4>(key, exact); if (!exact) cgt = count_gt<4>(key, K); break;
                case 5: K = topk_search<5>(key, exact); if (!exact) cgt = count_gt<5>(key, K); break;
                case 6: K = topk_search<6>(key, exact); if (!exact) cgt = count_gt<6>(key, K); break;
                case 7: K = topk_search<7>(key, exact); if (!exact) cgt = count_gt<7>(key, K); break;
                default: K = topk_search<8>(key, exact); if (!exact) cgt = count_gt<8>(key, K); break;
            }
            STAMP_END_PUB(213, _t213, F.ctl, 37, (float)(STAMP_SCALE)); STAMP_T0(214, _t214);
            const int quota = 256 - cgt; int taken = 0; unsigned mlo = 0u, mhi = 0u;
#pragma unroll
            for (int j = 0; j < 32; ++j) if (j <= jmax) {
                unsigned long long bm;
                if (exact) bm = __ballot(key[j] >= K);
                else { const unsigned long long eq = __ballot(key[j] == K); const int pre = __builtin_amdgcn_mbcnt_hi((unsigned)(eq >> 32), __builtin_amdgcn_mbcnt_lo((unsigned)eq, 0u));
                       bm = __ballot(key[j] > K || (key[j] == K && taken + pre < quota)); taken += __builtin_popcountll(eq); }
                asm volatile("v_writelane_b32 %0, %2, %4\n\tv_writelane_b32 %1, %3, %4" : "+v"(mlo), "+v"(mhi) : "s"((unsigned)bm), "s"((unsigned)(bm >> 32)), "n"(j)); }
            mine = ((unsigned long long)mhi << 32) | mlo;
            STAMP_END_PUB(214, _t214, F.ctl, 37, (float)(STAMP_SCALE));
        }
        if (lane < 32) MASK[((size_t)b * SEQ + t) * 32 + lane] = mine; }
    STAMP_END_PUB(211, _t211, F.ctl, 37, (float)(STAMP_SCALE));
    __syncthreads();
}

constexpr float LOG2E = 1.4426950408889634f, SCL2 = 0.125f * 1.4426950408889634f;
__device__ __forceinline__ bf16x8 pack_step(const f32x16& x, int s) {
    v4u p;
    asm volatile("v_cvt_pk_bf16_f32 %0, %4, %5\n\tv_cvt_pk_bf16_f32 %1, %6, %7\n\tv_cvt_pk_bf16_f32 %2, %8, %9\n\tv_cvt_pk_bf16_f32 %3, %10, %11\n\ts_nop 1"
                 : "=&v"(p[0]), "=&v"(p[1]), "=&v"(p[2]), "=&v"(p[3])
                 : "v"(x[8 * s]), "v"(x[8 * s + 1]), "v"(x[8 * s + 2]), "v"(x[8 * s + 3]), "v"(x[8 * s + 4]), "v"(x[8 * s + 5]), "v"(x[8 * s + 6]), "v"(x[8 * s + 7]));
    return __builtin_bit_cast(bf16x8, p);
}
__device__ __forceinline__ void dsa2_unit(Frame& F, const Args& a, int b, int g, int qb) {
    const int tid = F.tid, lane = F.lane, w = F.wave, n = lane & 31, h = lane >> 5, hl = w >> 1, hh = g * 4 + hl, t0 = qb * 64, tq0 = t0 + 32 * (w & 1);
    const bf16* H = (const bf16*)(a.ws + WS_H) + (size_t)b * SEQ * HP;
    const unsigned long long* MW = (const unsigned long long*)(a.ws + WS_MASK) + ((size_t)b * SEQ + tq0 + n) * 32;
    LAS unsigned char* L = F.lds + RING_OFF;
    LAS float* BT = (LAS float*)(L + 55296);
    LAS bf16* OS = (LAS bf16*)(L + 57344 + w * 4608);
    const float* relb = a.in[1];
    BT[tid] = relb[T5B[tid & 127] * 8 + g * 4 + (tid >> 7)] * LOG2E;
    const float B31 = relb[31 * 8 + hh] * LOG2E;
    bf16x8 Qf[4];
#pragma unroll
    for (int kk = 0; kk < 4; ++kk) Qf[kk] = *(const GAS bf16x8*)(H + (size_t)(tq0 + n) * HP + HC_AQ + hh * 64 + kk * 16 + 8 * h);
    f32x16 O[2];
#pragma unroll
    for (int i = 0; i < 16; ++i) { O[0][i] = 0.f; O[1][i] = 0.f; }
    float m = -1e30f, lsum = 0.f;
    const int krow = tid >> 3, kc8 = (tid & 7) * 8, vrow = tid & 63, vc8 = (tid >> 6) * 8, nt = qb + 1;
    v4u kreg, vreg;
#define DSA_LOADT(kt) do { kreg = *(const GAS v4u*)(H + (size_t)((kt) * 64 + krow) * HP + HC_AK + g * 64 + kc8); vreg = *(const GAS v4u*)(H + (size_t)((kt) * 64 + vrow) * HP + HC_AV + g * 64 + vc8); } while (0)
#define DSA_WRITET(bu) do { LAS bf16* _ks = (LAS bf16*)(L + (bu) * 18432); LAS bf16* _vt = (LAS bf16*)(L + (bu) * 18432 + 9216); *(LAS v4u*)(_ks + krow * GP + kc8) = kreg; \
        _vt[(vc8 + 0) * GP + vrow] = (bf16)(vreg.x & 0xffff); _vt[(vc8 + 1) * GP + vrow] = (bf16)(vreg.x >> 16); _vt[(vc8 + 2) * GP + vrow] = (bf16)(vreg.y & 0xffff); _vt[(vc8 + 3) * GP + vrow] = (bf16)(vreg.y >> 16); \
        _vt[(vc8 + 4) * GP + vrow] = (bf16)(vreg.z & 0xffff); _vt[(vc8 + 5) * GP + vrow] = (bf16)(vreg.z >> 16); _vt[(vc8 + 6) * GP + vrow] = (bf16)(vreg.w & 0xffff); _vt[(vc8 + 7) * GP + vrow] = (bf16)(vreg.w >> 16); } while (0)
#define DSA_QK(Sd, bu) do { const LAS bf16* _ks = (const LAS bf16*)(L + (bu) * 18432); _Pragma("unroll") for (int sb = 0; sb < 2; ++sb) { _Pragma("unroll") for (int i = 0; i < 16; ++i) Sd[sb][i] = 0.f; \
        _Pragma("unroll") for (int kk = 0; kk < 4; ++kk) { const bf16x8 ka = *(const LAS bf16x8*)(_ks + (32 * sb + n) * GP + kk * 16 + 8 * h); Sd[sb] = MFMA32(ka, Qf[kk], Sd[sb]); } } } while (0)
    DSA_LOADT(0); DSA_WRITET(0);
    if (nt > 1) { DSA_LOADT(1); DSA_WRITET(1); }
    if (nt > 2) DSA_LOADT(2);
    unsigned long long mw = MW[0];
    __syncthreads();
#define DSA_MASK(p, wsh, pos) do { int _t; asm volatile("v_bfe_i32 %1, %2, %3, 1\n\tv_and_b32 %0, %0, %1" : "+v"(p), "=&v"(_t) : "v"(wsh), "n"(pos)); } while (0)
#define DSA_TILE(Sc, Sn, kt) do { STAMP_BEGIN(1); STAMP_BEGIN(2); \
        const int s1 = slot == 2 ? 0 : slot + 1, s2 = s1 == 2 ? 0 : s1 + 1; \
        if ((kt) + 2 < nt) DSA_WRITET(s2); \
        if ((kt) + 3 < nt) DSA_LOADT((kt) + 3); \
        const unsigned long long mwn = ((kt) + 1 < nt) ? MW[(kt) + 1] : 0ull; \
        if ((kt) + 1 < nt) DSA_QK(Sn, s1); \
        STAMP_END(2); STAMP_BEGIN(3); \
        const LAS bf16* VT = (const LAS bf16*)(L + slot * 18432 + 9216); \
        const unsigned wsh0 = (unsigned)mw >> (4 * h), wsh1 = (unsigned)(mw >> 32) >> (4 * h); \
        float mx = -1e30f; \
        if ((kt) < qb - 2) {     \
            _Pragma("unroll") for (int sb = 0; sb < 2; ++sb) _Pragma("unroll") for (int i = 0; i < 16; ++i) { Sc[sb][i] = fmaf(Sc[sb][i], SCL2, B31); mx = fmaxf(mx, Sc[sb][i]); } \
        } else { const int dbase = tq0 + n - (kt) * 64 - 4 * h; \
            _Pragma("unroll") for (int sb = 0; sb < 2; ++sb) _Pragma("unroll") for (int i = 0; i < 16; ++i) { int dist = dbase - (32 * sb + (i & 3) + 8 * (i >> 2)); dist = dist < 0 ? 0 : (dist > 127 ? 127 : dist); \
                Sc[sb][i] = fmaf(Sc[sb][i], SCL2, BT[hl * 128 + dist]); mx = fmaxf(mx, Sc[sb][i]); } } \
        mx = xhalf_max(mx); \
        const float mn = fmaxf(m, mx); \
        if (__any(mn > m)) { const float al = __builtin_amdgcn_exp2f(m - mn); _Pragma("unroll") for (int i = 0; i < 16; ++i) { O[0][i] *= al; O[1][i] *= al; } lsum *= al; } \
        m = mn; \
        _Pragma("unroll") for (int i = 0; i < 16; ++i) { float p0 = __builtin_amdgcn_exp2f(Sc[0][i] - m), p1 = __builtin_amdgcn_exp2f(Sc[1][i] - m); \
            DSA_MASK(p0, wsh0, (i & 3) + 8 * (i >> 2)); DSA_MASK(p1, wsh1, (i & 3) + 8 * (i >> 2)); Sc[0][i] = p0; Sc[1][i] = p1; lsum += p0 + p1; } \
        STAMP_END(3); STAMP_BEGIN(4); \
        _Pragma("unroll") for (int sb = 0; sb < 2; ++sb) _Pragma("unroll") for (int s = 0; s < 2; ++s) { const bf16x8 pf = pack_step(Sc[sb], s); \
            _Pragma("unroll") for (int db = 0; db < 2; ++db) { const LAS bf16* vp = VT + (32 * db + n) * GP + 32 * sb + 16 * s + 4 * h; \
                const bf16x4 lo = *(const LAS bf16x4*)vp, hi = *(const LAS bf16x4*)(vp + 8); \
                const bf16x8 vf = __builtin_shufflevector(lo, hi, 0, 1, 2, 3, 4, 5, 6, 7); O[db] = MFMA32(vf, pf, O[db]); } } \
        mw = mwn; slot = s1; STAMP_END(4); STAMP_BEGIN(5); \
        asm volatile("s_waitcnt lgkmcnt(0)" ::: "memory"); __builtin_amdgcn_s_barrier(); asm volatile("" ::: "memory"); STAMP_END(5); STAMP_END(1); } while (0)
    STAMP_DECL;
    f32x16 SA[2], SB[2];
    DSA_QK(SA, 0);
    int slot = 0;
#pragma unroll 1
    for (int kt = 0; kt < nt; kt += 2) {
        DSA_TILE(SA, SB, kt);
        if (kt + 1 < nt) DSA_TILE(SB, SA, kt + 1);
    }
#undef DSA_TILE
#undef DSA_MASK
    STAMP_PUBLISH(F.ctl, 37, 1.0f / 100000.f);
#undef DSA_LOADT
#undef DSA_WRITET
#undef DSA_QK
    const float lt = xhalf_sum(lsum), inv = 1.f / lt;
#pragma unroll
    for (int db = 0; db < 2; ++db)
#pragma unroll
        for (int i = 0; i < 16; ++i) OS[n * GP + 32 * db + crow(i, h)] = (bf16)f2bf(O[db][i] * inv);
    asm volatile("s_waitcnt lgkmcnt(0)" ::: "memory");
    bf16* Og = (bf16*)(a.ws + WS_O) + ((size_t)b * SEQ + tq0) * D + hh * 64;
#pragma unroll
    for (int k = 0; k < 4; ++k) { const int idx = lane + 64 * k, row = idx >> 3, c8 = (idx & 7) * 8; *(GAS v4u*)(Og + (size_t)row * D + c8) = *(const LAS v4u*)(OS + row * GP + c8); }
    __syncthreads();
}
#define CONV_MOE 1
__device__ __forceinline__ void s5_build_group(Frame& F, const Args& a, int g, int part, LAS unsigned char* base) {
    LAS f32x2* AP = (LAS f32x2*)base;
    LAS f32x2* BB = (LAS f32x2*)(base + 8704);
    LAS f32x2* CC = (LAS f32x2*)(base + 8704 + 8192);
    LAS float* KT = (LAS float*)(base + 8704 + 16384);
    const float* lam_re = a.in[8]; const float* lam_im = a.in[9]; const float* log_dt = a.in[10];
    const float* b_re = a.in[11]; const float* b_im = a.in[12]; const float* c_re = a.in[13]; const float* c_im = a.in[14]; const float* dsk = a.in[15];
    const int tid = F.tid;
    if (tid < 64) { const int p = tid;
        const float lr = fminf(lam_re[g * 64 + p], -1e-4f), li = lam_im[g * 64 + p], dt = expf(log_dt[g]);
        const float mag = expf(lr * dt), are = mag * cosf(li * dt), aim = mag * sinf(li * dt);
        const float den = lr * lr + li * li, nr = are - 1.f, cre = (nr * lr + aim * li) / den, cim = (aim * lr - nr * li) / den;
        float pr = 1.f, pi = 0.f;
        for (int m = 0; m <= 16; ++m) { AP[m * 64 + p] = (f32x2){pr, pi}; const float t = pr * are - pi * aim; pi = pr * aim + pi * are; pr = t; }
        for (int c = 0; c < 16; ++c) { const float br = b_re[(g * 64 + p) * 16 + c], bi = b_im[(g * 64 + p) * 16 + c]; BB[p * 16 + c] = (f32x2){cre * br - cim * bi, cre * bi + cim * br}; }
    }
    for (int e = tid; e < 1024; e += NWAVES * 64) CC[e] = (f32x2){c_re[g * 1024 + e], c_im[g * 1024 + e]};
    __syncthreads();
    { const int m = tid >> 5, c = (tid >> 1) & 15, hc = tid & 1;
      if (m <= 4 * part + 3) { float acc[8];
#pragma unroll
          for (int q = 0; q < 8; ++q) acc[q] = 0.f;
          for (int p = 0; p < 64; ++p) { const f32x2 cc = CC[c * 64 + p], ap = AP[m * 64 + p]; const float tr = cc.x * ap.x - cc.y * ap.y, ti = cc.x * ap.y + cc.y * ap.x;
#pragma unroll
              for (int q = 0; q < 8; ++q) { const f32x2 bb = BB[p * 16 + 8 * hc + q]; acc[q] = fmaf(tr, bb.x, fmaf(-ti, bb.y, acc[q])); } }
#pragma unroll
          for (int q = 0; q < 8; ++q) KT[(m << 8) + (c << 4) + 8 * hc + q] = acc[q]; } }
    __syncthreads();
    bf16* MQ = (bf16*)(a.ws + WS_MQ) + (size_t)g * 256 * 384; bf16* PG = (bf16*)(a.ws + WS_PG) + (size_t)g * 256 * 256;
    for (int v = tid; v < 64 * 48; v += NWAVES * 64) { const int row = 64 * part + v / 48, cv = v % 48, j = row >> 4, c = row & 15, col0 = cv * 8; float val[8];
        if (col0 < 256) { const int i = col0 >> 4, c20 = col0 & 15;
#pragma unroll
            for (int q = 0; q < 8; ++q) { float t = (i <= j) ? KT[((j - i) << 8) + (c << 4) + c20 + q] : 0.f; if (i == j && c == c20 + q) t += dsk[g * 16 + c]; val[q] = t; } }
        else { const int p0 = (col0 - 256) & 63; const bool im = (col0 - 256) >= 64;
#pragma unroll
            for (int q = 0; q < 8; ++q) { const f32x2 cc = CC[c * 64 + p0 + q], ap = AP[(j + 1) * 64 + p0 + q]; val[q] = im ? -(cc.x * ap.y + cc.y * ap.x) : (cc.x * ap.x - cc.y * ap.y); } }
        v4u o; o.x = pk2(val[0], val[1]); o.y = pk2(val[2], val[3]); o.z = pk2(val[4], val[5]); o.w = pk2(val[6], val[7]);
        *(GAS v4u*)(MQ + (size_t)row * 384 + col0) = o; }
    for (int v = tid; v < 64 * 32; v += NWAVES * 64) { const int row = 64 * part + (v >> 5), col0 = (v & 31) * 8, i = col0 >> 4, c20 = col0 & 15; float val[8];
        if (row < 128) { const int p = row & 63; const bool im = row >= 64; const f32x2 ap = AP[(15 - i) * 64 + p];
#pragma unroll
            for (int q = 0; q < 8; ++q) { const f32x2 bb = BB[p * 16 + c20 + q]; val[q] = im ? (ap.x * bb.y + ap.y * bb.x) : (ap.x * bb.x - ap.y * bb.y); } }
        else {
#pragma unroll
            for (int q = 0; q < 8; ++q) val[q] = 0.f; }
        v4u o; o.x = pk2(val[0], val[1]); o.y = pk2(val[2], val[3]); o.z = pk2(val[4], val[5]); o.w = pk2(val[6], val[7]);
        *(GAS v4u*)(PG + (size_t)row * 256 + col0) = o; }
    __syncthreads();
}
__device__ __forceinline__ void s5_scan_local(Frame& F, const Args& a) {
    const float* lam_re = a.in[8]; const float* lam_im = a.in[9]; const float* log_dt = a.in[10];
    bf16* UA = (bf16*)(a.ws + WS_H); const float* Z = (const float*)(a.ws + WS_H + 96 * MiB);
    const int p = F.lane, nun = (512 - F.vcu + F.G - 1) / F.G;
    for (int q = F.wave; q < 2 * nun; q += NWAVES) { const int L = (q >> 1) * F.G + F.vcu, g = L >> 3, b = 2 * (L & 7) + (q & 1);
        const float lr = fminf(lam_re[g * 64 + p], -1e-4f), li = lam_im[g * 64 + p], dt = expf(log_dt[g]);
        const float mag = expf(lr * dt); float ar = mag * cosf(li * dt), ai = mag * sinf(li * dt);
#pragma unroll
        for (int k = 0; k < 4; ++k) { const float t = ar * ar - ai * ai; ai = 2.f * ar * ai; ar = t; }
        float sr = 0.f, si = 0.f;
        const float* zp = Z + ((size_t)(g * 2048 + b * 128)) * 128 + p; bf16* up = UA + ((size_t)(g * 2048 + b * 128)) * 384 + 256 + p;
        for (int n0 = 0; n0 < 128; n0 += 16) { float zr[16], zi[16];
#pragma unroll
            for (int k = 0; k < 16; ++k) { zr[k] = zp[(size_t)(n0 + k) * 128]; zi[k] = zp[(size_t)(n0 + k) * 128 + 64]; }
#pragma unroll
            for (int k = 0; k < 16; ++k) { up[(size_t)(n0 + k) * 384] = (bf16)f2bf(sr); up[(size_t)(n0 + k) * 384 + 64] = (bf16)f2bf(si);
                const float t = ar * sr - ai * si + zr[k]; si = ar * si + ai * sr + zi[k]; sr = t; } } }
}
template <int COMB, bool ROUTE, bool F32OUT>
__device__ __forceinline__ void ln_phase(Frame& F, const bf16* src, const bf16* cb, const float* gamma, const float* beta, float* dst, bf16* dstb,
                                         const float* rc, const float* rbc, const float* rf, const float* rbf, unsigned* cnt, int* list, float* tokw, int* tokpos = nullptr) {
    const int gw = F.vcu * NWAVES + F.wave, NGW = F.G * NWAVES, lane = F.lane;
    f32x4 gv[4], bv[4];
#pragma unroll
    for (int j = 0; j < 4; ++j) { gv[j] = ((const GAS f32x4*)gamma)[lane + 64 * j]; bv[j] = ((const GAS f32x4*)beta)[lane + 64 * j]; }
    volatile LAS unsigned* RT = (volatile LAS unsigned*)(F.lds + RING_OFF);
    int lrow = F.wave * 16;
    f32x4 rcv[16];
    LAS f32x4* RF = (LAS f32x4*)(F.lds + RING_OFF + 4096);
    if (ROUTE) { if (F.tid < 16) RT[F.tid] = 0u;
#pragma unroll
        for (int j = 0; j < 4; ++j)
#pragma unroll
            for (int q = 0; q < 4; ++q) rcv[j * 4 + q] = *(const GAS f32x4*)(rc + (size_t)(256 * j + 4 * lane + q) * 4);
        for (int i = F.tid; i < 4096; i += NWAVES * 64) RF[i] = ((const GAS f32x4*)rf)[i];
        __syncthreads(); }
    int cs0 = 0, cs1 = 0, ns0 = 0, ns1 = 0; float cw0 = 0.f, cw1 = 0.f, nw0 = 0.f, nw1 = 0.f;
#define LN_INFO(r, s0, s1, w0, w1) do { const int _p0 = list[(r) * 2], _p1 = list[(r) * 2 + 1]; s0 = (int)RT[_p0 >> 20] * 256 + (_p0 & 0xfffff); s1 = (int)RT[_p1 >> 20] * 256 + (_p1 & 0xfffff); w0 = tokw[(r) * 2]; w1 = tokw[(r) * 2 + 1]; } while (0)
    if (COMB == 1) { if (F.tid < 16) { unsigned acc = 0; for (int e = 0; e < F.tid; ++e) acc += (__hip_atomic_load(cnt + 64 * e, RLX_AGENT) + 255u) >> 8; RT[F.tid] = acc; }
        __syncthreads(); LN_INFO(gw, cs0, cs1, cw0, cw1); if (gw + NGW < NTOK) LN_INFO(gw + NGW, ns0, ns1, nw0, nw1); }
    v2u nx[4], na[4], nb[4];
    { const GAS v2u* xr = (const GAS v2u*)(src + (size_t)gw * D) + lane;
#pragma unroll
      for (int j = 0; j < 4; ++j) nx[j] = xr[64 * j];
      if (COMB == 1) { const GAS v2u* c0 = (const GAS v2u*)(cb + (size_t)cs0 * D) + lane; const GAS v2u* c1 = (const GAS v2u*)(cb + (size_t)cs1 * D) + lane;
#pragma unroll
          for (int j = 0; j < 4; ++j) { na[j] = c0[64 * j]; nb[j] = c1[64 * j]; } }
      if (COMB == 2) { const GAS v2u* c0 = (const GAS v2u*)(cb + (size_t)gw * D) + lane;
#pragma unroll
          for (int j = 0; j < 4; ++j) na[j] = c0[64 * j]; } }
    for (int row = gw; row < NTOK; row += NGW) {
        f32x4 v[4]; float s = 0.f;
#pragma unroll
        for (int j = 0; j < 4; ++j) { v[j].x = __uint_as_float(nx[j].x << 16); v[j].y = __uint_as_float(nx[j].x & 0xffff0000u); v[j].z = __uint_as_float(nx[j].y << 16); v[j].w = __uint_as_float(nx[j].y & 0xffff0000u); }
        if (COMB == 2) {
#pragma unroll
            for (int j = 0; j < 4; ++j) { const v2u a = na[j];
                v[j].x = fmaf(__uint_as_float(a.x << 16), ALPHA, v[j].x); v[j].y = fmaf(__uint_as_float(a.x & 0xffff0000u), ALPHA, v[j].y);
                v[j].z = fmaf(__uint_as_float(a.y << 16), ALPHA, v[j].z); v[j].w = fmaf(__uint_as_float(a.y & 0xffff0000u), ALPHA, v[j].w); } }
        if (COMB == 1) {
#pragma unroll
            for (int j = 0; j < 4; ++j) { const v2u a = na[j], b = nb[j];
                v[j].x = fmaf(v[j].x, ALPHA, fmaf(__uint_as_float(a.x << 16), cw0, __uint_as_float(b.x << 16) * cw1)); v[j].y = fmaf(v[j].y, ALPHA, fmaf(__uint_as_float(a.x & 0xffff0000u), cw0, __uint_as_float(b.x & 0xffff0000u) * cw1));
                v[j].z = fmaf(v[j].z, ALPHA, fmaf(__uint_as_float(a.y << 16), cw0, __uint_as_float(b.y << 16) * cw1)); v[j].w = fmaf(v[j].w, ALPHA, fmaf(__uint_as_float(a.y & 0xffff0000u), cw0, __uint_as_float(b.y & 0xffff0000u) * cw1)); } }
        if (row + NGW < NTOK) { const int nr = row + NGW; const GAS v2u* xr = (const GAS v2u*)(src + (size_t)nr * D) + lane;
#pragma unroll
            for (int j = 0; j < 4; ++j) nx[j] = xr[64 * j];
            if (COMB == 1) { const GAS v2u* c0 = (const GAS v2u*)(cb + (size_t)ns0 * D) + lane; const GAS v2u* c1 = (const GAS v2u*)(cb + (size_t)ns1 * D) + lane;
#pragma unroll
                for (int j = 0; j < 4; ++j) { na[j] = c0[64 * j]; nb[j] = c1[64 * j]; }
                cw0 = nw0; cw1 = nw1; if (nr + NGW < NTOK) LN_INFO(nr + NGW, ns0, ns1, nw0, nw1); }
            if (COMB == 2) { const GAS v2u* c0 = (const GAS v2u*)(cb + (size_t)nr * D) + lane;
#pragma unroll
                for (int j = 0; j < 4; ++j) na[j] = c0[64 * j]; } }
#pragma unroll
        for (int j = 0; j < 4; ++j) s += (v[j].x + v[j].y) + (v[j].z + v[j].w);
        const float mean = wsum(s) * (1.f / D); float s2 = 0.f;
#pragma unroll
        for (int j = 0; j < 4; ++j) { v[j] = v[j] - mean; s2 += (v[j].x * v[j].x + v[j].y * v[j].y) + (v[j].z * v[j].z + v[j].w * v[j].w); }
        const float rstd = 1.f / sqrtf(wsum(s2) * (1.f / D) + LN_EPS);
        GAS v2u* ob = (GAS v2u*)(dstb + (size_t)row * D) + lane;
#pragma unroll
        for (int j = 0; j < 4; ++j) { v[j] = v[j] * rstd * gv[j] + bv[j]; v2u w; w.x = cvt2bf(v[j].x, v[j].y); w.y = cvt2bf(v[j].z, v[j].w); if (dstb) ob[64 * j] = w;
            if (F32OUT) { f32x4 ov = v[j];
#ifdef STAMP
                ov = ov * (1.f + __uint_as_float(__hip_atomic_load((unsigned*)(F.ctl + CW_DIAG), RLX_AGENT)));
#endif
                ((GAS f32x4*)(dst + (size_t)row * D) + lane)[64 * j] = ov; } }
        if (ROUTE) {
            float gl[4] = {0.f, 0.f, 0.f, 0.f};
#pragma unroll
            for (int j = 0; j < 4; ++j)
#pragma unroll
                for (int q = 0; q < 4; ++q) { const f32x4 r = rcv[j * 4 + q]; const float xv = v[j][q];
                    gl[0] = fmaf(xv, r.x, gl[0]); gl[1] = fmaf(xv, r.y, gl[1]); gl[2] = fmaf(xv, r.z, gl[2]); gl[3] = fmaf(xv, r.w, gl[3]); }
#pragma unroll
            for (int g = 0; g < 4; ++g) gl[g] = wsum(gl[g]) + rbc[g];
            int gs = 0; float gm = gl[0];
#pragma unroll
            for (int g = 1; g < 4; ++g) if (gl[g] > gm) { gm = gl[g]; gs = g; }
            float se = 0.f;
#pragma unroll
            for (int g = 0; g < 4; ++g) se += expf(gl[g] - gm);
            const float gwt = 1.f / se;
            float fl[4] = {0.f, 0.f, 0.f, 0.f}; const LAS f32x4* rfg = RF + gs * D;
#pragma unroll
            for (int j = 0; j < 4; ++j)
#pragma unroll
                for (int q = 0; q < 4; ++q) { const f32x4 r = rfg[256 * j + 4 * lane + q]; const float xv = v[j][q];
                    fl[0] = fmaf(xv, r.x, fl[0]); fl[1] = fmaf(xv, r.y, fl[1]); fl[2] = fmaf(xv, r.z, fl[2]); fl[3] = fmaf(xv, r.w, fl[3]); }
#pragma unroll
            for (int e = 0; e < 4; ++e) fl[e] = wsum(fl[e]) + rbf[gs * 4 + e];
            int i1 = 0; float v1 = fl[0];
#pragma unroll
            for (int e = 1; e < 4; ++e) if (fl[e] > v1) { v1 = fl[e]; i1 = e; }
            int i2 = -1; float v2 = -INFINITY;
#pragma unroll
            for (int e = 0; e < 4; ++e) if (e != i1 && fl[e] > v2) { v2 = fl[e]; i2 = e; }
            const float e2 = expf(v2 - v1), w1 = gwt / (1.f + e2), w2 = gwt * e2 / (1.f + e2);
            if (lane == 0) { const int ea = gs * 4 + i1, eb = gs * 4 + i2;
                const unsigned pa = __hip_atomic_fetch_add((LAS unsigned*)RT + ea, 1u, __ATOMIC_RELAXED, __HIP_MEMORY_SCOPE_WORKGROUP), pb = __hip_atomic_fetch_add((LAS unsigned*)RT + eb, 1u, __ATOMIC_RELAXED, __HIP_MEMORY_SCOPE_WORKGROUP);
                RT[64 + lrow] = (unsigned)ea | ((unsigned)eb << 8) | (pa << 16); RT[64 + 128 + lrow] = pb; tokw[row * 2] = w1; tokw[row * 2 + 1] = w2; }
            ++lrow;
        }
    }
    if (ROUTE) {
        __syncthreads();
        if (F.tid < 16) RT[32 + F.tid] = __hip_atomic_fetch_add(cnt + 64 * F.tid, RT[F.tid], RLX_AGENT);
        __syncthreads();
        if (F.tid < 128) { const int lr = F.tid, rw = lr >> 4, it = lr & 15, row = F.vcu * NWAVES + rw + it * NGW;
            if (row < NTOK) { const unsigned e = RT[64 + lr], pb = RT[64 + 128 + lr]; const int ea = e & 255, eb = (e >> 8) & 255; const unsigned pa = e >> 16;
                const unsigned ga = RT[32 + ea] + pa, gb = RT[32 + eb] + pb; list[ea * NTOK + ga] = row * 2; list[eb * NTOK + gb] = row * 2 + 1;
                tokpos[row * 2] = (ea << 20) | (int)ga; tokpos[row * 2 + 1] = (eb << 20) | (int)gb; } }
        __syncthreads();
    }
}

__device__ __forceinline__ void moe_convert(const Args& a, int layer, int part  , int wk, int nw, LAS float* scr, int lane) {
    unsigned char* ws = a.ws;
    constexpr int PER = 64, NU = NEXP * 2 * 4 * PER, PERD = 256, ND = NEXP * PERD;
    auto desc = [&](int it) { TrDesc d;
        if (it < NU) { int j = it / PER; const int r = it % PER, pn = j & 3; j >>= 2; const int which = j & 1; j >>= 1; const int le = layer * NEXP + j, kb = r >> 2, nb = r & 3;
            d.W = a.in[27 + which] + (size_t)le * D * MOE_F; d.ldw = MOE_F; d.WT = (bf16*)(ws + WS_WGU) + (size_t)le * 1024 * D; d.ldt = D; d.k0 = kb * 64; d.c0 = pn * 128 + nb * 32; d.nc = 32; d.r0 = pn * 256 + which * 128 + nb * 32; }
        else { const int q = it - NU, le = layer * NEXP + q / PERD, r = q % PERD, kb = r >> 5, nb = r & 31;
            d.W = a.in[29] + (size_t)le * MOE_F * D; d.ldw = D; d.WT = (bf16*)(ws + WS_WD) + (size_t)le * D * MOE_F; d.ldt = MOE_F; d.k0 = kb * 64; d.c0 = nb * 32; d.nc = 32; d.r0 = nb * 32; }
        return d; };
    const int lo = part == 1 ? NU : 0, hi = part == 0 ? NU : NU + ND;
    f32x4 va[8], vb[8]; int it = lo + wk;
    if (it < hi) { TrDesc d0 = desc(it); tr_load(d0, va, lane); }
    for (; it < hi; it += 2 * nw) {
        const TrDesc d0 = desc(it); const bool h1 = it + nw < hi, h2 = it + 2 * nw < hi;
        if (h1) { const TrDesc d1 = desc(it + nw); tr_load(d1, vb, lane); }
        tr_store(d0, va, scr, lane);
        if (h2) { const TrDesc d2 = desc(it + 2 * nw); tr_load(d2, va, lane); }
        if (h1) { const TrDesc d1 = desc(it + nw); tr_store(d1, vb, scr, lane); }
    }
}
__device__ __forceinline__ void p0_prologue(Frame& F, const Args& a) {
    STAMP_T0(301, _t301);
    for (int u = F.vcu; u < 256; u += F.G) s5_build_group(F, a, u >> 2, u & 3, F.lds + RING_OFF);
    STAMP_END_PUB(301, _t301, F.ctl, 37, (float)(STAMP_SCALE)); STAMP_T0(302, _t302);
    LAS float* scr = (LAS float*)(F.lds + RING_OFF + F.wave * 16384);
    const int gw = F.vcu * NWAVES + F.wave, NGW = F.G * NWAVES, lane = F.lane;
    unsigned char* ws = a.ws;
    { const float* x = a.in[0]; bf16* xb = (bf16*)(ws + WS_XB); const size_t n8 = (size_t)NTOK * D / 8, st = (size_t)NGW * 64;
      for (size_t i = (size_t)gw * 64 + lane; i < n8; i += 4 * st) { f32x4 v0[4], v1[4];
#pragma unroll
          for (int u = 0; u < 4; ++u) if (i + u * st < n8) { v0[u] = __builtin_nontemporal_load((const GAS f32x4*)(x + (i + u * st) * 8)); v1[u] = __builtin_nontemporal_load((const GAS f32x4*)(x + (i + u * st) * 8 + 4)); }
#pragma unroll
          for (int u = 0; u < 4; ++u) if (i + u * st < n8) { v4u o; o.x = pk2(v0[u].x, v0[u].y); o.y = pk2(v0[u].z, v0[u].w); o.z = pk2(v1[u].x, v1[u].y); o.w = pk2(v1[u].z, v1[u].w);
              *(GAS v4u*)(xb + (i + u * st) * 8) = o; } } }
    STAMP_END_PUB(302, _t302, F.ctl, 37, (float)(STAMP_SCALE)); STAMP_T0(303, _t303);
    { const float* W = a.in[2]; bf16* WT = (bf16*)(ws + WS_WIN);
      const int n0 = tr_seg_items(D, 1088), n1 = tr_seg_items(D, 4), n2 = tr_seg_items(D, 16), n3 = tr_seg_items(D, 1024), n4 = tr_seg_items(D, 512);
      for (int it = gw; it < n0; it += NGW) tr_seg(W, ABP, D, 0, 1088, WT, D, 0, it, scr, lane);
      for (int it = gw; it < n1; it += NGW) tr_seg(W, ABP, D, 1088, 4, WT, D, HC_IW, it, scr, lane);
      for (int it = gw; it < n2; it += NGW) tr_seg(W, ABP, D, 2116, 16, WT, D, HC_BG, it, scr, lane);
      for (int it = gw; it < n3; it += NGW) tr_seg(W, ABP, D, 1092, 1024, WT, D, HC_BQ, it, scr, lane);
      for (int it = gw; it < n4; it += NGW) tr_seg(W, ABP, D, 2132, 512, WT, D, HC_BR, it, scr, lane);
      for (int i = gw * 64 + lane; i < 172 * (D / 8); i += NGW * 64) { const int rr = i / (D / 8), cc = i % (D / 8); const int row = rr < 4 ? 1092 + rr : 1112 + (rr - 4);
          *(GAS v4u*)(WT + (size_t)row * D + cc * 8) = (v4u){0u, 0u, 0u, 0u}; } }
    { const int n = tr_seg_items(D, D);
      for (int it = gw; it < n; it += NGW) tr_seg(a.in[6], D, D, 0, D, (bf16*)(ws + WS_WOUT), D, 0, it, scr, lane);
      for (int it = gw; it < n; it += NGW) tr_seg(a.in[7], D, D, 0, D, (bf16*)(ws + WS_S5IN), D, 0, it, scr, lane);
      for (int it = gw; it < n; it += NGW) tr_seg(a.in[18], D, D, 0, D, (bf16*)(ws + WS_S5OUT), D, 0, it, scr, lane); }
    { const int n = 2 * 8 * tr_seg_items(D, 128);
      for (int it = gw; it < n; it += NGW) { const int per = tr_seg_items(D, 128), j = it / per, which = j & 1, pn = j >> 1;
          tr_seg(a.in[16 + which], D, D, pn * 128, 128, (bf16*)(ws + WS_GLU), D, pn * 256 + which * 128, it % per, scr, lane); } }
    STAMP_END_PUB(303, _t303, F.ctl, 37, (float)(STAMP_SCALE));
    __syncthreads();
}


#define MOE_PHASES(L, PU, PD, PL, LG, LB) \
    if (IN(PU)) { \
        pg8::Gemm g{(const bf16*)(ws + WS_XB), (const bf16*)(ws + WS_WGU) + (size_t)(L) * NEXP * 1024 * D, D, D, D}; \
        pg8::MoeOrder S; S.list = (const int*)(ws + WS_LIST); S.G = F.G; S.c = F.vcu;     _Pragma("unroll") for (int _e = 0; _e < NEXP; ++_e) S.cnt[_e] = __builtin_amdgcn_readfirstlane((int)__hip_atomic_load((unsigned*)(F.ctl + CW_CNT + 1024 * (L)) + 64 * _e, RLX_AGENT)); \
        pg8::EpiGated<1> E{(bf16*)(ws + WS_HMID), MOE_F}; \
        STAMP_T0(70 + (L) * 100, _t70); \
        RP(PU) pg8::gemm_phase<pg8::EpiGated<1>, pg8::MoeOrder, true, PU>(F.lds + RING_OFF, g, S, E, F.ctl); \
        STAMP_END_PUB(70 + (L) * 100, _t70, F.ctl, 37, (float)(STAMP_SCALE)); STAMP_T0(71, _t71); \
        if ((L) == 0) { int _T = 0; _Pragma("unroll") for (int _e = 0; _e < NEXP; ++_e) _T += (S.cnt[_e] + 255) >> 8; const int _n5 = 4 * _T - 4 * F.G;     \
            const bool _all = _n5 < 0 || _n5 >= F.G; const int _wk = _all ? F.vcu * NWAVES + F.wave : (F.vcu - _n5) * NWAVES + F.wave, _nw = _all ? F.G * NWAVES : (F.G - _n5) * NWAVES; \
            if (_all || F.vcu >= _n5) { LAS float* _scr = (LAS float*)(F.lds + RING_OFF + F.wave * 16384); moe_convert(args, 0, 1, _wk, _nw, _scr, F.lane); } } \
        STAMP_END_PUB(71, _t71, F.ctl, 37, (float)(STAMP_SCALE)); \
        if (BOTH(PU)) GRID_BAR(); } \
    if (IN(PD)) { \
        pg8::Gemm g{(const bf16*)(ws + WS_HMID), (const bf16*)(ws + WS_WD) + (size_t)(L) * NEXP * D * MOE_F, MOE_F, MOE_F, MOE_F}; \
        pg8::MoeOrder S; S.list = (const int*)(ws + WS_LIST); S.G = F.G; S.c = F.vcu;     _Pragma("unroll") for (int _e = 0; _e < NEXP; ++_e) S.cnt[_e] = __builtin_amdgcn_readfirstlane((int)__hip_atomic_load((unsigned*)(F.ctl + CW_CNT + 1024 * (L)) + 64 * _e, RLX_AGENT)); \
        pg8::EpiStoreBf16 E{(bf16*)(ws + WS_CB), D};     \
        STAMP_T0(72 + (L) * 100, _t72); \
        RP(PD) pg8::gemm_phase<pg8::EpiStoreBf16, pg8::MoeOrder, false, PD>(F.lds + RING_OFF, g, S, E, F.ctl); \
        STAMP_END_PUB(72 + (L) * 100, _t72, F.ctl, 37, (float)(STAMP_SCALE)); \
        if ((L) == 0) { int _T = 0; _Pragma("unroll") for (int _e = 0; _e < NEXP; ++_e) _T += (S.cnt[_e] + 255) >> 8; const int _n5 = 4 * _T - 4 * F.G;     \
            const bool _all = _n5 < 0 || _n5 >= F.G; const int _wk = _all ? F.vcu * NWAVES + F.wave : (F.vcu - _n5) * NWAVES + F.wave, _nw = _all ? F.G * NWAVES : (F.G - _n5) * NWAVES; \
            if (_all || F.vcu >= _n5) moe_convert(args, 1, 2, _wk, _nw, (LAS float*)(F.lds + RING_OFF + F.wave * 16384), F.lane); } \
        if (BOTH(PD)) GRID_BAR(); } \
    if (IN(PL)) { \
        if ((L) == 0) ln_phase<1, false, false>(F, (const bf16*)(ws + WS_XB), (const bf16*)(ws + WS_CB), LG, LB, nullptr, (bf16*)(ws + WS_XB), nullptr, nullptr, nullptr, nullptr, (unsigned*)(F.ctl + CW_CNT + 1024 * (L)), (int*)(ws + WS_TOKPOS), (float*)(ws + WS_TOKW)); \
        else ln_phase<1, false, true>(F, (const bf16*)(ws + WS_XB), (const bf16*)(ws + WS_CB), LG, LB, args.out, nullptr, nullptr, nullptr, nullptr, nullptr, (unsigned*)(F.ctl + CW_CNT + 1024 * (L)), (int*)(ws + WS_TOKPOS), (float*)(ws + WS_TOKW)); \
        if (BOTH(PL)) GRID_BAR(); }

__global__ void __launch_bounds__(NWAVES * 64, 2) mk_fwd(Args args) {
    extern __shared__ __attribute__((aligned(16))) unsigned char lds[];
    Frame F;
    F.lds = (LAS unsigned char*)lds; F.MISC = (volatile LAS unsigned*)(F.lds + MISC_OFF);
    F.tid = threadIdx.x; F.lane = F.tid & 63; F.wave = __builtin_amdgcn_readfirstlane(F.tid >> 6);
    F.G = gridDim.x; { const int bx = blockIdx.x; F.vcu = (F.G % 8 == 0) ? (bx % 8) * (F.G / 8) + bx / 8 : bx; }
    unsigned char* ws = args.ws;
    F.ctl = (gu32*)(ws + WS_CTL);
    for (int u = F.tid; u < (LDS_BYTES - LDSCTL_OFF) / 4; u += NWAVES * 64) ((LAS unsigned*)(F.lds + LDSCTL_OFF))[u] = 0u;
    __syncthreads();
    XcdBarrier bar = xcd_barrier_post((unsigned*)(F.ctl + CW_BAR) + args.li * XCD_BAR_WORDS, F.MISC + 8);
    const int lo = args.ph_lo, hi = args.ph_hi;
#define IN(k) (lo <= (k) && (k) < hi)
#define BOTH(k) (IN(k) && IN((k) + 1))
#ifdef STAMP
    int _bi = 0;
#define STAMP_BAR() do { if (STAMP >= 1000 && blockIdx.x == 37 && threadIdx.x == 0) { const unsigned _now = (unsigned)__builtin_amdgcn_s_memtime(); \
        if (_bi == STAMP - 1000) __hip_atomic_store((unsigned*)(F.ctl + CW_DIAG), __float_as_uint((float)(_now - F.MISC[20]) * (float)(STAMP_SCALE)), RLX_AGENT); \
        if (_bi + 1 == STAMP - 1000) F.MISC[20] = _now; } ++_bi; } while (0)
#define GRID_BAR() do { xcd_barrier(bar); STAMP_BAR(); } while (0)
    if (STAMP == 1000 && blockIdx.x == 37 && threadIdx.x == 0) F.MISC[20] = (unsigned)__builtin_amdgcn_s_memtime();
#else
#define GRID_BAR() xcd_barrier(bar)
#endif
#define RP(k) for (int _rp = 0; _rp < ((PROBE == (k)) ? 2 : 1); ++_rp)
    if (IN(0)) { RP(0) p0_prologue(F, args); if (BOTH(0)) GRID_BAR(); }
    if (IN(1)) {
        pg8::Gemm g{(const bf16*)(ws + WS_XB), (const bf16*)(ws + WS_WIN), D, D, D}; pg8::StaticOrder S; S.init(NTOK, HP, F.G, (int)blockIdx.x);
        pg8::EpiStoreBf16 E{(bf16*)(ws + WS_H), HP};
        RP(1) pg8::gemm_phase<pg8::EpiStoreBf16, pg8::StaticOrder, false, 1>(F.lds + RING_OFF, g, S, E, F.ctl);
        { const int units = (NTOK / 256) * (HP / 256), rem = units % F.G;
          if ((int)blockIdx.x >= rem) moe_convert(args, 0, 0, ((int)blockIdx.x - rem) * NWAVES + F.wave, (F.G - rem) * NWAVES, (LAS float*)(F.lds + RING_OFF + F.wave * 16384), F.lane); }
        if (BOTH(1)) GRID_BAR();
    }


    if (IN(2)) {
        STAMP_DECL; STAMP_BEGIN(200);
        RP(20) { Dsa1Ops ops; { const int x = F.vcu; if (x < 2048) dsa1_load(F, args, x >> 7, x & 127, ops); }
          for (int k = 0, x = F.vcu; x < 2048; ++k, x += F.G) { const int b = x >> 7, qb = x & 127, xn = x + F.G;
              const int nb = xn < 2048 ? (xn >> 7) : -1, nq = xn & 127; dsa1_unit(F, args, b, (k & 1) ? 127 - qb : qb, ops, nb, ((k + 1) & 1) ? 127 - nq : nq); } }
        STAMP_END(200); STAMP_BEGIN(201);
        RP(21) for (int u = F.vcu; u < 1024; u += F.G) gla1_pair(F, args, 2 * u);
        STAMP_END(201); STAMP_PUBLISH(F.ctl, 37, (float)(STAMP_SCALE));
        if (BOTH(2)) GRID_BAR(); }
    if (IN(3)) {
        RP(30) gla2_scan(F, args);
        RP(31) for (int v = F.vcu; v < 256; v += F.G) { const int bg = v >> 3, s = v & 7;
#pragma unroll 1
            for (int k = 0; k < 4; ++k) { const int qb = k == 0 ? s : (k == 1 ? 15 - s : (k == 2 ? 16 + s : 31 - s)); dsa2_unit(F, args, bg >> 1, bg & 1, qb); } }
        if (BOTH(3)) GRID_BAR(); }
    if (IN(4)) { RP(4) for (int u = F.vcu; u < 1024; u += F.G) gla3_pair(F, args, 2 * u); if (BOTH(4)) GRID_BAR(); }
    if (IN(5)) {
        pg8::Gemm g{(const bf16*)(ws + WS_O), (const bf16*)(ws + WS_WOUT), D, D, D}; pg8::StaticOrder S; S.init(NTOK, D, F.G, (int)blockIdx.x);
        pg8::EpiStoreBf16 E{(bf16*)(ws + WS_H), D};
        RP(5) pg8::gemm_phase<pg8::EpiStoreBf16, pg8::StaticOrder, false, 5>(F.lds + RING_OFF, g, S, E, F.ctl);
        if (BOTH(5)) GRID_BAR();
    }
    if (IN(6)) {
        ln_phase<2, true, false>(F, (const bf16*)(ws + WS_H), (const bf16*)(ws + WS_XB), args.in[19], args.in[20], nullptr, (bf16*)(ws + WS_XB), args.in[23], args.in[24], args.in[25], args.in[26],
                          (unsigned*)(F.ctl + CW_CNT), (int*)(ws + WS_LIST), (float*)(ws + WS_TOKW), (int*)(ws + WS_TOKPOS));
        if (BOTH(6)) GRID_BAR(); }
    MOE_PHASES(0, 7, 8, 9, args.in[21], args.in[22])
    if (IN(10)) {
        pg8::Gemm g{(const bf16*)(ws + WS_XB), (const bf16*)(ws + WS_S5IN), D, D, D}; pg8::StaticOrder S; S.init(NTOK, D, F.G, (int)blockIdx.x);
        pg8::EpiS5U E{(bf16*)(ws + WS_H)};
        RP(10) pg8::gemm_phase<pg8::EpiS5U, pg8::StaticOrder, false>(F.lds + RING_OFF, g, S, E);
        if (BOTH(10)) GRID_BAR();
    }
    if (IN(11)) {
        STAMP_T0(110, _t110);
        { pg8::Gemm g{(const bf16*)(ws + WS_H), (const bf16*)(ws + WS_PG), 384, 256, 256}; pg8::S5Order S{F.G, F.vcu};
          pg8::EpiS5Z E{(float*)(ws + WS_H + 96 * MiB)};
          pg8::gemm_phase<pg8::EpiS5Z, pg8::S5Order, false>(F.lds + RING_OFF, g, S, E); }
        VM_WAIT(); __syncthreads();
        STAMP_END_PUB(110, _t110, F.ctl, 37, (float)(STAMP_SCALE)); STAMP_T0(111, _t111);
        s5_scan_local(F, args);
        VM_WAIT(); __syncthreads();
        STAMP_END_PUB(111, _t111, F.ctl, 37, (float)(STAMP_SCALE)); STAMP_T0(112, _t112);
        { pg8::Gemm g{(const bf16*)(ws + WS_H), (const bf16*)(ws + WS_MQ), 384, 384, 384}; pg8::S5Order S{F.G, F.vcu};
          pg8::EpiS5Y E{(bf16*)(ws + WS_O)};
          pg8::gemm_phase<pg8::EpiS5Y, pg8::S5Order, false>(F.lds + RING_OFF, g, S, E); }
        STAMP_END_PUB(112, _t112, F.ctl, 37, (float)(STAMP_SCALE));
        if (IN(14)) GRID_BAR();
    }
    if (IN(14)) {
        pg8::Gemm g{(const bf16*)(ws + WS_O), (const bf16*)(ws + WS_GLU), D, D, D}; pg8::StaticOrder S; S.init(NTOK, 2 * D, F.G, (int)blockIdx.x);
        pg8::EpiGated<0> E{(bf16*)(ws + WS_F1), D};
        RP(14) pg8::gemm_phase<pg8::EpiGated<0>, pg8::StaticOrder, false, 14, true>(F.lds + RING_OFF, g, S, E, F.ctl);
        if (BOTH(14)) GRID_BAR();
    }
    if (IN(15)) {
        pg8::Gemm g{(const bf16*)(ws + WS_F1), (const bf16*)(ws + WS_S5OUT), D, D, D}; pg8::StaticOrder S; S.init(NTOK, D, F.G, (int)blockIdx.x);
        pg8::EpiStoreBf16 E{(bf16*)(ws + WS_H), D};
        pg8::gemm_phase<pg8::EpiStoreBf16, pg8::StaticOrder, false>(F.lds + RING_OFF, g, S, E);
        if (BOTH(15)) GRID_BAR();
    }
    if (IN(16)) {
        ln_phase<2, true, false>(F, (const bf16*)(ws + WS_H), (const bf16*)(ws + WS_XB), args.in[19] + D, args.in[20] + D, nullptr, (bf16*)(ws + WS_XB), args.in[23] + D * 4, args.in[24] + 4, args.in[25] + 4 * D * 4, args.in[26] + 16,
                          (unsigned*)(F.ctl + CW_CNT + 1024), (int*)(ws + WS_LIST), (float*)(ws + WS_TOKW), (int*)(ws + WS_TOKPOS));
        if (BOTH(16)) GRID_BAR(); }
    MOE_PHASES(1, 17, 18, 19, args.in[21] + D, args.in[22] + D)
#ifdef STAMP
    STAMP_BAR();
#endif
#undef IN
#undef BOTH
}
static int g_grid = 0;
extern "C" void kernel_launch(void* const* d_in, const int* in_sizes, int n_in, void* d_out, int out_size, void* d_ws, size_t ws_size, hipStream_t stream) {
    if (g_grid == 0) {
        if (n_in != 30 || out_size != NTOK * D || ws_size < WS_END) { fprintf(stderr, "kernel_launch: unexpected problem (n_in %d out %d ws %zu)\n", n_in, out_size, ws_size); g_grid = -1; return; }
        int dev = 0, cus = 0, per_cu = 0;
        if (hipGetDevice(&dev) != hipSuccess || hipDeviceGetAttribute(&cus, hipDeviceAttributeMultiprocessorCount, dev) != hipSuccess) { g_grid = -1; return; }
        if (hipFuncSetAttribute((const void*)mk_fwd, hipFuncAttributeMaxDynamicSharedMemorySize, LDS_BYTES) != hipSuccess) { fprintf(stderr, "kernel_launch: hipFuncSetAttribute failed\n"); g_grid = -1; return; }
        if (hipOccupancyMaxActiveBlocksPerMultiprocessor(&per_cu, (const void*)mk_fwd, NWAVES * 64, LDS_BYTES) != hipSuccess || per_cu < 1) fprintf(stderr, "kernel_launch: occupancy query says %d\n", per_cu);
        (void)hipGetLastError();
        if (cus < 256) { fprintf(stderr, "kernel_launch: built for a 256-CU MI355X (one workgroup per CU); found %d CUs\n", cus); g_grid = -1; return; }
        g_grid = 256;
    }
    if (g_grid < 0) return;
    (void)hipMemsetAsync((char*)d_ws + WS_CTL, 0, CTL_ZERO_BYTES, stream);
    Args a{};
    for (int i = 0; i < 30; ++i) a.in[i] = (const float*)d_in[i];
    a.out = (float*)d_out; a.ws = (unsigned char*)d_ws; a.ph_lo = 0; a.ph_hi = 20; a.li = 0; a.pad = 0;
    hipLaunchKernelGGL(mk_fwd, dim3(g_grid), dim3(NWAVES * 64), LDS_BYTES, stream, a);
}
```

```cpp
#include <hip/hip_runtime.h>
#include <math.h>
#include <stdio.h>
#include <stdint.h>

#define GAS __attribute__((address_space(1)))
#define LAS __attribute__((address_space(3)))
typedef unsigned short bf16;
typedef unsigned v4u __attribute__((ext_vector_type(4)));
typedef unsigned v2u __attribute__((ext_vector_type(2)));
typedef float f32x4 __attribute__((ext_vector_type(4)));
typedef float f32x2 __attribute__((ext_vector_type(2)));
typedef float f32x16 __attribute__((ext_vector_type(16)));
typedef short bf16x8 __attribute__((ext_vector_type(8)));
typedef short bf16x4 __attribute__((ext_vector_type(4)));
typedef GAS unsigned gu32;
#define RLX_AGENT __ATOMIC_RELAXED, __HIP_MEMORY_SCOPE_AGENT
#define LDS_WAIT() asm volatile("s_waitcnt lgkmcnt(0)" ::: "memory")
#define VM_WAIT() asm volatile("s_waitcnt vmcnt(0)" ::: "memory")

constexpr int D = 1024, BATCH = 16, SEQ = 2048, NTOK = BATCH * SEQ;
constexpr int ABP = 2644;
constexpr int HP = 2816;
constexpr int HC_AQ = 0, HC_AK = 512, HC_AV = 640, HC_IQ = 768, HC_IK = 1024, HC_IW = 1088, HC_BG = 1096, HC_BQ = 1280, HC_BK = 1536, HC_BV = 1792, HC_BR = 2304;
constexpr float ALPHA = 1.4142135623730951f;
constexpr float LN_EPS = 1e-5f;
constexpr int NEXP = 16, MOE_F = 512;
constexpr int MAXSLOT = 65536 + NEXP * 256;

__device__ __forceinline__ float bf2f(bf16 v) { return __uint_as_float(((unsigned)v) << 16); }
__device__ __forceinline__ unsigned f2bf(float f) { unsigned u = __float_as_uint(f); return (u + 0x7fffu + ((u >> 16) & 1u)) >> 16; }
__device__ __forceinline__ unsigned cvt2bf(float lo, float hi) { unsigned r; asm volatile("v_cvt_pk_bf16_f32 %0, %1, %2" : "=v"(r) : "v"(lo), "v"(hi)); return r; }
__device__ __forceinline__ unsigned pk2(float lo, float hi) { return f2bf(lo) | (f2bf(hi) << 16); }
__device__ __forceinline__ float wsum(float v) {
#define WS_DPP(ctrl, rm, bc) v += __int_as_float(__builtin_amdgcn_update_dpp(0, __float_as_int(v), ctrl, rm, 0xF, bc))
    WS_DPP(0xB1, 0xF, true); WS_DPP(0x4E, 0xF, true); WS_DPP(0x141, 0xF, true); WS_DPP(0x140, 0xF, true); WS_DPP(0x142, 0xA, false); WS_DPP(0x143, 0xC, false);
#undef WS_DPP
    return __int_as_float(__builtin_amdgcn_readlane(__float_as_int(v), 63));
}
__device__ const unsigned char T5B[128] = {0, 1, 2, 3, 4, 5, 6, 7, 8, 9, 10, 11, 12, 13, 14, 15, 16, 16, 16, 17, 17, 18, 18, 18, 19, 19, 19, 20, 20, 20, 20, 21, 21, 21, 21, 22, 22, 22, 22, 22, 23, 23, 23, 23, 23, 23, 24, 24, 24, 24, 24, 24, 25, 25, 25, 25, 25, 25, 25, 26, 26, 26, 26, 26, 26, 26, 26, 27, 27, 27, 27, 27, 27, 27, 27, 27, 27, 28, 28, 28, 28, 28, 28, 28, 28, 28, 28, 29, 29, 29, 29, 29, 29, 29, 29, 29, 29, 29, 29, 30, 30, 30, 30, 30, 30, 30, 30, 30, 30, 30, 30, 30, 30, 31, 31, 31, 31, 31, 31, 31, 31, 31, 31, 31, 31, 31, 31, 31};

__device__ __forceinline__ float xhalf_max(float v) { const auto r = __builtin_amdgcn_permlane32_swap(__float_as_uint(v), __float_as_uint(v), false, false); return fmaxf(__uint_as_float(r[0]), __uint_as_float(r[1])); }
__device__ __forceinline__ float xhalf_sum(float v) { const auto r = __builtin_amdgcn_permlane32_swap(__float_as_uint(v), __float_as_uint(v), false, false); return __uint_as_float(r[0]) + __uint_as_float(r[1]); }
#ifndef PROBE
#define PROBE -1
#endif
constexpr int CW_DIAG = 8;
#ifdef STAMP
#define STAMP_DECL unsigned _st_acc = 0u, _st_t0 = 0u, _st_n = 0u
#define STAMP_BEGIN(id) do { if (STAMP == (id)) _st_t0 = (unsigned)__builtin_amdgcn_s_memtime(); } while (0)
#define STAMP_END(id) do { if (STAMP == (id)) { _st_acc += (unsigned)__builtin_amdgcn_s_memtime() - _st_t0; ++_st_n; } } while (0)
#define STAMP_PUBLISH(ctl, wg, scale) do { if ((int)blockIdx.x == (wg) && threadIdx.x == 0 && _st_n) __hip_atomic_store((unsigned*)((ctl) + CW_DIAG), __float_as_uint((float)_st_acc / (float)_st_n * (scale)), RLX_AGENT); } while (0)
#define STAMP_T0(id, t0) unsigned t0 = 0u; do { if (STAMP == (id)) t0 = (unsigned)__builtin_amdgcn_s_memtime(); } while (0)
#define STAMP_END_PUB(id, t0, ctl, wg, scale) do { if (STAMP == (id)) { const unsigned _dt = (unsigned)__builtin_amdgcn_s_memtime() - t0; if ((int)blockIdx.x == (wg) && threadIdx.x == 0) __hip_atomic_store((unsigned*)((ctl) + CW_DIAG), __float_as_uint((float)_dt * (scale)), RLX_AGENT); } } while (0)
#else
#define STAMP_DECL
#define STAMP_BEGIN(id)
#define STAMP_END(id)
#define STAMP_PUBLISH(ctl, wg, scale)
#define STAMP_T0(id, t0)
#define STAMP_END_PUB(id, t0, ctl, wg, scale)
#endif
namespace pg8 {
#define PG8_LAS __attribute__((address_space(3)))
constexpr int BM = 256, BK = 64, HALF = 128, HTB = HALF * BK * 2  , STAGE_BYTES = 8 * HTB, NXCD = 8, WGM = 8;
__host__ __device__ __forceinline__ int lds_byte(int r, int c) { const int st = (r >> 4) * 2 + (c >> 5), rr = r & 15, cc = c & 31, ob = rr * 64 + cc * 2; return st * 1024 + (ob ^ (((ob >> 9) & 1) << 5)); }
__host__ __device__ __forceinline__ void stage_rc(int b, int& R, int& C) { const int st = b / 1024, sb = b % 1024, swz = sb ^ (((sb >> 9) & 1) << 5); R = (st >> 1) * 16 + swz / 64; C = (st & 1) * 32 + (swz % 64) / 2; }
__host__ __device__ __forceinline__ int perm32(int rho) { const int n = rho >> 4, i = rho & 15; return 8 * (i >> 2) + 4 * n + (i & 3); }

struct Unit { int arow0, brow0, pm, pn, aux, cnt; const int* gather; };
struct Gemm { const bf16* A; const bf16* Bt; int lda, ldb, K; };

struct StaticOrder {
    int nM, nN, nwg, G, c;
    __device__ void init(int M, int N, int G_, int c_) { nM = M / BM; nN = N / BM; nwg = nM * nN; G = G_; c = c_; }
    __device__ bool next(int i, Unit& u) const {
        const long L = (long)i * G + c; if (L >= nwg) return false;
        int wgid = (int)L; { const int q = nwg / NXCD, r = nwg % NXCD, xcd = wgid % NXCD, off = wgid / NXCD; wgid = (xcd < r ? xcd * (q + 1) : r * (q + 1) + (xcd - r) * q) + off; }
        const int nig = WGM * nN, gid = wgid / nig, fm = gid * WGM, gsz = (nM - fm) < WGM ? (nM - fm) : WGM;
        u.pm = fm + ((wgid % nig) % gsz); u.pn = (wgid % nig) / gsz; u.arow0 = u.pm * BM; u.brow0 = u.pn * BM; u.aux = 0; u.cnt = BM; u.gather = nullptr; return true;
    }
};
__device__ __forceinline__ unsigned cvt_pk_bf16(float lo, float hi) { unsigned r; asm volatile("v_cvt_pk_bf16_f32 %0, %1, %2" : "=v"(r) : "v"(lo), "v"(hi)); return r; }

template <class Epi, class Sched, bool GATHER = false, int SID = 0, bool GA = false>
__device__ __forceinline__ void gemm_phase(PG8_LAS unsigned char* lds, const Gemm g, const Sched& S, const Epi& E, gu32* sctl = nullptr) {
    const int tid = threadIdx.x, wid = __builtin_amdgcn_readfirstlane(tid >> 6), lane = tid & 63, wr = wid >> 2, wc = wid & 3, fr = lane & 15, fq = lane >> 4;
    const int K = g.K, nt = K / BK;
    unsigned voffA[2], voffB[2];
#pragma unroll
    for (int i = 0; i < 2; ++i) { int R, C; stage_rc(tid * 16 + i * 8192, R, C); const int Rb = Epi::PERM ? ((R & ~31) + perm32(R & 31)) : R;
        voffA[i] = GATHER ? (unsigned)(C * 2) : (GA ? (unsigned)(R * 32 + (C >> 4) * (NTOK * 32) + (C & 15) * 2) : (unsigned)(R * g.lda + C) * 2u); voffB[i] = (unsigned)(Rb * g.ldb + C) * 2u; }
    const size_t kstep = (size_t)(BK * 2), kstepA = GA ? (size_t)4 * NTOK * 32 : kstep;
    const size_t hstepA = GA ? (size_t)HALF * 32 : (size_t)HALF * g.lda * 2, hstepB = (size_t)HALF * g.ldb * 2;
    const unsigned ldsw = (unsigned)wid * 1024u;
    const int aoff = lds_byte(wr * 64 + fr, fq * 8), boff = lds_byte(wc * 32 + fr, fq * 8);
#define PG8_SA(b, h) (((b) * 2 + (h)) * HTB)
#define PG8_SB(b, h) ((4 + (b) * 2 + (h)) * HTB)
#define PG8_STAGE(bufoff, gbase, voff) do { _Pragma("unroll") for (int _i = 0; _i < 2; ++_i) \
        __builtin_amdgcn_global_load_lds((const unsigned*)((const char*)(gbase) + (voff)[_i]), (PG8_LAS unsigned*)(lds + (bufoff) + ldsw + _i * 8192), 16, 0, 0); } while (0)
#define PG8_STAGE_A(bufoff, P, O, h, ko) do { _Pragma("unroll") for (int _i = 0; _i < 2; ++_i) { \
        const char* _p; if constexpr (GATHER) { const unsigned _t = _i ? ((O)[h] >> 16) : ((O)[h] & 0xffffu); _p = (const char*)(P) + (ko) + (size_t)(_t * (unsigned)(g.lda * 2) + voffA[_i]); } \
        else _p = (const char*)(P) + (ko) + (size_t)(h) * hstepA + voffA[_i]; \
        __builtin_amdgcn_global_load_lds((const unsigned*)_p, (PG8_LAS unsigned*)(lds + (bufoff) + ldsw + _i * 8192), 16, 0, 0); } } while (0)
#define PG8_LDA(dst, b, h) do { _Pragma("unroll") for (int m = 0; m < 4; ++m) _Pragma("unroll") for (int k = 0; k < 2; ++k) dst[m][k] = *(const PG8_LAS bf16x8*)(lds + PG8_SA(b, h) + aoff + m * 2048 + k * 1024); } while (0)
#define PG8_LDB(dst, b, h) do { _Pragma("unroll") for (int n = 0; n < 2; ++n) _Pragma("unroll") for (int k = 0; k < 2; ++k) dst[n][k] = *(const PG8_LAS bf16x8*)(lds + PG8_SB(b, h) + boff + n * 2048 + k * 1024); } while (0)
#define PG8_MMA(ai, bj, At, Bt) do { __builtin_amdgcn_s_setprio(1); _Pragma("unroll") for (int m = 0; m < 4; ++m) _Pragma("unroll") for (int n = 0; n < 2; ++n) _Pragma("unroll") for (int k = 0; k < 2; ++k) \
        acc[ai][bj][m][n] = __builtin_amdgcn_mfma_f32_16x16x32_bf16(Bt[n][k], At[m][k], acc[ai][bj][m][n], 0, 0, 0); __builtin_amdgcn_s_setprio(0); } while (0)
#define PG8_WAIT_V(n) asm volatile("s_waitcnt vmcnt(" #n ")" ::: "memory")
#define PG8_WAIT_L(n) asm volatile("s_waitcnt lgkmcnt(" #n ")" ::: "memory")
#define PG8_BAR __builtin_amdgcn_s_barrier()
#define PG8_SCHED __builtin_amdgcn_sched_barrier(0)
    Unit cur, nxt; int ui = 0;
    if (!S.next(0, cur)) return;
    f32x4 acc[2][2][4][2];
#pragma unroll
    for (int a = 0; a < 2; ++a)
#pragma unroll
        for (int b = 0; b < 2; ++b)
#pragma unroll
            for (int m = 0; m < 4; ++m)
#pragma unroll
                for (int n = 0; n < 2; ++n) acc[a][b][m][n] = (f32x4){0.f, 0.f, 0.f, 0.f};
    bf16x8 At[4][2], B0[2][2], B1[2][2];
    unsigned OA[2], ON[2];
    const char* cA; const char* cB;
#define PG8_SETUP(u, P, O) do { \
        if constexpr (GATHER) { P = (const char*)g.A; _Pragma("unroll") for (int _h = 0; _h < 2; ++_h) { unsigned _pk = 0u; _Pragma("unroll") for (int _i = 0; _i < 2; ++_i) { \
            int _R, _C; stage_rc(tid * 16 + _i * 8192, _R, _C); const int _r = _h * HALF + _R; const unsigned _t = (_r < (u).cnt) ? (unsigned)((u).gather[_r] >> 1) : 0u; _pk |= _t << (16 * _i); } O[_h] = _pk; } } \
        else { P = (const char*)g.A + (GA ? (size_t)(u).arow0 * 32 : (size_t)(u).arow0 * g.lda * 2); } } while (0)
    PG8_SETUP(cur, cA, OA);
    cB = (const char*)g.Bt + (size_t)cur.brow0 * g.ldb * 2;
    PG8_STAGE(PG8_SB(0, 0), cB, voffB); PG8_STAGE(PG8_SB(0, 1), cB + hstepB, voffB); PG8_STAGE_A(PG8_SA(0, 0), cA, OA, 0, 0); PG8_STAGE_A(PG8_SA(0, 1), cA, OA, 1, 0);
    if (wr == 1) PG8_BAR;
    PG8_WAIT_V(2); PG8_BAR;
    PG8_STAGE(PG8_SB(1, 0), cB + kstep, voffB); PG8_STAGE_A(PG8_SA(1, 0), cA, OA, 0, kstepA); PG8_STAGE(PG8_SB(1, 1), cB + hstepB + kstep, voffB);
    PG8_WAIT_V(6); PG8_BAR;
    for (;;) {
        STAMP_T0(SID * 10 + 1, _tu);
        const bool has_next = S.next(ui + 1, nxt);
        const char* nA = cA; const char* nB = cB;
        if constexpr (GATHER) { ON[0] = OA[0]; ON[1] = OA[1]; }
        if (has_next) { PG8_SETUP(nxt, nA, ON); nB = (const char*)g.Bt + (size_t)nxt.brow0 * g.ldb * 2; }
        STAMP_T0(SID * 10 + 2, _tk);
#ifdef STAMP
        unsigned _d5 = 0u;
#endif
        for (int t = 0; t < nt; t += 2) {
            const bool last = (t == nt - 2);
            STAMP_T0(SID * 10 + 5, _ti0); STAMP_T0(SID * 10 + 6, _ti1);
            const size_t k1 = (size_t)(t + 1) * kstepA;
            const char* a2 = last ? nA : cA; const char* b2 = last ? nB : cB + (size_t)(t + 2) * kstep;
            const size_t k2 = last ? 0 : (size_t)(t + 2) * kstepA, k3 = k2 + kstepA;
            const char* b3 = b2 + kstep;
            unsigned O2[2];
            if constexpr (GATHER) { O2[0] = last ? ON[0] : OA[0]; O2[1] = last ? ON[1] : OA[1]; }
            PG8_LDB(B0, 0, 0); PG8_LDB(B1, 0, 1); PG8_SCHED; PG8_LDA(At, 0, 0); PG8_STAGE_A(PG8_SA(1, 1), cA, OA, 1, k1);
            PG8_WAIT_V(8); PG8_WAIT_L(0); PG8_BAR; PG8_MMA(0, 0, At, B0); PG8_MMA(0, 1, At, B1); PG8_BAR; PG8_SCHED;
            PG8_LDA(At, 0, 1); PG8_STAGE(PG8_SB(0, 0), b2, voffB); PG8_STAGE(PG8_SB(0, 1), b2 + hstepB, voffB); PG8_STAGE_A(PG8_SA(0, 0), a2, O2, 0, k2);
            PG8_WAIT_V(8); PG8_WAIT_L(0); PG8_BAR; PG8_MMA(1, 0, At, B0); PG8_MMA(1, 1, At, B1); PG8_BAR; PG8_SCHED;
            PG8_LDB(B0, 1, 0); PG8_LDB(B1, 1, 1); PG8_SCHED; PG8_LDA(At, 1, 0); PG8_STAGE_A(PG8_SA(0, 1), a2, O2, 1, k2);
            PG8_WAIT_V(8); PG8_WAIT_L(0); PG8_BAR; PG8_MMA(0, 0, At, B0); PG8_MMA(0, 1, At, B1); PG8_BAR; PG8_SCHED;
            PG8_LDA(At, 1, 1); PG8_STAGE(PG8_SB(1, 0), b3, voffB); PG8_STAGE(PG8_SB(1, 1), b3 + hstepB, voffB); PG8_STAGE_A(PG8_SA(1, 0), a2, O2, 0, k3);
            PG8_WAIT_V(8); PG8_WAIT_L(0); PG8_BAR; PG8_MMA(1, 0, At, B0); PG8_MMA(1, 1, At, B1); PG8_BAR; PG8_SCHED;
#ifdef STAMP
            if (STAMP == SID * 10 + 5 && t == 0) _d5 = (unsigned)__builtin_amdgcn_s_memtime() - _ti0;
            if (STAMP == SID * 10 + 6 && last) _d5 = (unsigned)__builtin_amdgcn_s_memtime() - _ti1;
#endif
        }
        STAMP_END_PUB(SID * 10 + 2, _tk, sctl, 37, (float)(STAMP_SCALE));
#ifdef STAMP
        if ((STAMP == SID * 10 + 5 || STAMP == SID * 10 + 6) && blockIdx.x == 37 && threadIdx.x == 0) __hip_atomic_store((unsigned*)(sctl + CW_DIAG), __float_as_uint((float)_d5 * (float)(STAMP_SCALE)), RLX_AGENT);
#endif
        STAMP_T0(SID * 10 + 3, _ta);
        if (wr == 0) PG8_BAR;
        STAMP_END_PUB(SID * 10 + 3, _ta, sctl, 37, (float)(STAMP_SCALE)); STAMP_T0(SID * 10 + 4, _tb);
        E(acc, cur, wr, wc, fr, fq);
        asm volatile("" ::: "memory"); STAMP_END_PUB(SID * 10 + 4, _tb, sctl, 37, (float)(STAMP_SCALE)); STAMP_END_PUB(SID * 10 + 1, _tu, sctl, 37, (float)(STAMP_SCALE));
        if (!has_next) break;
#pragma unroll
        for (int a = 0; a < 2; ++a)
#pragma unroll
            for (int b = 0; b < 2; ++b)
#pragma unroll
                for (int m = 0; m < 4; ++m)
#pragma unroll
                    for (int n = 0; n < 2; ++n) acc[a][b][m][n] = (f32x4){0.f, 0.f, 0.f, 0.f};
        cur = nxt; cA = nA; cB = nB; ++ui;
        if constexpr (GATHER) { OA[0] = ON[0]; OA[1] = ON[1]; }
        if (wr == 1) PG8_BAR;
    }
    PG8_WAIT_V(0);
    PG8_BAR;
#undef PG8_SA
#undef PG8_SB
#undef PG8_STAGE
#undef PG8_STAGE_A
#undef PG8_LDA
#undef PG8_LDB
#undef PG8_MMA
#undef PG8_WAIT_V
#undef PG8_WAIT_L
#undef PG8_BAR
#undef PG8_SCHED
#undef PG8_SETUP
}

struct EpiStoreBf16 {
    static constexpr bool PERM = true;
    bf16* O; int ldc;
    __device__ __forceinline__ void operator()(const f32x4 (&acc)[2][2][4][2], const Unit& u, int wr, int wc, int fr, int fq) const {
        const int row0 = u.pm * BM + wr * 64 + fr, col0 = u.pn * BM + wc * 32 + 8 * fq;
#pragma unroll
        for (int ai = 0; ai < 2; ++ai)
#pragma unroll
            for (int m = 0; m < 4; ++m) { bf16* rowp = O + (size_t)(row0 + ai * HALF + m * 16) * ldc + col0;
#pragma unroll
                for (int bj = 0; bj < 2; ++bj) { const f32x4 v0 = acc[ai][bj][m][0], v1 = acc[ai][bj][m][1];
                    v4u w; w.x = cvt_pk_bf16(v0[0], v0[1]); w.y = cvt_pk_bf16(v0[2], v0[3]); w.z = cvt_pk_bf16(v1[0], v1[1]); w.w = cvt_pk_bf16(v1[2], v1[3]);
                    __builtin_nontemporal_store(w, (v4u*)(rowp + bj * HALF)); } }
    }
};

struct EpiPre {
    static constexpr bool PERM = true;
    const bf16* base; bf16* out; int ldc;
    __device__ __forceinline__ void operator()(const f32x4 (&acc)[2][2][4][2], const Unit& u, int wr, int wc, int fr, int fq) const {
        const int row0 = u.pm * BM + wr * 64 + fr, col0 = u.pn * BM + wc * 32 + 8 * fq;
#pragma unroll
        for (int ai = 0; ai < 2; ++ai)
#pragma unroll
            for (int m = 0; m < 4; ++m) { const size_t off = (size_t)(row0 + ai * HALF + m * 16) * ldc + col0;
#pragma unroll
                for (int bj = 0; bj < 2; ++bj) { const v4u bs = *(const v4u*)(base + off + bj * HALF); const f32x4 v0 = acc[ai][bj][m][0], v1 = acc[ai][bj][m][1]; v4u w;
                    w.x = cvt_pk_bf16(fmaf(__uint_as_float(bs.x << 16), ALPHA, v0[0]), fmaf(__uint_as_float(bs.x & 0xffff0000u), ALPHA, v0[1]));
                    w.y = cvt_pk_bf16(fmaf(__uint_as_float(bs.y << 16), ALPHA, v0[2]), fmaf(__uint_as_float(bs.y & 0xffff0000u), ALPHA, v0[3]));
                    w.z = cvt_pk_bf16(fmaf(__uint_as_float(bs.z << 16), ALPHA, v1[0]), fmaf(__uint_as_float(bs.z & 0xffff0000u), ALPHA, v1[1]));
                    w.w = cvt_pk_bf16(fmaf(__uint_as_float(bs.w << 16), ALPHA, v1[2]), fmaf(__uint_as_float(bs.w & 0xffff0000u), ALPHA, v1[3]));
                    *(v4u*)(out + off + bj * HALF) = w; } }
    }
};
struct EpiS5U {
    static constexpr bool PERM = true;
    bf16* UA;
    __device__ __forceinline__ void operator()(const f32x4 (&acc)[2][2][4][2], const Unit& u, int wr, int wc, int fr, int fq) const {
#pragma unroll
        for (int ai = 0; ai < 2; ++ai)
#pragma unroll
            for (int m = 0; m < 4; ++m) { const int tok = u.pm * BM + ai * HALF + wr * 64 + m * 16 + fr; const int b = tok >> 11, l = tok & 2047, ch = l >> 4, tl = l & 15;
#pragma unroll
                for (int bj = 0; bj < 2; ++bj) { const int c0 = u.pn * BM + bj * HALF + wc * 32 + 8 * fq; const int g = c0 >> 4, cc = c0 & 15;
                    const f32x4 v0 = acc[ai][bj][m][0], v1 = acc[ai][bj][m][1];
                    v4u w; w.x = cvt_pk_bf16(v0[0], v0[1]); w.y = cvt_pk_bf16(v0[2], v0[3]); w.z = cvt_pk_bf16(v1[0], v1[1]); w.w = cvt_pk_bf16(v1[2], v1[3]);
                    *(v4u*)(UA + ((size_t)(g * 2048 + b * 128 + ch)) * 384 + tl * 16 + cc) = w; } }
    }
};
struct EpiS5Z {
    static constexpr bool PERM = false;
    float* Z;
    __device__ __forceinline__ void operator()(const f32x4 (&acc)[2][2][4][2], const Unit& u, int wr, int wc, int fr, int fq) const {
#pragma unroll
        for (int ai = 0; ai < 2; ++ai)
#pragma unroll
            for (int m = 0; m < 4; ++m) { float* rowp = Z + (size_t)(u.arow0 + ai * HALF + wr * 64 + m * 16 + fr) * 128 + wc * 32 + 4 * fq;
#pragma unroll
                for (int n = 0; n < 2; ++n) *(f32x4*)(rowp + n * 16) = acc[ai][0][m][n]; }
    }
};
__device__ __forceinline__ float gelu_tanh(float y) { const float z = 0.7978845608028654f * (y + 0.044715f * y * y * y); return y / (1.f + __expf(-2.f * z)); }
struct EpiS5Y {
    static constexpr bool PERM = true;
    bf16* G;
    __device__ __forceinline__ void operator()(const f32x4 (&acc)[2][2][4][2], const Unit& u, int wr, int wc, int fr, int fq) const {
        const int g = u.aux;
#pragma unroll
        for (int ai = 0; ai < 2; ++ai)
#pragma unroll
            for (int m = 0; m < 4; ++m) { const int row = u.pm * BM + ai * HALF + wr * 64 + m * 16 + fr; const int b = row >> 7, ch = row & 127;
#pragma unroll
                for (int bj = 0; bj < 2; ++bj) { const int c0 = bj * HALF + wc * 32 + 8 * fq; const int tl = c0 >> 4, cc = c0 & 15;
                    const f32x4 v0 = acc[ai][bj][m][0], v1 = acc[ai][bj][m][1];
                    v4u w; w.x = cvt_pk_bf16(gelu_tanh(v0[0]), gelu_tanh(v0[1])); w.y = cvt_pk_bf16(gelu_tanh(v0[2]), gelu_tanh(v0[3]));
                    w.z = cvt_pk_bf16(gelu_tanh(v1[0]), gelu_tanh(v1[1])); w.w = cvt_pk_bf16(gelu_tanh(v1[2]), gelu_tanh(v1[3]));
                    *(v4u*)(G + ((size_t)g * NTOK + (b * 2048 + ch * 16 + tl)) * 16 + cc) = w; } }
    }
};
template <int ACT> struct EpiGated {
    static constexpr bool PERM = true;
    bf16* O; int ldc;
    __device__ __forceinline__ void operator()(const f32x4 (&acc)[2][2][4][2], const Unit& u, int wr, int wc, int fr, int fq) const {
        const int col0 = u.pn * HALF + wc * 32 + 8 * fq;
#pragma unroll
        for (int ai = 0; ai < 2; ++ai)
#pragma unroll
            for (int m = 0; m < 4; ++m) { const int row = u.pm * BM + ai * HALF + wr * 64 + m * 16 + fr; float r[8];
#pragma unroll
                for (int n = 0; n < 2; ++n)
#pragma unroll
                    for (int j = 0; j < 4; ++j) { const float v = acc[ai][0][m][n][j], gt = acc[ai][1][m][n][j];
                        r[n * 4 + j] = ACT == 0 ? v / (1.f + __expf(-gt)) : v / (1.f + __expf(-v)) * gt; }
                v4u w; w.x = cvt_pk_bf16(r[0], r[1]); w.y = cvt_pk_bf16(r[2], r[3]); w.z = cvt_pk_bf16(r[4], r[5]); w.w = cvt_pk_bf16(r[6], r[7]);
                *(v4u*)(O + (size_t)row * ldc + col0) = w; }
    }
};
struct S5Order {
    int G, c;
    __device__ bool next(int i, Unit& u) const { const int L = i * G + c; if (L >= 512) return false; const int g = L >> 3, rt = L & 7;
        u.arow0 = g * 2048 + rt * BM; u.brow0 = g * BM; u.pm = rt; u.pn = 0; u.aux = g; u.cnt = BM; u.gather = nullptr; return true; }
};

struct MoeOrder {
    int cnt[NEXP]; const int* list; int G, c;
    __device__ bool next(int i, Unit& u) const { const int L = i * G + c, rt = L >> 2, pn = L & 3; int acc = 0, se = -1, loc = 0, sc = 0;
#pragma unroll
        for (int e = 0; e < NEXP; ++e) { const int ce = cnt[e], nt = (ce + 255) >> 8; if (rt >= acc && rt < acc + nt) { se = e; loc = rt - acc; sc = ce; } acc += nt; }
        if (se < 0) return false;
        u.arow0 = rt * BM; u.brow0 = se * 1024 + pn * BM; u.pm = rt; u.pn = pn; u.aux = se; const int rem = sc - loc * BM; u.cnt = rem < BM ? rem : BM; u.gather = list + se * NTOK + loc * BM; return true; }
};
struct EpiMoeDown {
    static constexpr bool PERM = true;
    const float* tokw; bf16* CB;
    __device__ __forceinline__ void operator()(const f32x4 (&acc)[2][2][4][2], const Unit& u, int wr, int wc, int fr, int fq) const {
        const int col0 = u.pn * BM + wc * 32 + 8 * fq;
#pragma unroll
        for (int ai = 0; ai < 2; ++ai)
#pragma unroll
            for (int m = 0; m < 4; ++m) { const int r = ai * HALF + wr * 64 + m * 16 + fr;
                if (r < u.cnt) { const int ent = u.gather[r]; const int tok = ent >> 1, k = ent & 1; const float w = tokw[ent];
                    bf16* rowp = CB + ((size_t)k * NTOK + tok) * D + col0;
#pragma unroll
                    for (int bj = 0; bj < 2; ++bj) { const f32x4 v0 = acc[ai][bj][m][0] * w, v1 = acc[ai][bj][m][1] * w;
                        v4u o; o.x = cvt_pk_bf16(v0[0], v0[1]); o.y = cvt_pk_bf16(v0[2], v0[3]); o.z = cvt_pk_bf16(v1[0], v1[1]); o.w = cvt_pk_bf16(v1[2], v1[3]);
                        *(v4u*)(rowp + bj * HALF) = o; } } }
    }
};
}
#define XB_TMO      128
#define XB_XCNT(j)  (256  + 64 * (j))
#define XB_XSUB(j)  (1280 + 64 * (j))
#define XB_XGEN(j)  (2304 + 64 * (j))
#define XB_TOP      3328
#define XB_TOPGEN   3392
#define XCD_BAR_WORDS 3456
#define XB_SPIN_CAP (1u << 18)
__device__ __forceinline__ unsigned xb_ld(unsigned* p)              { return __hip_atomic_load(p, __ATOMIC_RELAXED, __HIP_MEMORY_SCOPE_AGENT); }
__device__ __forceinline__ unsigned xb_add(unsigned* p, unsigned v) { return __hip_atomic_fetch_add(p, v, __ATOMIC_RELAXED, __HIP_MEMORY_SCOPE_AGENT); }
__device__ __forceinline__ unsigned xb_xcc_id() { return (unsigned)__builtin_amdgcn_s_getreg((3 << 11) | 20) & 0xFu; }
#define XB_SPIN(cond, bar) do { unsigned _sp = 0; while (cond) { __builtin_amdgcn_s_sleep(1); \
    if ((++_sp & 255u) == 0u) { if (xb_ld(&(bar)[XB_TMO])) break; if (_sp > XB_SPIN_CAP) { atomicAdd(&(bar)[XB_TMO], 1u); break; } } } } while (0)
struct XcdBarrier { unsigned* bar; unsigned x; volatile LAS unsigned* st; };
__device__ __forceinline__ XcdBarrier xcd_barrier_post(unsigned* bar, volatile LAS unsigned* st) {
    XcdBarrier b; b.bar = bar; b.x = xb_xcc_id(); b.st = st;
    if (threadIdx.x == 0) (void)xb_add(&bar[XB_XCNT(b.x)], 1u);
    return b;
}
__device__ __forceinline__ void xcd_barrier_complete(unsigned* bar, unsigned x, unsigned& nloc, unsigned& nx) {
    const unsigned G = gridDim.x * gridDim.y * gridDim.z;
    unsigned sum, cnt, mine, sp = 0u;
    for (;;) {
        sum = 0u; cnt = 0u; mine = 0u;
#pragma unroll
        for (unsigned j = 0; j < 16; ++j) { const unsigned c = xb_ld(&bar[XB_XCNT(j)]); sum += c; cnt += (c > 0u) ? 1u : 0u; mine = (j == x) ? c : mine; }
        if (sum == G) break;
        __builtin_amdgcn_s_sleep(1);
        if ((++sp & 255u) == 0u) { if (xb_ld(&bar[XB_TMO])) break; if (sp > XB_SPIN_CAP) { atomicAdd(&bar[XB_TMO], 1u); break; } }
    }
    nloc = mine > 0u ? mine : 1u; nx = cnt > 0u ? cnt : 1u;
}
__device__ __forceinline__ void xcd_barrier(const XcdBarrier& b) {
    asm volatile("s_waitcnt vmcnt(0)" ::: "memory");
    __syncthreads();
    if (threadIdx.x == 0) {
        unsigned* bar = b.bar;
        __builtin_amdgcn_s_waitcnt(0);
        unsigned nloc = b.st[0], nx = b.st[1];
        if (nloc == 0u) { xcd_barrier_complete(bar, b.x, nloc, nx); b.st[0] = nloc; b.st[1] = nx; }
        const unsigned old = xb_add(&bar[XB_XSUB(b.x)], 1u);
        const unsigned gen = old / nloc;
        if (old + 1u == (gen + 1u) * nloc) {
            __builtin_amdgcn_fence(__ATOMIC_RELEASE, "agent");
            asm volatile("s_waitcnt vmcnt(0)" ::: "memory");
            const unsigned og = xb_add(&bar[XB_TOP], 1u);
            const unsigned tg = og / nx;
            if (og + 1u == (tg + 1u) * nx) xb_add(&bar[XB_TOPGEN], 1u);
            else XB_SPIN(xb_ld(&bar[XB_TOPGEN]) == tg, bar);
            __builtin_amdgcn_fence(__ATOMIC_ACQUIRE, "agent");
            xb_add(&bar[XB_XGEN(b.x)], 1u);
            asm volatile("s_waitcnt vmcnt(0)" ::: "memory");
        } else {
            XB_SPIN(xb_ld(&bar[XB_XGEN(b.x)]) == gen, bar);
            __builtin_amdgcn_fence(__ATOMIC_ACQUIRE, "agent");
            asm volatile("s_waitcnt vmcnt(0)" ::: "memory");
        }
    }
    __syncthreads();
}

constexpr int NWAVES = 8;
constexpr size_t MiB = 1u << 20;
constexpr size_t WS_CTL = 0, CTL_ZERO_BYTES = 1 * MiB;
constexpr size_t WS_WIN = 2 * MiB, WS_WOUT = 8 * MiB, WS_S5IN = 10 * MiB, WS_GLU = 12 * MiB, WS_S5OUT = 16 * MiB, WS_PG = 18 * MiB, WS_MQ = 26 * MiB;
constexpr size_t WS_WGU = 40 * MiB, WS_WD = 104 * MiB;
constexpr size_t WS_XB = 136 * MiB, WS_H = 200 * MiB, WS_MASK = 376 * MiB, WS_O = 384 * MiB, WS_F1 = 448 * MiB, WS_END = 512 * MiB;
constexpr int CW_TMO = 0, CW_CODE = 1, CW_CNT = 2048  , CW_BAR = 4096;
constexpr size_t WS_TOKPOS = 768 * 1024  ;
constexpr size_t WS_TOKW = 512 * 1024  , WS_LIST = 38 * MiB  ;
constexpr size_t WS_HMID = 200 * MiB  , WS_CB = 268 * MiB  ;
constexpr int RING_OFF = 0, RING_BYTES = 131072, LDS_BYTES = 147456, LDSCTL_OFF = LDS_BYTES - 512, MISC_OFF = LDSCTL_OFF + 320;

struct Frame {
    LAS unsigned char* lds; volatile LAS unsigned* MISC; gu32* ctl;
    int tid, lane, wave, vcu, G;
};
struct Args { const float* in[30]; float* out; unsigned char* ws; int ph_lo, ph_hi, li, pad; };

__device__ __forceinline__ void tr_item(const float* __restrict__ W, int ldw, bf16* WT, int ldt, int k0, int c0, int nc, int r0, LAS float* scr, int lane) {
    f32x4 v[8];
#pragma unroll
    for (int i = 0; i < 8; ++i) { const int idx = lane + 64 * i, kk = idx >> 3, c4 = (idx & 7) * 4; v[i] = (c4 < nc) ? *(const GAS f32x4*)(W + (size_t)(k0 + kk) * ldw + c0 + c4) : (f32x4){0.f, 0.f, 0.f, 0.f}; }
#pragma unroll
    for (int i = 0; i < 8; ++i) { const int idx = lane + 64 * i, kk = idx >> 3, c4 = (idx & 7) * 4; LAS float* s = scr + kk * 33 + c4; s[0] = v[i].x; s[1] = v[i].y; s[2] = v[i].z; s[3] = v[i].w; }
    LDS_WAIT(); asm volatile("" ::: "memory");
    const int c = lane & 7;
#pragma unroll
    for (int j = 0; j < 4; ++j) { const int n = (lane >> 3) + 8 * j; const LAS float* s = scr + (8 * c) * 33 + n;
        v4u o; o.x = pk2(s[0 * 33], s[1 * 33]); o.y = pk2(s[2 * 33], s[3 * 33]); o.z = pk2(s[4 * 33], s[5 * 33]); o.w = pk2(s[6 * 33], s[7 * 33]);
        if (n < nc) *(GAS v4u*)(WT + (size_t)(r0 + n) * ldt + k0 + 8 * c) = o; }
    LDS_WAIT(); asm volatile("" ::: "memory");
}

struct TrDesc { const float* W; int ldw; bf16* WT; int ldt, k0, c0, nc, r0; };
__device__ __forceinline__ void tr_load(const TrDesc& d, f32x4 (&v)[8], int lane) {
#pragma unroll
    for (int i = 0; i < 8; ++i) { const int idx = lane + 64 * i, kk = idx >> 3, c4 = (idx & 7) * 4; v[i] = (c4 < d.nc) ? __builtin_nontemporal_load((const GAS f32x4*)(d.W + (size_t)(d.k0 + kk) * d.ldw + d.c0 + c4)) : (f32x4){0.f, 0.f, 0.f, 0.f}; }
}
__device__ __forceinline__ void tr_store(const TrDesc& d, const f32x4 (&v)[8], LAS float* scr, int lane) {
#pragma unroll
    for (int i = 0; i < 8; ++i) { const int idx = lane + 64 * i, kk = idx >> 3, c4 = (idx & 7) * 4; LAS float* s = scr + kk * 33 + c4; s[0] = v[i].x; s[1] = v[i].y; s[2] = v[i].z; s[3] = v[i].w; }
    LDS_WAIT(); asm volatile("" ::: "memory");
    const int c = lane & 7;
#pragma unroll
    for (int j = 0; j < 4; ++j) { const int n = (lane >> 3) + 8 * j; const LAS float* s = scr + (8 * c) * 33 + n;
        v4u o; o.x = pk2(s[0 * 33], s[1 * 33]); o.y = pk2(s[2 * 33], s[3 * 33]); o.z = pk2(s[4 * 33], s[5 * 33]); o.w = pk2(s[6 * 33], s[7 * 33]);
        if (n < d.nc) *(GAS v4u*)(d.WT + (size_t)(d.r0 + n) * d.ldt + d.k0 + 8 * c) = o; }
    LDS_WAIT(); asm volatile("" ::: "memory");
}
__device__ __forceinline__ int tr_seg_items(int K, int ncols) { return (K / 64) * ((ncols + 31) / 32); }
__device__ __forceinline__ void tr_seg(const float* W, int ldw, int K, int c0, int ncols, bf16* WT, int ldt, int r0, int it, LAS float* scr, int lane) {
    const int nblk = (ncols + 31) / 32, kb = it / nblk, nb = it % nblk; const int rem = ncols - nb * 32;
    tr_item(W, ldw, WT, ldt, kb * 64, c0 + nb * 32, rem < 32 ? rem : 32, r0 + nb * 32, scr, lane);
}
constexpr size_t WS_UPD = WS_F1, WS_DEC = WS_LIST;
constexpr size_t OUT_SPREV = 16 * MiB, OUT_OI = 48 * MiB;
constexpr int GP = 72;
#define MFMA32(a, b, c) __builtin_amdgcn_mfma_f32_32x32x16_bf16((a), (b), (c), 0, 0, 0)
__device__ __forceinline__ int crow(int reg, int h) { return (reg & 3) + 8 * (reg >> 2) + 4 * h; }
__device__ __forceinline__ f32x16 mma_tile64(const LAS bf16* A, const LAS bf16* Bt, int lane) {
    const int r = lane & 31, h = lane >> 5; f32x16 acc;
#pragma unroll
    for (int i = 0; i < 16; ++i) acc[i] = 0.f;
#pragma unroll
    for (int kk = 0; kk < 4; ++kk) { const bf16x8 a = *(const LAS bf16x8*)(A + r * GP + kk * 16 + 8 * h), b = *(const LAS bf16x8*)(Bt + r * GP + kk * 16 + 8 * h); acc = MFMA32(a, b, acc); }
    return acc;
}
constexpr int GLA1_HALF = 71168;
__device__ __forceinline__ void gla1_pair(Frame& F, const Args& a, int unit0) {
    const int hw = F.wave >> 2, wl = F.wave & 3, lt = F.tid & 255, lane = F.lane, unit = unit0 + hw;
    const int b = unit >> 7, n = (unit >> 2) & 31, h = unit & 3;
    const size_t tok0 = (size_t)b * SEQ + n * 64;
    const bf16* H = (const bf16*)(a.ws + WS_H);
    LAS unsigned char* L = F.lds + RING_OFF + hw * GLA1_HALF;
    LAS float* CUM = (LAS float*)L;
    LAS bf16* P = (LAS bf16*)L;
    LAS bf16* QD = (LAS bf16*)(L + 16640);
    LAS bf16* KI = (LAS bf16*)(L + 25856);
    LAS bf16* KET = (LAS bf16*)(L + 35072);
    LAS bf16* VT = (LAS bf16*)(L + 44288);
    LAS float* GW = (LAS float*)(L + 62720);
    LAS float* GB = (LAS float*)(L + 66816);
    LAS float* BG = (LAS float*)(L + 67072);
    const float* gw2 = a.in[3]; const float* gb = a.in[4];
#pragma unroll
    for (int k = 0; k < 4; ++k) { const int i = lt + 256 * k; GW[i] = gw2[(i >> 6) * 256 + h * 64 + (i & 63)]; BG[i] = bf2f(H[(tok0 + (i >> 4)) * HP + HC_BG + (i & 15)]); }
    if (lt < 64) GB[lt] = gb[h * 64 + lt];
    v4u qv[2], kv[2], vv[4];
#pragma unroll
    for (int k = 0; k < 2; ++k) { const int idx = lt + 256 * k, t = idx >> 3, d8 = (idx & 7) * 8; qv[k] = *(const GAS v4u*)(H + (tok0 + t) * HP + HC_BQ + h * 64 + d8); kv[k] = *(const GAS v4u*)(H + (tok0 + t) * HP + HC_BK + h * 64 + d8); }
#pragma unroll
    for (int k = 0; k < 4; ++k) { const int idx = lt + 256 * k, j = idx & 63, e8 = (idx >> 6) * 8; vv[k] = *(const GAS v4u*)(H + (tok0 + j) * HP + HC_BV + h * 128 + e8); }
    __syncthreads();
#pragma unroll 4
    for (int k = 0; k < 16; ++k) { const int idx = lt + 256 * k, t = idx >> 6, d = idx & 63; float z = GB[d];
#pragma unroll
        for (int r = 0; r < 16; ++r) z = fmaf(BG[t * 16 + r], GW[r * 64 + d], z);
        const float ls = -(fmaxf(-z, 0.f) + __logf(1.f + __expf(-fabsf(z)))); CUM[t * 65 + d] = ls * (1.f / 16.f); }
    __syncthreads();
    LAS float* OFF = GW;
    { const int seg = lt >> 6, d = lt & 63; float run = 0.f;
#pragma unroll
      for (int k = 0; k < 16; ++k) { const int t = 16 * seg + k; run += CUM[t * 65 + d]; CUM[t * 65 + d] = run; } }
    __syncthreads();
    { const int seg = lt >> 6, d = lt & 63; float off = 0.f;
#pragma unroll
      for (int s2 = 0; s2 < 3; ++s2) if (s2 < seg) off += CUM[(16 * s2 + 15) * 65 + d];
      OFF[seg * 64 + d] = off; }
    __syncthreads();
    bf16* QG = (bf16*)a.out;
#pragma unroll
    for (int k = 0; k < 2; ++k) { const int idx = lt + 256 * k, t = idx >> 3, d8 = (idx & 7) * 8; unsigned qo[4], ko[4]; const unsigned qw[4] = {qv[k].x, qv[k].y, qv[k].z, qv[k].w}, kw[4] = {kv[k].x, kv[k].y, kv[k].z, kv[k].w};
#pragma unroll
        for (int p2 = 0; p2 < 4; ++p2) { float qd[2], ki[2];
#pragma unroll
            for (int s = 0; s < 2; ++s) { const int d = d8 + 2 * p2 + s; const float c = CUM[t * 65 + d] + OFF[(t >> 4) * 64 + d], last = CUM[63 * 65 + d] + OFF[3 * 64 + d];
                const float q = (s ? __uint_as_float(qw[p2] & 0xffff0000u) : __uint_as_float(qw[p2] << 16)) * 0.125f, kk = s ? __uint_as_float(kw[p2] & 0xffff0000u) : __uint_as_float(kw[p2] << 16);
                qd[s] = q * __expf(c); ki[s] = kk * __expf(-c); KET[d * GP + t] = (bf16)f2bf(kk * __expf(last - c)); }
            qo[p2] = cvt2bf(qd[0], qd[1]); ko[p2] = cvt2bf(ki[0], ki[1]); }
        const v4u qq = (v4u){qo[0], qo[1], qo[2], qo[3]}; *(LAS v4u*)(QD + t * GP + d8) = qq; *(GAS v4u*)(QG + (tok0 + t) * 256 + h * 64 + d8) = qq; *(LAS v4u*)(KI + t * GP + d8) = (v4u){ko[0], ko[1], ko[2], ko[3]}; }
    if (lt < 64) ((float*)(a.ws + WS_DEC))[unit * 64 + lt] = __expf(CUM[63 * 65 + lt] + OFF[3 * 64 + lt]);
#pragma unroll
    for (int k = 0; k < 4; ++k) { const int idx = lt + 256 * k, j = idx & 63, e8 = (idx >> 6) * 8; const v4u v = vv[k];
        VT[(e8 + 0) * GP + j] = (bf16)(v.x & 0xffff); VT[(e8 + 1) * GP + j] = (bf16)(v.x >> 16); VT[(e8 + 2) * GP + j] = (bf16)(v.y & 0xffff); VT[(e8 + 3) * GP + j] = (bf16)(v.y >> 16);
        VT[(e8 + 4) * GP + j] = (bf16)(v.z & 0xffff); VT[(e8 + 5) * GP + j] = (bf16)(v.z >> 16); VT[(e8 + 6) * GP + j] = (bf16)(v.w & 0xffff); VT[(e8 + 7) * GP + j] = (bf16)(v.w >> 16); }
    __syncthreads();
    { const int ti = wl >> 1, tj = wl & 1, nn = lane & 31, hh = lane >> 5;
        if (tj <= ti) { const f32x16 c = mma_tile64(QD + 32 * ti * GP, KI + 32 * tj * GP, lane);
#pragma unroll
            for (int i = 0; i < 16; ++i) { const int qi = 32 * ti + crow(i, hh), kj = 32 * tj + nn; P[qi * GP + kj] = (bf16)f2bf(kj <= qi ? c[i] : 0.f); } }
        else {
#pragma unroll
            for (int i = 0; i < 16; ++i) P[(32 * ti + crow(i, hh)) * GP + 32 * tj + nn] = (bf16)0; } }
    __syncthreads();
    bf16* oi = (bf16*)((unsigned char*)a.out + OUT_OI); float* up = (float*)(a.ws + WS_UPD) + (size_t)unit * 8192;
#pragma unroll
    for (int k = 0; k < 2; ++k) { const int tile = wl * 2 + k, nn = lane & 31, hh = lane >> 5;
      { const int ti = tile >> 2, te = tile & 3;
        const f32x16 c = mma_tile64(P + 32 * ti * GP, VT + 32 * te * GP, lane);
#pragma unroll
        for (int i = 0; i < 16; ++i) oi[(tok0 + 32 * ti + crow(i, hh)) * 512 + h * 128 + 32 * te + nn] = (bf16)f2bf(c[i]); }
      { const int te = tile >> 1, td = tile & 1;
        const f32x16 c = mma_tile64(VT + 32 * te * GP, KET + 32 * td * GP, lane);
#pragma unroll
        for (int i = 0; i < 16; ++i) up[(32 * te + crow(i, hh)) * 64 + 32 * td + nn] = c[i]; } }
    __syncthreads();
}
__device__ __forceinline__ void gla2_scan(Frame& F, const Args& a) {
    const float* UPD = (const float*)(a.ws + WS_UPD); const float* DEC = (const float*)(a.ws + WS_DEC); bf16* SP = (bf16*)((unsigned char*)a.out + OUT_SPREV);
    for (int x = F.vcu * (NWAVES * 64) + F.tid; x < BATCH * 4 * 128 * 16; x += F.G * NWAVES * 64) {
        const int d4 = (x & 15) * 4, e = (x >> 4) & 127, bh = x >> 11, b = bh >> 2, h = bh & 3; f32x4 S = (f32x4){0.f, 0.f, 0.f, 0.f};
        for (int n0 = 0; n0 < 32; n0 += 8) { f32x4 u[8], dc[8];
#pragma unroll
            for (int k = 0; k < 8; ++k) { const int unit = b * 128 + (n0 + k) * 4 + h; u[k] = *(const GAS f32x4*)(UPD + (size_t)unit * 8192 + e * 64 + d4); dc[k] = *(const GAS f32x4*)(DEC + unit * 64 + d4); }
#pragma unroll
            for (int k = 0; k < 8; ++k) { const int unit = b * 128 + (n0 + k) * 4 + h; v2u o; o.x = pk2(S.x, S.y); o.y = pk2(S.z, S.w); *(GAS v2u*)(SP + (size_t)unit * 8192 + e * 64 + d4) = o; S = dc[k] * S + u[k]; } } }
}
constexpr int GLA3_HALF = 61440;
__device__ __forceinline__ void gla3_pair(Frame& F, const Args& a, int unit0) {
    const int hw = F.wave >> 2, wl = F.wave & 3, lt = F.tid & 255, lane = F.lane, unit = unit0 + hw;
    const int b = unit >> 7, n = (unit >> 2) & 31, h = unit & 3;
    const size_t tok0 = (size_t)b * SEQ + n * 64;
    const bf16* H = (const bf16*)(a.ws + WS_H); const bf16* SP = (const bf16*)((const unsigned char*)a.out + OUT_SPREV) + (size_t)unit * 8192; const bf16* oi = (const bf16*)((const unsigned char*)a.out + OUT_OI);
    LAS unsigned char* L = F.lds + RING_OFF + hw * GLA3_HALF;
    LAS bf16* QD = (LAS bf16*)L;
    LAS bf16* ST = (LAS bf16*)(L + 9216);
    LAS float* OF = (LAS float*)(L + 27648);
    const int nn = lane & 31, hh = lane >> 5;
    v4u qreg[2], sreg[4]; bf16 oiv[2][16]; unsigned short brv[16][2];
#pragma unroll
    for (int k = 0; k < 2; ++k) { const int idx = lt + 256 * k, t = idx >> 3, d8 = (idx & 7) * 8; qreg[k] = *(const GAS v4u*)((const bf16*)a.out + (tok0 + t) * 256 + h * 64 + d8); }
#pragma unroll
    for (int k = 0; k < 4; ++k) { const int idx = lt + 256 * k, e = idx >> 3, d8 = (idx & 7) * 8; sreg[k] = *(const GAS v4u*)(SP + e * 64 + d8); }
#pragma unroll
    for (int k = 0; k < 2; ++k) { const int tile = wl * 2 + k, ti = tile >> 2, te = tile & 3;
#pragma unroll
        for (int i = 0; i < 16; ++i) oiv[k][i] = oi[(tok0 + 32 * ti + crow(i, hh)) * 512 + h * 128 + 32 * te + nn]; }
#pragma unroll
    for (int rr = 0; rr < 16; ++rr) { const bf16* br = H + (tok0 + wl * 16 + rr) * HP + HC_BR + h * 128; brv[rr][0] = br[lane]; brv[rr][1] = br[lane + 64]; }
    const float* ng = a.in[5]; const float ng0 = ng[h * 128 + lane], ng1 = ng[h * 128 + lane + 64];
#pragma unroll
    for (int k = 0; k < 2; ++k) { const int idx = lt + 256 * k, t = idx >> 3, d8 = (idx & 7) * 8; *(LAS v4u*)(QD + t * GP + d8) = qreg[k]; }
#pragma unroll
    for (int k = 0; k < 4; ++k) { const int idx = lt + 256 * k, e = idx >> 3, d8 = (idx & 7) * 8; *(LAS v4u*)(ST + e * GP + d8) = sreg[k]; }
    __syncthreads();
#pragma unroll
    for (int k = 0; k < 2; ++k) { const int tile = wl * 2 + k, ti = tile >> 2, te = tile & 3;
      const f32x16 c = mma_tile64(QD + 32 * ti * GP, ST + 32 * te * GP, lane);
#pragma unroll
      for (int i = 0; i < 16; ++i) { const int r = 32 * ti + crow(i, hh), e = 32 * te + nn; OF[r * 132 + e] = c[i] + bf2f(oiv[k][i]); } }
    __syncthreads();
    bf16* O = (bf16*)(a.ws + WS_O);
#pragma unroll
    for (int rr = 0; rr < 16; ++rr) { const int r = wl * 16 + rr; const float x0 = OF[r * 132 + lane], x1 = OF[r * 132 + lane + 64];
        const float mean = wsum(x0 + x1) * (1.f / 128.f), d0 = x0 - mean, d1 = x1 - mean, var = wsum(d0 * d0 + d1 * d1) * (1.f / 128.f), rs = 1.f / sqrtf(var + LN_EPS);
        const float r0 = bf2f(brv[rr][0]), r1 = bf2f(brv[rr][1]);
        bf16* o = O + (tok0 + r) * D + 512 + h * 128;
        o[lane] = (bf16)f2bf(d0 * rs * ng0 * (r0 / (1.f + __expf(-r0)))); o[lane + 64] = (bf16)f2bf(d1 * rs * ng1 * (r1 / (1.f + __expf(-r1)))); }
    __syncthreads();
}
constexpr int SCP = 2048 + 16;
__device__ __forceinline__ unsigned fkey(float f) { const unsigned u = __float_as_uint(f); return (u & 0x80000000u) ? ~u : (u | 0x80000000u); }
__device__ __forceinline__ int wave_sum_dpp(int x) {
    x += __builtin_amdgcn_update_dpp(0, x, 0xB1, 0xF, 0xF, true);
    x += __builtin_amdgcn_update_dpp(0, x, 0x4E, 0xF, 0xF, true);
    x += __builtin_amdgcn_update_dpp(0, x, 0x141, 0xF, 0xF, true);
    x += __builtin_amdgcn_update_dpp(0, x, 0x140, 0xF, 0xF, true);
    x += __builtin_amdgcn_update_dpp(0, x, 0x142, 0xA, 0xF, false);
    x += __builtin_amdgcn_update_dpp(0, x, 0x143, 0xC, 0xF, false);
    return __builtin_amdgcn_readlane(x, 63);
}
#define CNT4(OP, a0, a1, a2, a3, k0, k1, k2, k3, c) do { unsigned long long _m0, _m1, _m2, _m3; \
    asm volatile("v_cmp_" OP "_u32_e64 %4, %8, %12\n\tv_cmp_" OP "_u32_e64 %5, %9, %12\n\tv_cmp_" OP "_u32_e64 %6, %10, %12\n\tv_cmp_" OP "_u32_e64 %7, %11, %12\n\t" \
                 "v_addc_co_u32_e64 %0, %4, 0, %0, %4\n\tv_addc_co_u32_e64 %1, %5, 0, %1, %5\n\tv_addc_co_u32_e64 %2, %6, 0, %2, %6\n\tv_addc_co_u32_e64 %3, %7, 0, %3, %7" \
                 : "+v"(a0), "+v"(a1), "+v"(a2), "+v"(a3), "=&s"(_m0), "=&s"(_m1), "=&s"(_m2), "=&s"(_m3) : "v"(k0), "v"(k1), "v"(k2), "v"(k3), "v"(c)); } while (0)
template <int NCH> __device__ __forceinline__ unsigned topk_search(const unsigned (&key)[32], bool& exact) {
    unsigned K = 0u; exact = false;
#pragma unroll 1
    for (int bit = 31; bit >= 0; --bit) { const unsigned cand = K | (1u << bit); int a0 = 0, a1 = 0, a2 = 0, a3 = 0;
#pragma unroll
        for (int c = 0; c < NCH; ++c) CNT4("ge", a0, a1, a2, a3, key[4 * c], key[4 * c + 1], key[4 * c + 2], key[4 * c + 3], cand);
        const int cnt = wave_sum_dpp((a0 + a1) + (a2 + a3));
        if (cnt >= 256) { K = cand; if (cnt == 256) { exact = true; break; } } }
    return K;
}
template <int NCH> __device__ __forceinline__ int count_gt(const unsigned (&key)[32], unsigned K) { int a0 = 0, a1 = 0, a2 = 0, a3 = 0;
#pragma unroll
    for (int c = 0; c < NCH; ++c) CNT4("gt", a0, a1, a2, a3, key[4 * c], key[4 * c + 1], key[4 * c + 2], key[4 * c + 3], K);
    return wave_sum_dpp((a0 + a1) + (a2 + a3)); }
struct Dsa1Ops { bf16x8 af[4][2]; float wq[4][4]; };
__device__ __forceinline__ void dsa1_load(Frame& F, const Args& a, int b, int qt, Dsa1Ops& o) {
    const int lane = F.lane, fr = lane & 15, fq = lane >> 4, t0 = qt * 16;
    const bf16* H = (const bf16*)(a.ws + WS_H) + (size_t)b * SEQ * HP;
#pragma unroll
    for (int qg = 0; qg < 4; ++qg) {
#pragma unroll
        for (int kk = 0; kk < 2; ++kk) o.af[qg][kk] = *(const GAS bf16x8*)(H + (size_t)(t0 + qg * 4 + (fr >> 2)) * HP + HC_IQ + (fr & 3) * 64 + kk * 32 + fq * 8);
        const v2u wv = *(const GAS v2u*)(H + (size_t)(t0 + qg * 4 + fq) * HP + HC_IW);
        o.wq[qg][0] = __uint_as_float(wv.x << 16); o.wq[qg][1] = __uint_as_float(wv.x & 0xffff0000u); o.wq[qg][2] = __uint_as_float(wv.y << 16); o.wq[qg][3] = __uint_as_float(wv.y & 0xffff0000u); }
}
__device__ __forceinline__ void dsa1_unit(Frame& F, const Args& a, int b, int qt, Dsa1Ops& cur, int nb, int nqt) {
    const int lane = F.lane, w = F.wave, fr = lane & 15, fq = lane >> 4, t0 = qt * 16;
    const bf16* H = (const bf16*)(a.ws + WS_H) + (size_t)b * SEQ * HP;
    LAS float* SC = (LAS float*)(F.lds + RING_OFF);
    const int nkb = qt + 1, nmine = (nkb - w + 7) >> 3;
    STAMP_T0(210, _t210);
    LAS unsigned* SK = (LAS unsigned*)SC;
    bf16x8 bA[4][2], bB[4][2];
#define DSA1_LOADB(dst, i0) do { _Pragma("unroll") for (int u = 0; u < 4; ++u) if ((i0) + u < nmine) { const int kb = w + 8 * ((i0) + u); \
        _Pragma("unroll") for (int kk = 0; kk < 2; ++kk) dst[u][kk] = *(const GAS bf16x8*)(H + (size_t)(kb * 16 + fr) * HP + HC_IK + kk * 32 + fq * 8); } } while (0)
#define DSA1_MMAB(src, i0) do { _Pragma("unroll") for (int u = 0; u < 4; ++u) if ((i0) + u < nmine) { const int kb = w + 8 * ((i0) + u), s = kb * 16 + fr; \
        _Pragma("unroll") for (int qg = 0; qg < 4; ++qg) { f32x4 c = (f32x4){0.f, 0.f, 0.f, 0.f}; \
            c = __builtin_amdgcn_mfma_f32_16x16x32_bf16(cur.af[qg][0], src[u][0], c, 0, 0, 0); c = __builtin_amdgcn_mfma_f32_16x16x32_bf16(cur.af[qg][1], src[u][1], c, 0, 0, 0); \
            float sc = 0.f; _Pragma("unroll") for (int i = 0; i < 4; ++i) sc += cur.wq[qg][i] * fmaxf(c[i], 0.f); \
            SK[(qg * 4 + fq) * SCP + s] = (s <= t0 + qg * 4 + fq) ? fkey(sc) : 0u; } } } while (0)
    DSA1_LOADB(bA, 0);
#pragma unroll 1
    for (int i0 = 0; i0 < nmine; i0 += 8) {
        DSA1_LOADB(bB, i0 + 4); DSA1_MMAB(bA, i0);
        DSA1_LOADB(bA, i0 + 8); DSA1_MMAB(bB, i0 + 4);
    }
#undef DSA1_LOADB
#undef DSA1_MMAB
    __syncthreads();
    STAMP_END_PUB(210, _t210, F.ctl, 37, (float)(STAMP_SCALE)); STAMP_T0(211, _t211);
    if (nb >= 0) dsa1_load(F, a, nb, nqt, cur);
    unsigned long long* MASK = (unsigned long long*)(a.ws + WS_MASK);
    for (int _rp = 0; _rp < (PROBE == 23 ? 2 : 1); ++_rp)
#pragma unroll 1
    for (int rr = 0; rr < 2; ++rr) { const int r = w + 8 * rr, t = t0 + r, jmax = t >> 6, nch = (jmax >> 2) + 1;
        STAMP_T0(212, _t212);
        unsigned key[32];
#pragma unroll
        for (int c = 0; c < 8; ++c) {
            if (c < nch) {
#pragma unroll
                for (int jj = 0; jj < 4; ++jj) { const int s = (c * 4 + jj) * 64 + lane; const unsigned kv = SK[r * SCP + s]; key[c * 4 + jj] = (s <= t) ? kv : 0u; } }
            else {
#pragma unroll
                for (int jj = 0; jj < 4; ++jj) key[c * 4 + jj] = 0u; } }
        STAMP_END_PUB(212, _t212, F.ctl, 37, (float)(STAMP_SCALE));
        unsigned long long mine = 0ull;
        if (t < 256) {
#pragma unroll
            for (int j = 0; j < 4; ++j) { const unsigned long long bm = __ballot(j * 64 + lane <= t); if (lane == j) mine = bm; }
        } else {
            unsigned K; bool exact; int cgt = 0;
            STAMP_T0(213, _t213);
            switch (nch) {
                case 1: K = topk_search<1>(key, exact); if (!exact) cgt = count_gt<1>(key, K); break;
                case 2: K = topk_search<2>(key, exact); if (!exact) cgt = count_gt<2>(key, K); break;
                case 3: K = topk_search<3>(key, exact); if (!exact) cgt = count_gt<3>(key, K); break;
                case 4: K = topk_search<4>(key, exact); if (!exact) cgt = count_gt<4>(key, K); break;
                case 5: K = topk_search<5>(key, exact); if (!exact) cgt = count_gt<5>(key, K); break;
                case 6: K = topk_search<6>(key, exact); if (!exact) cgt = count_gt<6>(key, K); break;
                case 7: K = topk_search<7>(key, exact); if (!exact) cgt = count_gt<7>(key, K); break;
                default: K = topk_search<8>(key, exact); if (!exact) cgt = count_gt<8>(key, K); break;
            }
            STAMP_END_PUB(213, _t213, F.ctl, 37, (float)(STAMP_SCALE)); STAMP_T0(214, _t214);
            const int quota = 256 - cgt; int taken = 0; unsigned mlo = 0u, mhi = 0u;
#pragma unroll
            for (int j = 0; j < 32; ++j) if (j <= jmax) {
                unsigned long long bm;
                if (exact) bm = __ballot(key[j] >= K);
                else { const unsigned long long eq = __ballot(key[j] == K); const int pre = __builtin_amdgcn_mbcnt_hi((unsigned)(eq >> 32), __builtin_amdgcn_mbcnt_lo((unsigned)eq, 0u));
                       bm = __ballot(key[j] > K || (key[j] == K && taken + pre < quota)); taken += __builtin_popcountll(eq); }
                asm volatile("v_writelane_b32 %0, %2, %4\n\tv_writelane_b32 %1, %3, %4" : "+v"(mlo), "+v"(mhi) : "s"((unsigned)bm), "s"((unsigned)(bm >> 32)), "n"(j)); }
            mine = ((unsigned long long)mhi << 32) | mlo;
            STAMP_END_PUB(214, _t214, F.ctl, 37, (float)(STAMP_SCALE));
        }
        if (lane < 32) MASK[((size_t)b * SEQ + t) * 32 + lane] = mine; }
    STAMP_END_PUB(211, _t211, F.ctl, 37, (float)(STAMP_SCALE));
    __syncthreads();
}

constexpr float LOG2E = 1.4426950408889634f, SCL2 = 0.125f * 1.4426950408889634f;
__device__ __forceinline__ bf16x8 pack_step(const f32x16& x, int s) {
    v4u p;
    asm volatile("v_cvt_pk_bf16_f32 %0, %4, %5\n\tv_cvt_pk_bf16_f32 %1, %6, %7\n\tv_cvt_pk_bf16_f32 %2, %8, %9\n\tv_cvt_pk_bf16_f32 %3, %10, %11\n\ts_nop 1"
                 : "=&v"(p[0]), "=&v"(p[1]), "=&v"(p[2]), "=&v"(p[3])
                 : "v"(x[8 * s]), "v"(x[8 * s + 1]), "v"(x[8 * s + 2]), "v"(x[8 * s + 3]), "v"(x[8 * s + 4]), "v"(x[8 * s + 5]), "v"(x[8 * s + 6]), "v"(x[8 * s + 7]));
    return __builtin_bit_cast(bf16x8, p);
}
__device__ __forceinline__ void dsa2_unit(Frame& F, const Args& a, int b, int g, int qb) {
    const int tid = F.tid, lane = F.lane, w = F.wave, n = lane & 31, h = lane >> 5, hl = w >> 1, hh = g * 4 + hl, t0 = qb * 64, tq0 = t0 + 32 * (w & 1);
    const bf16* H = (const bf16*)(a.ws + WS_H) + (size_t)b * SEQ * HP;
    const unsigned long long* MW = (const unsigned long long*)(a.ws + WS_MASK) + ((size_t)b * SEQ + tq0 + n) * 32;
    LAS unsigned char* L = F.lds + RING_OFF;
    LAS float* BT = (LAS float*)(L + 55296);
    LAS bf16* OS = (LAS bf16*)(L + 57344 + w * 4608);
    const float* relb = a.in[1];
    BT[tid] = relb[T5B[tid & 127] * 8 + g * 4 + (tid >> 7)] * LOG2E;
    const float B31 = relb[31 * 8 + hh] * LOG2E;
    bf16x8 Qf[4];
#pragma unroll
    for (int kk = 0; kk < 4; ++kk) Qf[kk] = *(const GAS bf16x8*)(H + (size_t)(tq0 + n) * HP + HC_AQ + hh * 64 + kk * 16 + 8 * h);
    f32x16 O[2];
#pragma unroll
    for (int i = 0; i < 16; ++i) { O[0][i] = 0.f; O[1][i] = 0.f; }
    float m = -1e30f, lsum = 0.f;
    const int krow = tid >> 3, kc8 = (tid & 7) * 8, vrow = tid & 63, vc8 = (tid >> 6) * 8, nt = qb + 1;
    v4u kreg, vreg;
#define DSA_LOADT(kt) do { kreg = *(const GAS v4u*)(H + (size_t)((kt) * 64 + krow) * HP + HC_AK + g * 64 + kc8); vreg = *(const GAS v4u*)(H + (size_t)((kt) * 64 + vrow) * HP + HC_AV + g * 64 + vc8); } while (0)
#define DSA_WRITET(bu) do { LAS bf16* _ks = (LAS bf16*)(L + (bu) * 18432); LAS bf16* _vt = (LAS bf16*)(L + (bu) * 18432 + 9216); *(LAS v4u*)(_ks + krow * GP + kc8) = kreg; \
        _vt[(vc8 + 0) * GP + vrow] = (bf16)(vreg.x & 0xffff); _vt[(vc8 + 1) * GP + vrow] = (bf16)(vreg.x >> 16); _vt[(vc8 + 2) * GP + vrow] = (bf16)(vreg.y & 0xffff); _vt[(vc8 + 3) * GP + vrow] = (bf16)(vreg.y >> 16); \
        _vt[(vc8 + 4) * GP + vrow] = (bf16)(vreg.z & 0xffff); _vt[(vc8 + 5) * GP + vrow] = (bf16)(vreg.z >> 16); _vt[(vc8 + 6) * GP + vrow] = (bf16)(vreg.w & 0xffff); _vt[(vc8 + 7) * GP + vrow] = (bf16)(vreg.w >> 16); } while (0)
#define DSA_QK(Sd, bu) do { const LAS bf16* _ks = (const LAS bf16*)(L + (bu) * 18432); _Pragma("unroll") for (int sb = 0; sb < 2; ++sb) { _Pragma("unroll") for (int i = 0; i < 16; ++i) Sd[sb][i] = 0.f; \
        _Pragma("unroll") for (int kk = 0; kk < 4; ++kk) { const bf16x8 ka = *(const LAS bf16x8*)(_ks + (32 * sb + n) * GP + kk * 16 + 8 * h); Sd[sb] = MFMA32(ka, Qf[kk], Sd[sb]); } } } while (0)
    DSA_LOADT(0); DSA_WRITET(0);
    if (nt > 1) { DSA_LOADT(1); DSA_WRITET(1); }
    if (nt > 2) DSA_LOADT(2);
    unsigned long long mw = MW[0];
    __syncthreads();
#define DSA_MASK(p, wsh, pos) do { int _t; asm volatile("v_bfe_i32 %1, %2, %3, 1\n\tv_and_b32 %0, %0, %1" : "+v"(p), "=&v"(_t) : "v"(wsh), "n"(pos)); } while (0)
#define DSA_TILE(Sc, Sn, kt) do { STAMP_BEGIN(1); STAMP_BEGIN(2); \
        const int s1 = slot == 2 ? 0 : slot + 1, s2 = s1 == 2 ? 0 : s1 + 1; \
        if ((kt) + 2 < nt) DSA_WRITET(s2); \
        if ((kt) + 3 < nt) DSA_LOADT((kt) + 3); \
        const unsigned long long mwn = ((kt) + 1 < nt) ? MW[(kt) + 1] : 0ull; \
        if ((kt) + 1 < nt) DSA_QK(Sn, s1); \
        STAMP_END(2); STAMP_BEGIN(3); \
        const LAS bf16* VT = (const LAS bf16*)(L + slot * 18432 + 9216); \
        const unsigned wsh0 = (unsigned)mw >> (4 * h), wsh1 = (unsigned)(mw >> 32) >> (4 * h); \
        float mx = -1e30f; \
        if ((kt) < qb - 2) {     \
            _Pragma("unroll") for (int sb = 0; sb < 2; ++sb) _Pragma("unroll") for (int i = 0; i < 16; ++i) { Sc[sb][i] = fmaf(Sc[sb][i], SCL2, B31); mx = fmaxf(mx, Sc[sb][i]); } \
        } else { const int dbase = tq0 + n - (kt) * 64 - 4 * h; \
            _Pragma("unroll") for (int sb = 0; sb < 2; ++sb) _Pragma("unroll") for (int i = 0; i < 16; ++i) { int dist = dbase - (32 * sb + (i & 3) + 8 * (i >> 2)); dist = dist < 0 ? 0 : (dist > 127 ? 127 : dist); \
                Sc[sb][i] = fmaf(Sc[sb][i], SCL2, BT[hl * 128 + dist]); mx = fmaxf(mx, Sc[sb][i]); } } \
        mx = xhalf_max(mx); \
        const float mn = fmaxf(m, mx); \
        if (__any(mn > m)) { const float al = __builtin_amdgcn_exp2f(m - mn); _Pragma("unroll") for (int i = 0; i < 16; ++i) { O[0][i] *= al; O[1][i] *= al; } lsum *= al; } \
        m = mn; \
        _Pragma("unroll") for (int i = 0; i < 16; ++i) { float p0 = __builtin_amdgcn_exp2f(Sc[0][i] - m), p1 = __builtin_amdgcn_exp2f(Sc[1][i] - m); \
            DSA_MASK(p0, wsh0, (i & 3) + 8 * (i >> 2)); DSA_MASK(p1, wsh1, (i & 3) + 8 * (i >> 2)); Sc[0][i] = p0; Sc[1][i] = p1; lsum += p0 + p1; } \
        STAMP_END(3); STAMP_BEGIN(4); \
        _Pragma("unroll") for (int sb = 0; sb < 2; ++sb) _Pragma("unroll") for (int s = 0; s < 2; ++s) { const bf16x8 pf = pack_step(Sc[sb], s); \
            _Pragma("unroll") for (int db = 0; db < 2; ++db) { const LAS bf16* vp = VT + (32 * db + n) * GP + 32 * sb + 16 * s + 4 * h; \
                const bf16x4 lo = *(const LAS bf16x4*)vp, hi = *(const LAS bf16x4*)(vp + 8); \
                const bf16x8 vf = __builtin_shufflevector(lo, hi, 0, 1, 2, 3, 4, 5, 6, 7); O[db] = MFMA32(vf, pf, O[db]); } } \
        mw = mwn; slot = s1; STAMP_END(4); STAMP_BEGIN(5); \
        asm volatile("s_waitcnt lgkmcnt(0)" ::: "memory"); __builtin_amdgcn_s_barrier(); asm volatile("" ::: "memory"); STAMP_END(5); STAMP_END(1); } while (0)
    STAMP_DECL;
    f32x16 SA[2], SB[2];
    DSA_QK(SA, 0);
    int slot = 0;
#pragma unroll 1
    for (int kt = 0; kt < nt; kt += 2) {
        DSA_TILE(SA, SB, kt);
        if (kt + 1 < nt) DSA_TILE(SB, SA, kt + 1);
    }
#undef DSA_TILE
#undef DSA_MASK
    STAMP_PUBLISH(F.ctl, 37, 1.0f / 100000.f);
#undef DSA_LOADT
#undef DSA_WRITET
#undef DSA_QK
    const float lt = xhalf_sum(lsum), inv = 1.f / lt;
#pragma unroll
    for (int db = 0; db < 2; ++db)
#pragma unroll
        for (int i = 0; i < 16; ++i) OS[n * GP + 32 * db + crow(i, h)] = (bf16)f2bf(O[db][i] * inv);
    asm volatile("s_waitcnt lgkmcnt(0)" ::: "memory");
    bf16* Og = (bf16*)(a.ws + WS_O) + ((size_t)b * SEQ + tq0) * D + hh * 64;
#pragma unroll
    for (int k = 0; k < 4; ++k) { const int idx = lane + 64 * k, row = idx >> 3, c8 = (idx & 7) * 8; *(GAS v4u*)(Og + (size_t)row * D + c8) = *(const LAS v4u*)(OS + row * GP + c8); }
    __syncthreads();
}
#define CONV_MOE 1
__device__ __forceinline__ void s5_build_group(Frame& F, const Args& a, int g, int part, LAS unsigned char* base) {
    LAS f32x2* AP = (LAS f32x2*)base;
    LAS f32x2* BB = (LAS f32x2*)(base + 8704);
    LAS f32x2* CC = (LAS f32x2*)(base + 8704 + 8192);
    LAS float* KT = (LAS float*)(base + 8704 + 16384);
    const float* lam_re = a.in[8]; const float* lam_im = a.in[9]; const float* log_dt = a.in[10];
    const float* b_re = a.in[11]; const float* b_im = a.in[12]; const float* c_re = a.in[13]; const float* c_im = a.in[14]; const float* dsk = a.in[15];
    const int tid = F.tid;
    if (tid < 64) { const int p = tid;
        const float lr = fminf(lam_re[g * 64 + p], -1e-4f), li = lam_im[g * 64 + p], dt = expf(log_dt[g]);
        const float mag = expf(lr * dt), are = mag * cosf(li * dt), aim = mag * sinf(li * dt);
        const float den = lr * lr + li * li, nr = are - 1.f, cre = (nr * lr + aim * li) / den, cim = (aim * lr - nr * li) / den;
        float pr = 1.f, pi = 0.f;
        for (int m = 0; m <= 16; ++m) { AP[m * 64 + p] = (f32x2){pr, pi}; const float t = pr * are - pi * aim; pi = pr * aim + pi * are; pr = t; }
        for (int c = 0; c < 16; ++c) { const float br = b_re[(g * 64 + p) * 16 + c], bi = b_im[(g * 64 + p) * 16 + c]; BB[p * 16 + c] = (f32x2){cre * br - cim * bi, cre * bi + cim * br}; }
    }
    for (int e = tid; e < 1024; e += NWAVES * 64) CC[e] = (f32x2){c_re[g * 1024 + e], c_im[g * 1024 + e]};
    __syncthreads();
    { const int m = tid >> 5, c = (tid >> 1) & 15, hc = tid & 1;
      if (m <= 4 * part + 3) { float acc[8];
#pragma unroll
          for (int q = 0; q < 8; ++q) acc[q] = 0.f;
          for (int p = 0; p < 64; ++p) { const f32x2 cc = CC[c * 64 + p], ap = AP[m * 64 + p]; const float tr = cc.x * ap.x - cc.y * ap.y, ti = cc.x * ap.y + cc.y * ap.x;
#pragma unroll
              for (int q = 0; q < 8; ++q) { const f32x2 bb = BB[p * 16 + 8 * hc + q]; acc[q] = fmaf(tr, bb.x, fmaf(-ti, bb.y, acc[q])); } }
#pragma unroll
          for (int q = 0; q < 8; ++q) KT[(m << 8) + (c << 4) + 8 * hc + q] = acc[q]; } }
    __syncthreads();
    bf16* MQ = (bf16*)(a.ws + WS_MQ) + (size_t)g * 256 * 384; bf16* PG = (bf16*)(a.ws + WS_PG) + (size_t)g * 256 * 256;
    for (int v = tid; v < 64 * 48; v += NWAVES * 64) { const int row = 64 * part + v / 48, cv = v % 48, j = row >> 4, c = row & 15, col0 = cv * 8; float val[8];
        if (col0 < 256) { const int i = col0 >> 4, c20 = col0 & 15;
#pragma unroll
            for (int q = 0; q < 8; ++q) { float t = (i <= j) ? KT[((j - i) << 8) + (c << 4) + c20 + q] : 0.f; if (i == j && c == c20 + q) t += dsk[g * 16 + c]; val[q] = t; } }
        else { const int p0 = (col0 - 256) & 63; const bool im = (col0 - 256) >= 64;
#pragma unroll
            for (int q = 0; q < 8; ++q) { const f32x2 cc = CC[c * 64 + p0 + q], ap = AP[(j + 1) * 64 + p0 + q]; val[q] = im ? -(cc.x * ap.y + cc.y * ap.x) : (cc.x * ap.x - cc.y * ap.y); } }
        v4u o; o.x = pk2(val[0], val[1]); o.y = pk2(val[2], val[3]); o.z = pk2(val[4], val[5]); o.w = pk2(val[6], val[7]);
        *(GAS v4u*)(MQ + (size_t)row * 384 + col0) = o; }
    for (int v = tid; v < 64 * 32; v += NWAVES * 64) { const int row = 64 * part + (v >> 5), col0 = (v & 31) * 8, i = col0 >> 4, c20 = col0 & 15; float val[8];
        if (row < 128) { const int p = row & 63; const bool im = row >= 64; const f32x2 ap = AP[(15 - i) * 64 + p];
#pragma unroll
            for (int q = 0; q < 8; ++q) { const f32x2 bb = BB[p * 16 + c20 + q]; val[q] = im ? (ap.x * bb.y + ap.y * bb.x) : (ap.x * bb.x - ap.y * bb.y); } }
        else {
#pragma unroll
            for (int q = 0; q < 8; ++q) val[q] = 0.f; }
        v4u o; o.x = pk2(val[0], val[1]); o.y = pk2(val[2], val[3]); o.z = pk2(val[4], val[5]); o.w = pk2(val[6], val[7]);
        *(GAS v4u*)(PG + (size_t)row * 256 + col0) = o; }
    __syncthreads();
}
__device__ __forceinline__ void s5_scan_local(Frame& F, const Args& a) {
    const float* lam_re = a.in[8]; const float* lam_im = a.in[9]; const float* log_dt = a.in[10];
    bf16* UA = (bf16*)(a.ws + WS_H); const float* Z = (const float*)(a.ws + WS_H + 96 * MiB);
    const int p = F.lane, nun = (512 - F.vcu + F.G - 1) / F.G;
    for (int q = F.wave; q < 2 * nun; q += NWAVES) { const int L = (q >> 1) * F.G + F.vcu, g = L >> 3, b = 2 * (L & 7) + (q & 1);
        const float lr = fminf(lam_re[g * 64 + p], -1e-4f), li = lam_im[g * 64 + p], dt = expf(log_dt[g]);
        const float mag = expf(lr * dt); float ar = mag * cosf(li * dt), ai = mag * sinf(li * dt);
#pragma unroll
        for (int k = 0; k < 4; ++k) { const float t = ar * ar - ai * ai; ai = 2.f * ar * ai; ar = t; }
        float sr = 0.f, si = 0.f;
        const float* zp = Z + ((size_t)(g * 2048 + b * 128)) * 128 + p; bf16* up = UA + ((size_t)(g * 2048 + b * 128)) * 384 + 256 + p;
        for (int n0 = 0; n0 < 128; n0 += 16) { float zr[16], zi[16];
#pragma unroll
            for (int k = 0; k < 16; ++k) { zr[k] = zp[(size_t)(n0 + k) * 128]; zi[k] = zp[(size_t)(n0 + k) * 128 + 64]; }
#pragma unroll
            for (int k = 0; k < 16; ++k) { up[(size_t)(n0 + k) * 384] = (bf16)f2bf(sr); up[(size_t)(n0 + k) * 384 + 64] = (bf16)f2bf(si);
                const float t = ar * sr - ai * si + zr[k]; si = ar * si + ai * sr + zi[k]; sr = t; } } }
}
template <int COMB, bool ROUTE, bool F32OUT>
__device__ __forceinline__ void ln_phase(Frame& F, const bf16* src, const bf16* cb, const float* gamma, const float* beta, float* dst, bf16* dstb,
                                         const float* rc, const float* rbc, const float* rf, const float* rbf, unsigned* cnt, int* list, float* tokw, int* tokpos = nullptr) {
    const int gw = F.vcu * NWAVES + F.wave, NGW = F.G * NWAVES, lane = F.lane;
    f32x4 gv[4], bv[4];
#pragma unroll
    for (int j = 0; j < 4; ++j) { gv[j] = ((const GAS f32x4*)gamma)[lane + 64 * j]; bv[j] = ((const GAS f32x4*)beta)[lane + 64 * j]; }
    volatile LAS unsigned* RT = (volatile LAS unsigned*)(F.lds + RING_OFF);
    int lrow = F.wave * 16;
    f32x4 rcv[16];
    LAS f32x4* RF = (LAS f32x4*)(F.lds + RING_OFF + 4096);
    if (ROUTE) { if (F.tid < 16) RT[F.tid] = 0u;
#pragma unroll
        for (int j = 0; j < 4; ++j)
#pragma unroll
            for (int q = 0; q < 4; ++q) rcv[j * 4 + q] = *(const GAS f32x4*)(rc + (size_t)(256 * j + 4 * lane + q) * 4);
        for (int i = F.tid; i < 4096; i += NWAVES * 64) RF[i] = ((const GAS f32x4*)rf)[i];
        __syncthreads(); }
    int cs0 = 0, cs1 = 0, ns0 = 0, ns1 = 0; float cw0 = 0.f, cw1 = 0.f, nw0 = 0.f, nw1 = 0.f;
#define LN_INFO(r, s0, s1, w0, w1) do { const int _p0 = list[(r) * 2], _p1 = list[(r) * 2 + 1]; s0 = (int)RT[_p0 >> 20] * 256 + (_p0 & 0xfffff); s1 = (int)RT[_p1 >> 20] * 256 + (_p1 & 0xfffff); w0 = tokw[(r) * 2]; w1 = tokw[(r) * 2 + 1]; } while (0)
    if (COMB == 1) { if (F.tid < 16) { unsigned acc = 0; for (int e = 0; e < F.tid; ++e) acc += (__hip_atomic_load(cnt + 64 * e, RLX_AGENT) + 255u) >> 8; RT[F.tid] = acc; }
        __syncthreads(); LN_INFO(gw, cs0, cs1, cw0, cw1); if (gw + NGW < NTOK) LN_INFO(gw + NGW, ns0, ns1, nw0, nw1); }
    v2u nx[4], na[4], nb[4];
    { const GAS v2u* xr = (const GAS v2u*)(src + (size_t)gw * D) + lane;
#pragma unroll
      for (int j = 0; j < 4; ++j) nx[j] = xr[64 * j];
      if (COMB == 1) { const GAS v2u* c0 = (const GAS v2u*)(cb + (size_t)cs0 * D) + lane; const GAS v2u* c1 = (const GAS v2u*)(cb + (size_t)cs1 * D) + lane;
#pragma unroll
          for (int j = 0; j < 4; ++j) { na[j] = c0[64 * j]; nb[j] = c1[64 * j]; } }
      if (COMB == 2) { const GAS v2u* c0 = (const GAS v2u*)(cb + (size_t)gw * D) + lane;
#pragma unroll
          for (int j = 0; j < 4; ++j) na[j] = c0[64 * j]; } }
    for (int row = gw; row < NTOK; row += NGW) {
        f32x4 v[4]; float s = 0.f;
#pragma unroll
        for (int j = 0; j < 4; ++j) { v[j].x = __uint_as_float(nx[j].x << 16); v[j].y = __uint_as_float(nx[j].x & 0xffff0000u); v[j].z = __uint_as_float(nx[j].y << 16); v[j].w = __uint_as_float(nx[j].y & 0xffff0000u); }
        if (COMB == 2) {
#pragma unroll
            for (int j = 0; j < 4; ++j) { const v2u a = na[j];
                v[j].x = fmaf(__uint_as_float(a.x << 16), ALPHA, v[j].x); v[j].y = fmaf(__uint_as_float(a.x & 0xffff0000u), ALPHA, v[j].y);
                v[j].z = fmaf(__uint_as_float(a.y << 16), ALPHA, v[j].z); v[j].w = fmaf(__uint_as_float(a.y & 0xffff0000u), ALPHA, v[j].w); } }
        if (COMB == 1) {
#pragma unroll
            for (int j = 0; j < 4; ++j) { const v2u a = na[j], b = nb[j];
                v[j].x = fmaf(v[j].x, ALPHA, fmaf(__uint_as_float(a.x << 16), cw0, __uint_as_float(b.x << 16) * cw1)); v[j].y = fmaf(v[j].y, ALPHA, fmaf(__uint_as_float(a.x & 0xffff0000u), cw0, __uint_as_float(b.x & 0xffff0000u) * cw1));
                v[j].z = fmaf(v[j].z, ALPHA, fmaf(__uint_as_float(a.y << 16), cw0, __uint_as_float(b.y << 16) * cw1)); v[j].w = fmaf(v[j].w, ALPHA, fmaf(__uint_as_float(a.y & 0xffff0000u), cw0, __uint_as_float(b.y & 0xffff0000u) * cw1)); } }
        if (row + NGW < NTOK) { const int nr = row + NGW; const GAS v2u* xr = (const GAS v2u*)(src + (size_t)nr * D) + lane;
#pragma unroll
            for (int j = 0; j < 4; ++j) nx[j] = xr[64 * j];
            if (COMB == 1) { const GAS v2u* c0 = (const GAS v2u*)(cb + (size_t)ns0 * D) + lane; const GAS v2u* c1 = (const GAS v2u*)(cb + (size_t)ns1 * D) + lane;
#pragma unroll
                for (int j = 0; j < 4; ++j) { na[j] = c0[64 * j]; nb[j] = c1[64 * j]; }
                cw0 = nw0; cw1 = nw1; if (nr + NGW < NTOK) LN_INFO(nr + NGW, ns0, ns1, nw0, nw1); }
            if (COMB == 2) { const GAS v2u* c0 = (const GAS v2u*)(cb + (size_t)nr * D) + lane;
#pragma unroll
                for (int j = 0; j < 4; ++j) na[j] = c0[64 * j]; } }
#pragma unroll
        for (int j = 0; j < 4; ++j) s += (v[j].x + v[j].y) + (v[j].z + v[j].w);
        const float mean = wsum(s) * (1.f / D); float s2 = 0.f;
#pragma unroll
        for (int j = 0; j < 4; ++j) { v[j] = v[j] - mean; s2 += (v[j].x * v[j].x + v[j].y * v[j].y) + (v[j].z * v[j].z + v[j].w * v[j].w); }
        const float rstd = 1.f / sqrtf(wsum(s2) * (1.f / D) + LN_EPS);
        GAS v2u* ob = (GAS v2u*)(dstb + (size_t)row * D) + lane;
#pragma unroll
        for (int j = 0; j < 4; ++j) { v[j] = v[j] * rstd * gv[j] + bv[j]; v2u w; w.x = cvt2bf(v[j].x, v[j].y); w.y = cvt2bf(v[j].z, v[j].w); if (dstb) ob[64 * j] = w;
            if (F32OUT) { f32x4 ov = v[j];
#ifdef STAMP
                ov = ov * (1.f + __uint_as_float(__hip_atomic_load((unsigned*)(F.ctl + CW_DIAG), RLX_AGENT)));
#endif
                __builtin_nontemporal_store(ov, &((GAS f32x4*)(dst + (size_t)row * D) + lane)[64 * j]); } }
        if (ROUTE) {
            float gl[4] = {0.f, 0.f, 0.f, 0.f};
#pragma unroll
            for (int j = 0; j < 4; ++j)
#pragma unroll
                for (int q = 0; q < 4; ++q) { const f32x4 r = rcv[j * 4 + q]; const float xv = v[j][q];
                    gl[0] = fmaf(xv, r.x, gl[0]); gl[1] = fmaf(xv, r.y, gl[1]); gl[2] = fmaf(xv, r.z, gl[2]); gl[3] = fmaf(xv, r.w, gl[3]); }
#pragma unroll
            for (int g = 0; g < 4; ++g) gl[g] = wsum(gl[g]) + rbc[g];
            int gs = 0; float gm = gl[0];
#pragma unroll
            for (int g = 1; g < 4; ++g) if (gl[g] > gm) { gm = gl[g]; gs = g; }
            float se = 0.f;
#pragma unroll
            for (int g = 0; g < 4; ++g) se += expf(gl[g] - gm);
            const float gwt = 1.f / se;
            float fl[4] = {0.f, 0.f, 0.f, 0.f}; const LAS f32x4* rfg = RF + gs * D;
#pragma unroll
            for (int j = 0; j < 4; ++j)
#pragma unroll
                for (int q = 0; q < 4; ++q) { const f32x4 r = rfg[256 * j + 4 * lane + q]; const float xv = v[j][q];
                    fl[0] = fmaf(xv, r.x, fl[0]); fl[1] = fmaf(xv, r.y, fl[1]); fl[2] = fmaf(xv, r.z, fl[2]); fl[3] = fmaf(xv, r.w, fl[3]); }
#pragma unroll
            for (int e = 0; e < 4; ++e) fl[e] = wsum(fl[e]) + rbf[gs * 4 + e];
            int i1 = 0; float v1 = fl[0];
#pragma unroll
            for (int e = 1; e < 4; ++e) if (fl[e] > v1) { v1 = fl[e]; i1 = e; }
            int i2 = -1; float v2 = -INFINITY;
#pragma unroll
            for (int e = 0; e < 4; ++e) if (e != i1 && fl[e] > v2) { v2 = fl[e]; i2 = e; }
            const float e2 = expf(v2 - v1), w1 = gwt / (1.f + e2), w2 = gwt * e2 / (1.f + e2);
            if (lane == 0) { const int ea = gs * 4 + i1, eb = gs * 4 + i2;
                const unsigned pa = __hip_atomic_fetch_add((LAS unsigned*)RT + ea, 1u, __ATOMIC_RELAXED, __HIP_MEMORY_SCOPE_WORKGROUP), pb = __hip_atomic_fetch_add((LAS unsigned*)RT + eb, 1u, __ATOMIC_RELAXED, __HIP_MEMORY_SCOPE_WORKGROUP);
                RT[64 + lrow] = (unsigned)ea | ((unsigned)eb << 8) | (pa << 16); RT[64 + 128 + lrow] = pb; tokw[row * 2] = w1; tokw[row * 2 + 1] = w2; }
            ++lrow;
        }
    }
    if (ROUTE) {
        __syncthreads();
        if (F.tid < 16) RT[32 + F.tid] = __hip_atomic_fetch_add(cnt + 64 * F.tid, RT[F.tid], RLX_AGENT);
        __syncthreads();
        if (F.tid < 128) { const int lr = F.tid, rw = lr >> 4, it = lr & 15, row = F.vcu * NWAVES + rw + it * NGW;
            if (row < NTOK) { const unsigned e = RT[64 + lr], pb = RT[64 + 128 + lr]; const int ea = e & 255, eb = (e >> 8) & 255; const unsigned pa = e >> 16;
                const unsigned ga = RT[32 + ea] + pa, gb = RT[32 + eb] + pb; list[ea * NTOK + ga] = row * 2; list[eb * NTOK + gb] = row * 2 + 1;
                tokpos[row * 2] = (ea << 20) | (int)ga; tokpos[row * 2 + 1] = (eb << 20) | (int)gb; } }
        __syncthreads();
    }
}

__device__ __forceinline__ void moe_convert(const Args& a, int layer, int part  , int wk, int nw, LAS float* scr, int lane) {
    unsigned char* ws = a.ws;
    constexpr int PER = 64, NU = NEXP * 2 * 4 * PER, PERD = 256, ND = NEXP * PERD;
    auto desc = [&](int it) { TrDesc d;
        if (it < NU) { int j = it / PER; const int r = it % PER, pn = j & 3; j >>= 2; const int which = j & 1; j >>= 1; const int le = layer * NEXP + j, kb = r >> 2, nb = r & 3;
            d.W = a.in[27 + which] + (size_t)le * D * MOE_F; d.ldw = MOE_F; d.WT = (bf16*)(ws + WS_WGU) + (size_t)le * 1024 * D; d.ldt = D; d.k0 = kb * 64; d.c0 = pn * 128 + nb * 32; d.nc = 32; d.r0 = pn * 256 + which * 128 + nb * 32; }
        else { const int q = it - NU, le = layer * NEXP + q / PERD, r = q % PERD, kb = r >> 5, nb = r & 31;
            d.W = a.in[29] + (size_t)le * MOE_F * D; d.ldw = D; d.WT = (bf16*)(ws + WS_WD) + (size_t)le * D * MOE_F; d.ldt = MOE_F; d.k0 = kb * 64; d.c0 = nb * 32; d.nc = 32; d.r0 = nb * 32; }
        return d; };
    const int lo = part == 1 ? NU : 0, hi = part == 0 ? NU : NU + ND;
    f32x4 va[8], vb[8]; int it = lo + wk;
    if (it < hi) { TrDesc d0 = desc(it); tr_load(d0, va, lane); }
    for (; it < hi; it += 2 * nw) {
        const TrDesc d0 = desc(it); const bool h1 = it + nw < hi, h2 = it + 2 * nw < hi;
        if (h1) { const TrDesc d1 = desc(it + nw); tr_load(d1, vb, lane); }
        tr_store(d0, va, scr, lane);
        if (h2) { const TrDesc d2 = desc(it + 2 * nw); tr_load(d2, va, lane); }
        if (h1) { const TrDesc d1 = desc(it + nw); tr_store(d1, vb, scr, lane); }
    }
}
__device__ __forceinline__ void p0_prologue(Frame& F, const Args& a) {
    STAMP_T0(301, _t301);
    for (int u = F.vcu; u < 256; u += F.G) s5_build_group(F, a, u >> 2, u & 3, F.lds + RING_OFF);
    STAMP_END_PUB(301, _t301, F.ctl, 37, (float)(STAMP_SCALE)); STAMP_T0(302, _t302);
    LAS float* scr = (LAS float*)(F.lds + RING_OFF + F.wave * 16384);
    const int gw = F.vcu * NWAVES + F.wave, NGW = F.G * NWAVES, lane = F.lane;
    unsigned char* ws = a.ws;
    { const float* x = a.in[0]; bf16* xb = (bf16*)(ws + WS_XB); const size_t n8 = (size_t)NTOK * D / 8, st = (size_t)NGW * 64;
      for (size_t i = (size_t)gw * 64 + lane; i < n8; i += 4 * st) { f32x4 v0[4], v1[4];
#pragma unroll
          for (int u = 0; u < 4; ++u) if (i + u * st < n8) { v0[u] = __builtin_nontemporal_load((const GAS f32x4*)(x + (i + u * st) * 8)); v1[u] = __builtin_nontemporal_load((const GAS f32x4*)(x + (i + u * st) * 8 + 4)); }
#pragma unroll
          for (int u = 0; u < 4; ++u) if (i + u * st < n8) { v4u o; o.x = pk2(v0[u].x, v0[u].y); o.y = pk2(v0[u].z, v0[u].w); o.z = pk2(v1[u].x, v1[u].y); o.w = pk2(v1[u].z, v1[u].w);
              *(GAS v4u*)(xb + (i + u * st) * 8) = o; } } }
    STAMP_END_PUB(302, _t302, F.ctl, 37, (float)(STAMP_SCALE)); STAMP_T0(303, _t303);
    { const float* W = a.in[2]; bf16* WT = (bf16*)(ws + WS_WIN);
      const int n0 = tr_seg_items(D, 1088), n1 = tr_seg_items(D, 4), n2 = tr_seg_items(D, 16), n3 = tr_seg_items(D, 1024), n4 = tr_seg_items(D, 512);
      for (int it = gw; it < n0; it += NGW) tr_seg(W, ABP, D, 0, 1088, WT, D, 0, it, scr, lane);
      for (int it = gw; it < n1; it += NGW) tr_seg(W, ABP, D, 1088, 4, WT, D, HC_IW, it, scr, lane);
      for (int it = gw; it < n2; it += NGW) tr_seg(W, ABP, D, 2116, 16, WT, D, HC_BG, it, scr, lane);
      for (int it = gw; it < n3; it += NGW) tr_seg(W, ABP, D, 1092, 1024, WT, D, HC_BQ, it, scr, lane);
      for (int it = gw; it < n4; it += NGW) tr_seg(W, ABP, D, 2132, 512, WT, D, HC_BR, it, scr, lane);
      for (int i = gw * 64 + lane; i < 172 * (D / 8); i += NGW * 64) { const int rr = i / (D / 8), cc = i % (D / 8); const int row = rr < 4 ? 1092 + rr : 1112 + (rr - 4);
          *(GAS v4u*)(WT + (size_t)row * D + cc * 8) = (v4u){0u, 0u, 0u, 0u}; } }
    { const int n = tr_seg_items(D, D);
      for (int it = gw; it < n; it += NGW) tr_seg(a.in[6], D, D, 0, D, (bf16*)(ws + WS_WOUT), D, 0, it, scr, lane);
      for (int it = gw; it < n; it += NGW) tr_seg(a.in[7], D, D, 0, D, (bf16*)(ws + WS_S5IN), D, 0, it, scr, lane);
      for (int it = gw; it < n; it += NGW) tr_seg(a.in[18], D, D, 0, D, (bf16*)(ws + WS_S5OUT), D, 0, it, scr, lane); }
    { const int n = 2 * 8 * tr_seg_items(D, 128);
      for (int it = gw; it < n; it += NGW) { const int per = tr_seg_items(D, 128), j = it / per, which = j & 1, pn = j >> 1;
          tr_seg(a.in[16 + which], D, D, pn * 128, 128, (bf16*)(ws + WS_GLU), D, pn * 256 + which * 128, it % per, scr, lane); } }
    STAMP_END_PUB(303, _t303, F.ctl, 37, (float)(STAMP_SCALE));
    __syncthreads();
}


#define MOE_PHASES(L, PU, PD, PL, LG, LB) \
    if (IN(PU)) { \
        pg8::Gemm g{(const bf16*)(ws + WS_XB), (const bf16*)(ws + WS_WGU) + (size_t)(L) * NEXP * 1024 * D, D, D, D}; \
        pg8::MoeOrder S; S.list = (const int*)(ws + WS_LIST); S.G = F.G; S.c = F.vcu;     _Pragma("unroll") for (int _e = 0; _e < NEXP; ++_e) S.cnt[_e] = __builtin_amdgcn_readfirstlane((int)__hip_atomic_load((unsigned*)(F.ctl + CW_CNT + 1024 * (L)) + 64 * _e, RLX_AGENT)); \
        pg8::EpiGated<1> E{(bf16*)(ws + WS_HMID), MOE_F}; \
        STAMP_T0(70 + (L) * 100, _t70); \
        RP(PU) pg8::gemm_phase<pg8::EpiGated<1>, pg8::MoeOrder, true, PU>(F.lds + RING_OFF, g, S, E, F.ctl); \
        STAMP_END_PUB(70 + (L) * 100, _t70, F.ctl, 37, (float)(STAMP_SCALE)); STAMP_T0(71, _t71); \
        if ((L) == 0) { int _T = 0; _Pragma("unroll") for (int _e = 0; _e < NEXP; ++_e) _T += (S.cnt[_e] + 255) >> 8; const int _n5 = 4 * _T - 4 * F.G;     \
            const bool _all = _n5 < 0 || _n5 >= F.G; const int _wk = _all ? F.vcu * NWAVES + F.wave : (F.vcu - _n5) * NWAVES + F.wave, _nw = _all ? F.G * NWAVES : (F.G - _n5) * NWAVES; \
            if (_all || F.vcu >= _n5) { LAS float* _scr = (LAS float*)(F.lds + RING_OFF + F.wave * 16384); moe_convert(args, 0, 1, _wk, _nw, _scr, F.lane); } } \
        STAMP_END_PUB(71, _t71, F.ctl, 37, (float)(STAMP_SCALE)); \
        if (BOTH(PU)) GRID_BAR(); } \
    if (IN(PD)) { \
        pg8::Gemm g{(const bf16*)(ws + WS_HMID), (const bf16*)(ws + WS_WD) + (size_t)(L) * NEXP * D * MOE_F, MOE_F, MOE_F, MOE_F}; \
        pg8::MoeOrder S; S.list = (const int*)(ws + WS_LIST); S.G = F.G; S.c = F.vcu;     _Pragma("unroll") for (int _e = 0; _e < NEXP; ++_e) S.cnt[_e] = __builtin_amdgcn_readfirstlane((int)__hip_atomic_load((unsigned*)(F.ctl + CW_CNT + 1024 * (L)) + 64 * _e, RLX_AGENT)); \
        pg8::EpiStoreBf16 E{(bf16*)(ws + WS_CB), D};     \
        STAMP_T0(72 + (L) * 100, _t72); \
        RP(PD) pg8::gemm_phase<pg8::EpiStoreBf16, pg8::MoeOrder, false, PD>(F.lds + RING_OFF, g, S, E, F.ctl); \
        STAMP_END_PUB(72 + (L) * 100, _t72, F.ctl, 37, (float)(STAMP_SCALE)); \
        if ((L) == 0) { int _T = 0; _Pragma("unroll") for (int _e = 0; _e < NEXP; ++_e) _T += (S.cnt[_e] + 255) >> 8; const int _n5 = 4 * _T - 4 * F.G;     \
            const bool _all = _n5 < 0 || _n5 >= F.G; const int _wk = _all ? F.vcu * NWAVES + F.wave : (F.vcu - _n5) * NWAVES + F.wave, _nw = _all ? F.G * NWAVES : (F.G - _n5) * NWAVES; \
            if (_all || F.vcu >= _n5) moe_convert(args, 1, 2, _wk, _nw, (LAS float*)(F.lds + RING_OFF + F.wave * 16384), F.lane); } \
        if (BOTH(PD)) GRID_BAR(); } \
    if (IN(PL)) { \
        if ((L) == 0) ln_phase<1, false, false>(F, (const bf16*)(ws + WS_XB), (const bf16*)(ws + WS_CB), LG, LB, nullptr, (bf16*)(ws + WS_XB), nullptr, nullptr, nullptr, nullptr, (unsigned*)(F.ctl + CW_CNT + 1024 * (L)), (int*)(ws + WS_TOKPOS), (float*)(ws + WS_TOKW)); \
        else ln_phase<1, false, true>(F, (const bf16*)(ws + WS_XB), (const bf16*)(ws + WS_CB), LG, LB, args.out, nullptr, nullptr, nullptr, nullptr, nullptr, (unsigned*)(F.ctl + CW_CNT + 1024 * (L)), (int*)(ws + WS_TOKPOS), (float*)(ws + WS_TOKW)); \
        if (BOTH(PL)) GRID_BAR(); }

__global__ void __launch_bounds__(NWAVES * 64, 2) mk_fwd(Args args) {
    extern __shared__ __attribute__((aligned(16))) unsigned char lds[];
    Frame F;
    F.lds = (LAS unsigned char*)lds; F.MISC = (volatile LAS unsigned*)(F.lds + MISC_OFF);
    F.tid = threadIdx.x; F.lane = F.tid & 63; F.wave = __builtin_amdgcn_readfirstlane(F.tid >> 6);
    F.G = gridDim.x; { const int bx = blockIdx.x; F.vcu = (F.G % 8 == 0) ? (bx % 8) * (F.G / 8) + bx / 8 : bx; }
    unsigned char* ws = args.ws;
    F.ctl = (gu32*)(ws + WS_CTL);
    for (int u = F.tid; u < (LDS_BYTES - LDSCTL_OFF) / 4; u += NWAVES * 64) ((LAS unsigned*)(F.lds + LDSCTL_OFF))[u] = 0u;
    __syncthreads();
    XcdBarrier bar = xcd_barrier_post((unsigned*)(F.ctl + CW_BAR) + args.li * XCD_BAR_WORDS, F.MISC + 8);
    const int lo = args.ph_lo, hi = args.ph_hi;
#define IN(k) (lo <= (k) && (k) < hi)
#define BOTH(k) (IN(k) && IN((k) + 1))
#ifdef STAMP
    int _bi = 0;
#define STAMP_BAR() do { if (STAMP >= 1000 && blockIdx.x == 37 && threadIdx.x == 0) { const unsigned _now = (unsigned)__builtin_amdgcn_s_memtime(); \
        if (_bi == STAMP - 1000) __hip_atomic_store((unsigned*)(F.ctl + CW_DIAG), __float_as_uint((float)(_now - F.MISC[20]) * (float)(STAMP_SCALE)), RLX_AGENT); \
        if (_bi + 1 == STAMP - 1000) F.MISC[20] = _now; } ++_bi; } while (0)
#define GRID_BAR() do { xcd_barrier(bar); STAMP_BAR(); } while (0)
    if (STAMP == 1000 && blockIdx.x == 37 && threadIdx.x == 0) F.MISC[20] = (unsigned)__builtin_amdgcn_s_memtime();
#else
#define GRID_BAR() xcd_barrier(bar)
#endif
#define RP(k) for (int _rp = 0; _rp < ((PROBE == (k)) ? 2 : 1); ++_rp)
    if (IN(0)) { RP(0) p0_prologue(F, args); if (BOTH(0)) GRID_BAR(); }
    if (IN(1)) {
        pg8::Gemm g{(const bf16*)(ws + WS_XB), (const bf16*)(ws + WS_WIN), D, D, D}; pg8::StaticOrder S; S.init(NTOK, HP, F.G, (int)blockIdx.x);
        pg8::EpiStoreBf16 E{(bf16*)(ws + WS_H), HP};
        RP(1) pg8::gemm_phase<pg8::EpiStoreBf16, pg8::StaticOrder, false, 1>(F.lds + RING_OFF, g, S, E, F.ctl);
        { const int units = (NTOK / 256) * (HP / 256), rem = units % F.G;
          if ((int)blockIdx.x >= rem) moe_convert(args, 0, 0, ((int)blockIdx.x - rem) * NWAVES + F.wave, (F.G - rem) * NWAVES, (LAS float*)(F.lds + RING_OFF + F.wave * 16384), F.lane); }
        if (BOTH(1)) GRID_BAR();
    }


    if (IN(2)) {
        STAMP_DECL; STAMP_BEGIN(200);
        RP(20) { Dsa1Ops ops; { const int x = F.vcu; if (x < 2048) dsa1_load(F, args, x >> 7, x & 127, ops); }
          for (int k = 0, x = F.vcu; x < 2048; ++k, x += F.G) { const int b = x >> 7, qb = x & 127, xn = x + F.G;
              const int nb = xn < 2048 ? (xn >> 7) : -1, nq = xn & 127; dsa1_unit(F, args, b, (k & 1) ? 127 - qb : qb, ops, nb, ((k + 1) & 1) ? 127 - nq : nq); } }
        STAMP_END(200); STAMP_BEGIN(201);
        RP(21) for (int u = F.vcu; u < 1024; u += F.G) gla1_pair(F, args, 2 * u);
        STAMP_END(201); STAMP_PUBLISH(F.ctl, 37, (float)(STAMP_SCALE));
        if (BOTH(2)) GRID_BAR(); }
    if (IN(3)) {
        RP(30) gla2_scan(F, args);
        RP(31) for (int v = F.vcu; v < 256; v += F.G) { const int bg = v >> 3, s = v & 7;
#pragma unroll 1
            for (int k = 0; k < 4; ++k) { const int qb = k == 0 ? s : (k == 1 ? 15 - s : (k == 2 ? 16 + s : 31 - s)); dsa2_unit(F, args, bg >> 1, bg & 1, qb); } }
        if (BOTH(3)) GRID_BAR(); }
    if (IN(4)) { RP(4) for (int u = F.vcu; u < 1024; u += F.G) gla3_pair(F, args, 2 * u); if (BOTH(4)) GRID_BAR(); }
    if (IN(5)) {
        pg8::Gemm g{(const bf16*)(ws + WS_O), (const bf16*)(ws + WS_WOUT), D, D, D}; pg8::StaticOrder S; S.init(NTOK, D, F.G, (int)blockIdx.x);
        pg8::EpiStoreBf16 E{(bf16*)(ws + WS_H), D};
        RP(5) pg8::gemm_phase<pg8::EpiStoreBf16, pg8::StaticOrder, false, 5>(F.lds + RING_OFF, g, S, E, F.ctl);
        if (BOTH(5)) GRID_BAR();
    }
    if (IN(6)) {
        ln_phase<2, true, false>(F, (const bf16*)(ws + WS_H), (const bf16*)(ws + WS_XB), args.in[19], args.in[20], nullptr, (bf16*)(ws + WS_XB), args.in[23], args.in[24], args.in[25], args.in[26],
                          (unsigned*)(F.ctl + CW_CNT), (int*)(ws + WS_LIST), (float*)(ws + WS_TOKW), (int*)(ws + WS_TOKPOS));
        if (BOTH(6)) GRID_BAR(); }
    MOE_PHASES(0, 7, 8, 9, args.in[21], args.in[22])
    if (IN(10)) {
        pg8::Gemm g{(const bf16*)(ws + WS_XB), (const bf16*)(ws + WS_S5IN), D, D, D}; pg8::StaticOrder S; S.init(NTOK, D, F.G, (int)blockIdx.x);
        pg8::EpiS5U E{(bf16*)(ws + WS_H)};
        RP(10) pg8::gemm_phase<pg8::EpiS5U, pg8::StaticOrder, false>(F.lds + RING_OFF, g, S, E);
        if (BOTH(10)) GRID_BAR();
    }
    if (IN(11)) {
        STAMP_T0(110, _t110);
        { pg8::Gemm g{(const bf16*)(ws + WS_H), (const bf16*)(ws + WS_PG), 384, 256, 256}; pg8::S5Order S{F.G, F.vcu};
          pg8::EpiS5Z E{(float*)(ws + WS_H + 96 * MiB)};
          pg8::gemm_phase<pg8::EpiS5Z, pg8::S5Order, false, 11>(F.lds + RING_OFF, g, S, E, F.ctl); }
        VM_WAIT(); __syncthreads();
        STAMP_END_PUB(110, _t110, F.ctl, 37, (float)(STAMP_SCALE)); STAMP_T0(111, _t111);
        s5_scan_local(F, args);
        VM_WAIT(); __syncthreads();
        STAMP_END_PUB(111, _t111, F.ctl, 37, (float)(STAMP_SCALE)); STAMP_T0(112, _t112);
        { pg8::Gemm g{(const bf16*)(ws + WS_H), (const bf16*)(ws + WS_MQ), 384, 384, 384}; pg8::S5Order S{F.G, F.vcu};
          pg8::EpiS5Y E{(bf16*)(ws + WS_O)};
          pg8::gemm_phase<pg8::EpiS5Y, pg8::S5Order, false, 13>(F.lds + RING_OFF, g, S, E, F.ctl); }
        STAMP_END_PUB(112, _t112, F.ctl, 37, (float)(STAMP_SCALE));
        if (IN(14)) GRID_BAR();
    }
    if (IN(14)) {
        pg8::Gemm g{(const bf16*)(ws + WS_O), (const bf16*)(ws + WS_GLU), D, D, D}; pg8::StaticOrder S; S.init(NTOK, 2 * D, F.G, (int)blockIdx.x);
        pg8::EpiGated<0> E{(bf16*)(ws + WS_F1), D};
        RP(14) pg8::gemm_phase<pg8::EpiGated<0>, pg8::StaticOrder, false, 14, true>(F.lds + RING_OFF, g, S, E, F.ctl);
        if (BOTH(14)) GRID_BAR();
    }
    if (IN(15)) {
        pg8::Gemm g{(const bf16*)(ws + WS_F1), (const bf16*)(ws + WS_S5OUT), D, D, D}; pg8::StaticOrder S; S.init(NTOK, D, F.G, (int)blockIdx.x);
        pg8::EpiStoreBf16 E{(bf16*)(ws + WS_H), D};
        pg8::gemm_phase<pg8::EpiStoreBf16, pg8::StaticOrder, false>(F.lds + RING_OFF, g, S, E);
        if (BOTH(15)) GRID_BAR();
    }
    if (IN(16)) {
        ln_phase<2, true, false>(F, (const bf16*)(ws + WS_H), (const bf16*)(ws + WS_XB), args.in[19] + D, args.in[20] + D, nullptr, (bf16*)(ws + WS_XB), args.in[23] + D * 4, args.in[24] + 4, args.in[25] + 4 * D * 4, args.in[26] + 16,
                          (unsigned*)(F.ctl + CW_CNT + 1024), (int*)(ws + WS_LIST), (float*)(ws + WS_TOKW), (int*)(ws + WS_TOKPOS));
        if (BOTH(16)) GRID_BAR(); }
    MOE_PHASES(1, 17, 18, 19, args.in[21] + D, args.in[22] + D)
#ifdef STAMP
    STAMP_BAR();
#endif
#undef IN
#undef BOTH
}
static int g_grid = 0;
extern "C" void kernel_launch(void* const* d_in, const int* in_sizes, int n_in, void* d_out, int out_size, void* d_ws, size_t ws_size, hipStream_t stream) {
    if (g_grid == 0) {
        if (n_in != 30 || out_size != NTOK * D || ws_size < WS_END) { fprintf(stderr, "kernel_launch: unexpected problem (n_in %d out %d ws %zu)\n", n_in, out_size, ws_size); g_grid = -1; return; }
        int dev = 0, cus = 0, per_cu = 0;
        if (hipGetDevice(&dev) != hipSuccess || hipDeviceGetAttribute(&cus, hipDeviceAttributeMultiprocessorCount, dev) != hipSuccess) { g_grid = -1; return; }
        if (hipFuncSetAttribute((const void*)mk_fwd, hipFuncAttributeMaxDynamicSharedMemorySize, LDS_BYTES) != hipSuccess) { fprintf(stderr, "kernel_launch: hipFuncSetAttribute failed\n"); g_grid = -1; return; }
        if (hipOccupancyMaxActiveBlocksPerMultiprocessor(&per_cu, (const void*)mk_fwd, NWAVES * 64, LDS_BYTES) != hipSuccess || per_cu < 1) fprintf(stderr, "kernel_launch: occupancy query says %d\n", per_cu);
        (void)hipGetLastError();
        if (cus < 256) { fprintf(stderr, "kernel_launch: built for a 256-CU MI355X (one workgroup per CU); found %d CUs\n", cus); g_grid = -1; return; }
        g_grid = 256;
    }
    if (g_grid < 0) return;
    (void)hipMemsetAsync((char*)d_ws + WS_CTL, 0, CTL_ZERO_BYTES, stream);
    Args a{};
    for (int i = 0; i < 30; ++i) a.in[i] = (const float*)d_in[i];
    a.out = (float*)d_out; a.ws = (unsigned char*)d_ws; a.ph_lo = 0; a.ph_hi = 20; a.li = 0; a.pad = 0;
    hipLaunchKernelGGL(mk_fwd, dim3(g_grid), dim3(NWAVES * 64), LDS_BYTES, stream, a);
}
```

```cpp
#include <hip/hip_runtime.h>
#include <math.h>
#include <stdio.h>
#include <stdint.h>

#define GAS __attribute__((address_space(1)))
#define LAS __attribute__((address_space(3)))
typedef unsigned short bf16;
typedef unsigned v4u __attribute__((ext_vector_type(4)));
typedef unsigned v2u __attribute__((ext_vector_type(2)));
typedef float f32x4 __attribute__((ext_vector_type(4)));
typedef float f32x2 __attribute__((ext_vector_type(2)));
typedef float f32x16 __attribute__((ext_vector_type(16)));
typedef short bf16x8 __attribute__((ext_vector_type(8)));
typedef short bf16x4 __attribute__((ext_vector_type(4)));
typedef GAS unsigned gu32;
#define RLX_AGENT __ATOMIC_RELAXED, __HIP_MEMORY_SCOPE_AGENT
#define LDS_WAIT() asm volatile("s_waitcnt lgkmcnt(0)" ::: "memory")
#define VM_WAIT() asm volatile("s_waitcnt vmcnt(0)" ::: "memory")

constexpr int D = 1024, BATCH = 16, SEQ = 2048, NTOK = BATCH * SEQ;
constexpr int ABP = 2644;
constexpr int HP = 2816;
constexpr int HC_AQ = 0, HC_AK = 512, HC_AV = 640, HC_IQ = 768, HC_IK = 1024, HC_IW = 1088, HC_BG = 1096, HC_BQ = 1280, HC_BK = 1536, HC_BV = 1792, HC_BR = 2304;
constexpr float ALPHA = 1.4142135623730951f;
constexpr float LN_EPS = 1e-5f;
constexpr int NEXP = 16, MOE_F = 512;
constexpr int MAXSLOT = 65536 + NEXP * 256;

__device__ __forceinline__ float bf2f(bf16 v) { return __uint_as_float(((unsigned)v) << 16); }
__device__ __forceinline__ unsigned f2bf(float f) { unsigned u = __float_as_uint(f); return (u + 0x7fffu + ((u >> 16) & 1u)) >> 16; }
__device__ __forceinline__ unsigned cvt2bf(float lo, float hi) { unsigned r; asm volatile("v_cvt_pk_bf16_f32 %0, %1, %2" : "=v"(r) : "v"(lo), "v"(hi)); return r; }
__device__ __forceinline__ unsigned pk2(float lo, float hi) { return f2bf(lo) | (f2bf(hi) << 16); }
__device__ __forceinline__ float wsum(float v) {
#define WS_DPP(ctrl, rm, bc) v += __int_as_float(__builtin_amdgcn_update_dpp(0, __float_as_int(v), ctrl, rm, 0xF, bc))
    WS_DPP(0xB1, 0xF, true); WS_DPP(0x4E, 0xF, true); WS_DPP(0x141, 0xF, true); WS_DPP(0x140, 0xF, true); WS_DPP(0x142, 0xA, false); WS_DPP(0x143, 0xC, false);
#undef WS_DPP
    return __int_as_float(__builtin_amdgcn_readlane(__float_as_int(v), 63));
}
__device__ const unsigned char T5B[128] = {0, 1, 2, 3, 4, 5, 6, 7, 8, 9, 10, 11, 12, 13, 14, 15, 16, 16, 16, 17, 17, 18, 18, 18, 19, 19, 19, 20, 20, 20, 20, 21, 21, 21, 21, 22, 22, 22, 22, 22, 23, 23, 23, 23, 23, 23, 24, 24, 24, 24, 24, 24, 25, 25, 25, 25, 25, 25, 25, 26, 26, 26, 26, 26, 26, 26, 26, 27, 27, 27, 27, 27, 27, 27, 27, 27, 27, 28, 28, 28, 28, 28, 28, 28, 28, 28, 28, 29, 29, 29, 29, 29, 29, 29, 29, 29, 29, 29, 29, 30, 30, 30, 30, 30, 30, 30, 30, 30, 30, 30, 30, 30, 30, 31, 31, 31, 31, 31, 31, 31, 31, 31, 31, 31, 31, 31, 31, 31};

__device__ __forceinline__ float xhalf_max(float v) { const auto r = __builtin_amdgcn_permlane32_swap(__float_as_uint(v), __float_as_uint(v), false, false); return fmaxf(__uint_as_float(r[0]), __uint_as_float(r[1])); }
__device__ __forceinline__ float xhalf_sum(float v) { const auto r = __builtin_amdgcn_permlane32_swap(__float_as_uint(v), __float_as_uint(v), false, false); return __uint_as_float(r[0]) + __uint_as_float(r[1]); }
#ifndef PROBE
#define PROBE -1
#endif
constexpr int CW_DIAG = 8;
#ifdef STAMP
#define STAMP_DECL unsigned _st_acc = 0u, _st_t0 = 0u, _st_n = 0u
#define STAMP_BEGIN(id) do { if (STAMP == (id)) _st_t0 = (unsigned)__builtin_amdgcn_s_memtime(); } while (0)
#define STAMP_END(id) do { if (STAMP == (id)) { _st_acc += (unsigned)__builtin_amdgcn_s_memtime() - _st_t0; ++_st_n; } } while (0)
#define STAMP_PUBLISH(ctl, wg, scale) do { if ((int)blockIdx.x == (wg) && threadIdx.x == 0 && _st_n) __hip_atomic_store((unsigned*)((ctl) + CW_DIAG), __float_as_uint((float)_st_acc / (float)_st_n * (scale)), RLX_AGENT); } while (0)
#define STAMP_T0(id, t0) unsigned t0 = 0u; do { if (STAMP == (id)) t0 = (unsigned)__builtin_amdgcn_s_memtime(); } while (0)
#define STAMP_END_PUB(id, t0, ctl, wg, scale) do { if (STAMP == (id)) { const unsigned _dt = (unsigned)__builtin_amdgcn_s_memtime() - t0; if ((int)blockIdx.x == (wg) && threadIdx.x == 0) __hip_atomic_store((unsigned*)((ctl) + CW_DIAG), __float_as_uint((float)_dt * (scale)), RLX_AGENT); } } while (0)
#else
#define STAMP_DECL
#define STAMP_BEGIN(id)
#define STAMP_END(id)
#define STAMP_PUBLISH(ctl, wg, scale)
#define STAMP_T0(id, t0)
#define STAMP_END_PUB(id, t0, ctl, wg, scale)
#endif
namespace pg8 {
#define PG8_LAS __attribute__((address_space(3)))
constexpr int BM = 256, BK = 64, HALF = 128, HTB = HALF * BK * 2  , STAGE_BYTES = 8 * HTB, NXCD = 8, WGM = 4;
__host__ __device__ __forceinline__ int lds_byte(int r, int c) { const int st = (r >> 4) * 2 + (c >> 5), rr = r & 15, cc = c & 31, ob = rr * 64 + cc * 2; return st * 1024 + (ob ^ (((ob >> 9) & 1) << 5)); }
__host__ __device__ __forceinline__ void stage_rc(int b, int& R, int& C) { const int st = b / 1024, sb = b % 1024, swz = sb ^ (((sb >> 9) & 1) << 5); R = (st >> 1) * 16 + swz / 64; C = (st & 1) * 32 + (swz % 64) / 2; }
__host__ __device__ __forceinline__ int perm32(int rho) { const int n = rho >> 4, i = rho & 15; return 8 * (i >> 2) + 4 * n + (i & 3); }

struct Unit { int arow0, brow0, pm, pn, aux, cnt; const int* gather; };
struct Gemm { const bf16* A; const bf16* Bt; int lda, ldb, K; };

struct StaticOrder {
    int nM, nN, nwg, G, c;
    __device__ void init(int M, int N, int G_, int c_) { nM = M / BM; nN = N / BM; nwg = nM * nN; G = G_; c = c_; }
    __device__ bool next(int i, Unit& u) const {
        const long L = (long)i * G + c; if (L >= nwg) return false;
        int wgid = (int)L; { const int q = nwg / NXCD, r = nwg % NXCD, xcd = wgid % NXCD, off = wgid / NXCD; wgid = (xcd < r ? xcd * (q + 1) : r * (q + 1) + (xcd - r) * q) + off; }
        const int nig = WGM * nN, gid = wgid / nig, fm = gid * WGM, gsz = (nM - fm) < WGM ? (nM - fm) : WGM;
        u.pm = fm + ((wgid % nig) % gsz); u.pn = (wgid % nig) / gsz; u.arow0 = u.pm * BM; u.brow0 = u.pn * BM; u.aux = 0; u.cnt = BM; u.gather = nullptr; return true;
    }
};
__device__ __forceinline__ unsigned cvt_pk_bf16(float lo, float hi) { unsigned r; asm volatile("v_cvt_pk_bf16_f32 %0, %1, %2" : "=v"(r) : "v"(lo), "v"(hi)); return r; }

template <class Epi, class Sched, bool GATHER = false, int SID = 0, bool GA = false>
__device__ __forceinline__ void gemm_phase(PG8_LAS unsigned char* lds, const Gemm g, const Sched& S, const Epi& E, gu32* sctl = nullptr) {
    const int tid = threadIdx.x, wid = __builtin_amdgcn_readfirstlane(tid >> 6), lane = tid & 63, wr = wid >> 2, wc = wid & 3, fr = lane & 15, fq = lane >> 4;
    const int K = g.K, nt = K / BK;
    unsigned voffA[2], voffB[2];
#pragma unroll
    for (int i = 0; i < 2; ++i) { int R, C; stage_rc(tid * 16 + i * 8192, R, C); const int Rb = Epi::PERM ? ((R & ~31) + perm32(R & 31)) : R;
        voffA[i] = GATHER ? (unsigned)(C * 2) : (GA ? (unsigned)(R * 32 + (C >> 4) * (NTOK * 32) + (C & 15) * 2) : (unsigned)(R * g.lda + C) * 2u); voffB[i] = (unsigned)(Rb * g.ldb + C) * 2u; }
    const size_t kstep = (size_t)(BK * 2), kstepA = GA ? (size_t)4 * NTOK * 32 : kstep;
    const size_t hstepA = GA ? (size_t)HALF * 32 : (size_t)HALF * g.lda * 2, hstepB = (size_t)HALF * g.ldb * 2;
    const unsigned ldsw = (unsigned)wid * 1024u;
    const int aoff = lds_byte(wr * 64 + fr, fq * 8), boff = lds_byte(wc * 32 + fr, fq * 8);
#define PG8_SA(b, h) (((b) * 2 + (h)) * HTB)
#define PG8_SB(b, h) ((4 + (b) * 2 + (h)) * HTB)
#define PG8_STAGE(bufoff, gbase, voff) do { _Pragma("unroll") for (int _i = 0; _i < 2; ++_i) \
        __builtin_amdgcn_global_load_lds((const unsigned*)((const char*)(gbase) + (voff)[_i]), (PG8_LAS unsigned*)(lds + (bufoff) + ldsw + _i * 8192), 16, 0, 0); } while (0)
#define PG8_STAGE_A(bufoff, P, O, h, ko) do { _Pragma("unroll") for (int _i = 0; _i < 2; ++_i) { \
        const char* _p; if constexpr (GATHER) { const unsigned _t = _i ? ((O)[h] >> 16) : ((O)[h] & 0xffffu); _p = (const char*)(P) + (ko) + (size_t)(_t * (unsigned)(g.lda * 2) + voffA[_i]); } \
        else _p = (const char*)(P) + (ko) + (size_t)(h) * hstepA + voffA[_i]; \
        __builtin_amdgcn_global_load_lds((const unsigned*)_p, (PG8_LAS unsigned*)(lds + (bufoff) + ldsw + _i * 8192), 16, 0, 0); } } while (0)
#define PG8_LDA(dst, b, h) do { _Pragma("unroll") for (int m = 0; m < 4; ++m) _Pragma("unroll") for (int k = 0; k < 2; ++k) dst[m][k] = *(const PG8_LAS bf16x8*)(lds + PG8_SA(b, h) + aoff + m * 2048 + k * 1024); } while (0)
#define PG8_LDB(dst, b, h) do { _Pragma("unroll") for (int n = 0; n < 2; ++n) _Pragma("unroll") for (int k = 0; k < 2; ++k) dst[n][k] = *(const PG8_LAS bf16x8*)(lds + PG8_SB(b, h) + boff + n * 2048 + k * 1024); } while (0)
#define PG8_MMA(ai, bj, At, Bt) do { __builtin_amdgcn_s_setprio(1); _Pragma("unroll") for (int m = 0; m < 4; ++m) _Pragma("unroll") for (int n = 0; n < 2; ++n) _Pragma("unroll") for (int k = 0; k < 2; ++k) \
        acc[ai][bj][m][n] = __builtin_amdgcn_mfma_f32_16x16x32_bf16(Bt[n][k], At[m][k], acc[ai][bj][m][n], 0, 0, 0); __builtin_amdgcn_s_setprio(0); } while (0)
#define PG8_WAIT_V(n) asm volatile("s_waitcnt vmcnt(" #n ")" ::: "memory")
#define PG8_WAIT_L(n) asm volatile("s_waitcnt lgkmcnt(" #n ")" ::: "memory")
#define PG8_BAR __builtin_amdgcn_s_barrier()
#define PG8_SCHED __builtin_amdgcn_sched_barrier(0)
    Unit cur, nxt; int ui = 0;
    if (!S.next(0, cur)) return;
    f32x4 acc[2][2][4][2];
#pragma unroll
    for (int a = 0; a < 2; ++a)
#pragma unroll
        for (int b = 0; b < 2; ++b)
#pragma unroll
            for (int m = 0; m < 4; ++m)
#pragma unroll
                for (int n = 0; n < 2; ++n) acc[a][b][m][n] = (f32x4){0.f, 0.f, 0.f, 0.f};
    bf16x8 At[4][2], B0[2][2], B1[2][2];
    unsigned OA[2], ON[2];
    const char* cA; const char* cB;
#define PG8_SETUP(u, P, O) do { \
        if constexpr (GATHER) { P = (const char*)g.A; _Pragma("unroll") for (int _h = 0; _h < 2; ++_h) { unsigned _pk = 0u; _Pragma("unroll") for (int _i = 0; _i < 2; ++_i) { \
            int _R, _C; stage_rc(tid * 16 + _i * 8192, _R, _C); const int _r = _h * HALF + _R; const unsigned _t = (_r < (u).cnt) ? (unsigned)((u).gather[_r] >> 1) : 0u; _pk |= _t << (16 * _i); } O[_h] = _pk; } } \
        else { P = (const char*)g.A + (GA ? (size_t)(u).arow0 * 32 : (size_t)(u).arow0 * g.lda * 2); } } while (0)
    PG8_SETUP(cur, cA, OA);
    cB = (const char*)g.Bt + (size_t)cur.brow0 * g.ldb * 2;
    PG8_STAGE(PG8_SB(0, 0), cB, voffB); PG8_STAGE(PG8_SB(0, 1), cB + hstepB, voffB); PG8_STAGE_A(PG8_SA(0, 0), cA, OA, 0, 0); PG8_STAGE_A(PG8_SA(0, 1), cA, OA, 1, 0);
    if (wr == 1) PG8_BAR;
    PG8_WAIT_V(2); PG8_BAR;
    PG8_STAGE(PG8_SB(1, 0), cB + kstep, voffB); PG8_STAGE_A(PG8_SA(1, 0), cA, OA, 0, kstepA); PG8_STAGE(PG8_SB(1, 1), cB + hstepB + kstep, voffB);
    PG8_WAIT_V(6); PG8_BAR;
    for (;;) {
        STAMP_T0(SID * 10 + 1, _tu);
        const bool has_next = S.next(ui + 1, nxt);
        const char* nA = cA; const char* nB = cB;
        if constexpr (GATHER) { ON[0] = OA[0]; ON[1] = OA[1]; }
        if (has_next) { PG8_SETUP(nxt, nA, ON); nB = (const char*)g.Bt + (size_t)nxt.brow0 * g.ldb * 2; }
        STAMP_T0(SID * 10 + 2, _tk);
#ifdef STAMP
        unsigned _d5 = 0u;
#endif
        for (int t = 0; t < nt; t += 2) {
            const bool last = (t == nt - 2);
            STAMP_T0(SID * 10 + 5, _ti0); STAMP_T0(SID * 10 + 6, _ti1);
            const size_t k1 = (size_t)(t + 1) * kstepA;
            const char* a2 = last ? nA : cA; const char* b2 = last ? nB : cB + (size_t)(t + 2) * kstep;
            const size_t k2 = last ? 0 : (size_t)(t + 2) * kstepA, k3 = k2 + kstepA;
            const char* b3 = b2 + kstep;
            unsigned O2[2];
            if constexpr (GATHER) { O2[0] = last ? ON[0] : OA[0]; O2[1] = last ? ON[1] : OA[1]; }
            PG8_LDB(B0, 0, 0); PG8_LDB(B1, 0, 1); PG8_SCHED; PG8_LDA(At, 0, 0); PG8_STAGE_A(PG8_SA(1, 1), cA, OA, 1, k1);
            PG8_WAIT_V(8); PG8_WAIT_L(0); PG8_BAR; PG8_MMA(0, 0, At, B0); PG8_MMA(0, 1, At, B1); PG8_BAR; PG8_SCHED;
            PG8_LDA(At, 0, 1); PG8_STAGE(PG8_SB(0, 0), b2, voffB); PG8_STAGE(PG8_SB(0, 1), b2 + hstepB, voffB); PG8_STAGE_A(PG8_SA(0, 0), a2, O2, 0, k2);
            PG8_WAIT_V(8); PG8_WAIT_L(0); PG8_BAR; PG8_MMA(1, 0, At, B0); PG8_MMA(1, 1, At, B1); PG8_BAR; PG8_SCHED;
            PG8_LDB(B0, 1, 0); PG8_LDB(B1, 1, 1); PG8_SCHED; PG8_LDA(At, 1, 0); PG8_STAGE_A(PG8_SA(0, 1), a2, O2, 1, k2);
            PG8_WAIT_V(8); PG8_WAIT_L(0); PG8_BAR; PG8_MMA(0, 0, At, B0); PG8_MMA(0, 1, At, B1); PG8_BAR; PG8_SCHED;
            PG8_LDA(At, 1, 1); PG8_STAGE(PG8_SB(1, 0), b3, voffB); PG8_STAGE(PG8_SB(1, 1), b3 + hstepB, voffB); PG8_STAGE_A(PG8_SA(1, 0), a2, O2, 0, k3);
            PG8_WAIT_V(8); PG8_WAIT_L(0); PG8_BAR; PG8_MMA(1, 0, At, B0); PG8_MMA(1, 1, At, B1); PG8_BAR; PG8_SCHED;
#ifdef STAMP
            if (STAMP == SID * 10 + 5 && t == 0) _d5 = (unsigned)__builtin_amdgcn_s_memtime() - _ti0;
            if (STAMP == SID * 10 + 6 && last) _d5 = (unsigned)__builtin_amdgcn_s_memtime() - _ti1;
#endif
        }
        STAMP_END_PUB(SID * 10 + 2, _tk, sctl, 37, (float)(STAMP_SCALE));
#ifdef STAMP
        if ((STAMP == SID * 10 + 5 || STAMP == SID * 10 + 6) && blockIdx.x == 37 && threadIdx.x == 0) __hip_atomic_store((unsigned*)(sctl + CW_DIAG), __float_as_uint((float)_d5 * (float)(STAMP_SCALE)), RLX_AGENT);
#endif
        STAMP_T0(SID * 10 + 3, _ta);
        if (wr == 0) PG8_BAR;
        STAMP_END_PUB(SID * 10 + 3, _ta, sctl, 37, (float)(STAMP_SCALE)); STAMP_T0(SID * 10 + 4, _tb);
        E(acc, cur, wr, wc, fr, fq);
        asm volatile("" ::: "memory"); STAMP_END_PUB(SID * 10 + 4, _tb, sctl, 37, (float)(STAMP_SCALE)); STAMP_END_PUB(SID * 10 + 1, _tu, sctl, 37, (float)(STAMP_SCALE));
        if (!has_next) break;
#pragma unroll
        for (int a = 0; a < 2; ++a)
#pragma unroll
            for (int b = 0; b < 2; ++b)
#pragma unroll
                for (int m = 0; m < 4; ++m)
#pragma unroll
                    for (int n = 0; n < 2; ++n) acc[a][b][m][n] = (f32x4){0.f, 0.f, 0.f, 0.f};
        cur = nxt; cA = nA; cB = nB; ++ui;
        if constexpr (GATHER) { OA[0] = ON[0]; OA[1] = ON[1]; }
        if (wr == 1) PG8_BAR;
    }
    PG8_WAIT_V(0);
    PG8_BAR;
#undef PG8_SA
#undef PG8_SB
#undef PG8_STAGE
#undef PG8_STAGE_A
#undef PG8_LDA
#undef PG8_LDB
#undef PG8_MMA
#undef PG8_WAIT_V
#undef PG8_WAIT_L
#undef PG8_BAR
#undef PG8_SCHED
#undef PG8_SETUP
}

struct EpiStoreBf16 {
    static constexpr bool PERM = true;
    bf16* O; int ldc;
    __device__ __forceinline__ void operator()(const f32x4 (&acc)[2][2][4][2], const Unit& u, int wr, int wc, int fr, int fq) const {
        const int row0 = u.pm * BM + wr * 64 + fr, col0 = u.pn * BM + wc * 32 + 8 * fq;
#pragma unroll
        for (int ai = 0; ai < 2; ++ai)
#pragma unroll
            for (int m = 0; m < 4; ++m) { bf16* rowp = O + (size_t)(row0 + ai * HALF + m * 16) * ldc + col0;
#pragma unroll
                for (int bj = 0; bj < 2; ++bj) { const f32x4 v0 = acc[ai][bj][m][0], v1 = acc[ai][bj][m][1];
                    v4u w; w.x = cvt_pk_bf16(v0[0], v0[1]); w.y = cvt_pk_bf16(v0[2], v0[3]); w.z = cvt_pk_bf16(v1[0], v1[1]); w.w = cvt_pk_bf16(v1[2], v1[3]);
                    __builtin_nontemporal_store(w, (v4u*)(rowp + bj * HALF)); } }
    }
};

struct EpiPre {
    static constexpr bool PERM = true;
    const bf16* base; bf16* out; int ldc;
    __device__ __forceinline__ void operator()(const f32x4 (&acc)[2][2][4][2], const Unit& u, int wr, int wc, int fr, int fq) const {
        const int row0 = u.pm * BM + wr * 64 + fr, col0 = u.pn * BM + wc * 32 + 8 * fq;
#pragma unroll
        for (int ai = 0; ai < 2; ++ai)
#pragma unroll
            for (int m = 0; m < 4; ++m) { const size_t off = (size_t)(row0 + ai * HALF + m * 16) * ldc + col0;
#pragma unroll
                for (int bj = 0; bj < 2; ++bj) { const v4u bs = *(const v4u*)(base + off + bj * HALF); const f32x4 v0 = acc[ai][bj][m][0], v1 = acc[ai][bj][m][1]; v4u w;
                    w.x = cvt_pk_bf16(fmaf(__uint_as_float(bs.x << 16), ALPHA, v0[0]), fmaf(__uint_as_float(bs.x & 0xffff0000u), ALPHA, v0[1]));
                    w.y = cvt_pk_bf16(fmaf(__uint_as_float(bs.y << 16), ALPHA, v0[2]), fmaf(__uint_as_float(bs.y & 0xffff0000u), ALPHA, v0[3]));
                    w.z = cvt_pk_bf16(fmaf(__uint_as_float(bs.z << 16), ALPHA, v1[0]), fmaf(__uint_as_float(bs.z & 0xffff0000u), ALPHA, v1[1]));
                    w.w = cvt_pk_bf16(fmaf(__uint_as_float(bs.w << 16), ALPHA, v1[2]), fmaf(__uint_as_float(bs.w & 0xffff0000u), ALPHA, v1[3]));
                    *(v4u*)(out + off + bj * HALF) = w; } }
    }
};
struct EpiS5U {
    static constexpr bool PERM = true;
    bf16* UA;
    __device__ __forceinline__ void operator()(const f32x4 (&acc)[2][2][4][2], const Unit& u, int wr, int wc, int fr, int fq) const {
#pragma unroll
        for (int ai = 0; ai < 2; ++ai)
#pragma unroll
            for (int m = 0; m < 4; ++m) { const int tok = u.pm * BM + ai * HALF + wr * 64 + m * 16 + fr; const int b = tok >> 11, l = tok & 2047, ch = l >> 4, tl = l & 15;
#pragma unroll
                for (int bj = 0; bj < 2; ++bj) { const int c0 = u.pn * BM + bj * HALF + wc * 32 + 8 * fq; const int g = c0 >> 4, cc = c0 & 15;
                    const f32x4 v0 = acc[ai][bj][m][0], v1 = acc[ai][bj][m][1];
                    v4u w; w.x = cvt_pk_bf16(v0[0], v0[1]); w.y = cvt_pk_bf16(v0[2], v0[3]); w.z = cvt_pk_bf16(v1[0], v1[1]); w.w = cvt_pk_bf16(v1[2], v1[3]);
                    *(v4u*)(UA + ((size_t)(g * 2048 + b * 128 + ch)) * 384 + tl * 16 + cc) = w; } }
    }
};
struct EpiS5Z {
    static constexpr bool PERM = false;
    float* Z;
    __device__ __forceinline__ void operator()(const f32x4 (&acc)[2][2][4][2], const Unit& u, int wr, int wc, int fr, int fq) const {
#pragma unroll
        for (int ai = 0; ai < 2; ++ai)
#pragma unroll
            for (int m = 0; m < 4; ++m) { float* rowp = Z + (size_t)(u.arow0 + ai * HALF + wr * 64 + m * 16 + fr) * 128 + wc * 32 + 4 * fq;
#pragma unroll
                for (int n = 0; n < 2; ++n) *(f32x4*)(rowp + n * 16) = acc[ai][0][m][n]; }
    }
};
__device__ __forceinline__ float gelu_tanh(float y) { const float z = 0.7978845608028654f * (y + 0.044715f * y * y * y); return y * __builtin_amdgcn_rcpf(1.f + __expf(-2.f * z)); }
struct EpiS5Y {
    static constexpr bool PERM = true;
    bf16* G;
    __device__ __forceinline__ void operator()(const f32x4 (&acc)[2][2][4][2], const Unit& u, int wr, int wc, int fr, int fq) const {
        const int g = u.aux;
#pragma unroll
        for (int ai = 0; ai < 2; ++ai)
#pragma unroll
            for (int m = 0; m < 4; ++m) { const int row = u.pm * BM + ai * HALF + wr * 64 + m * 16 + fr; const int b = row >> 7, ch = row & 127;
#pragma unroll
                for (int bj = 0; bj < 2; ++bj) { const int c0 = bj * HALF + wc * 32 + 8 * fq; const int tl = c0 >> 4, cc = c0 & 15;
                    const f32x4 v0 = acc[ai][bj][m][0], v1 = acc[ai][bj][m][1];
                    v4u w; w.x = cvt_pk_bf16(gelu_tanh(v0[0]), gelu_tanh(v0[1])); w.y = cvt_pk_bf16(gelu_tanh(v0[2]), gelu_tanh(v0[3]));
                    w.z = cvt_pk_bf16(gelu_tanh(v1[0]), gelu_tanh(v1[1])); w.w = cvt_pk_bf16(gelu_tanh(v1[2]), gelu_tanh(v1[3]));
                    *(v4u*)(G + ((size_t)g * NTOK + (b * 2048 + ch * 16 + tl)) * 16 + cc) = w; } }
    }
};
template <int ACT> struct EpiGated {
    static constexpr bool PERM = true;
    bf16* O; int ldc;
    __device__ __forceinline__ void operator()(const f32x4 (&acc)[2][2][4][2], const Unit& u, int wr, int wc, int fr, int fq) const {
        const int col0 = u.pn * HALF + wc * 32 + 8 * fq;
#pragma unroll
        for (int ai = 0; ai < 2; ++ai)
#pragma unroll
            for (int m = 0; m < 4; ++m) { const int row = u.pm * BM + ai * HALF + wr * 64 + m * 16 + fr; float r[8];
#pragma unroll
                for (int n = 0; n < 2; ++n)
#pragma unroll
                    for (int j = 0; j < 4; ++j) { const float v = acc[ai][0][m][n][j], gt = acc[ai][1][m][n][j];
                        r[n * 4 + j] = ACT == 0 ? v * __builtin_amdgcn_rcpf(1.f + __expf(-gt)) : v * __builtin_amdgcn_rcpf(1.f + __expf(-v)) * gt; }
                v4u w; w.x = cvt_pk_bf16(r[0], r[1]); w.y = cvt_pk_bf16(r[2], r[3]); w.z = cvt_pk_bf16(r[4], r[5]); w.w = cvt_pk_bf16(r[6], r[7]);
                *(v4u*)(O + (size_t)row * ldc + col0) = w; }
    }
};
struct S5Order {
    int G, c;
    __device__ bool next(int i, Unit& u) const { const int L = i * G + c; if (L >= 512) return false; const int g = L >> 3, rt = L & 7;
        u.arow0 = g * 2048 + rt * BM; u.brow0 = g * BM; u.pm = rt; u.pn = 0; u.aux = g; u.cnt = BM; u.gather = nullptr; return true; }
};

struct MoeOrder {
    int cnt[NEXP]; const int* list; int G, c;
    __device__ bool next(int i, Unit& u) const { const int L = i * G + c, rt = L >> 2, pn = L & 3; int acc = 0, se = -1, loc = 0, sc = 0;
#pragma unroll
        for (int e = 0; e < NEXP; ++e) { const int ce = cnt[e], nt = (ce + 255) >> 8; if (rt >= acc && rt < acc + nt) { se = e; loc = rt - acc; sc = ce; } acc += nt; }
        if (se < 0) return false;
        u.arow0 = rt * BM; u.brow0 = se * 1024 + pn * BM; u.pm = rt; u.pn = pn; u.aux = se; const int rem = sc - loc * BM; u.cnt = rem < BM ? rem : BM; u.gather = list + se * NTOK + loc * BM; return true; }
};
struct EpiMoeDown {
    static constexpr bool PERM = true;
    const float* tokw; bf16* CB;
    __device__ __forceinline__ void operator()(const f32x4 (&acc)[2][2][4][2], const Unit& u, int wr, int wc, int fr, int fq) const {
        const int col0 = u.pn * BM + wc * 32 + 8 * fq;
#pragma unroll
        for (int ai = 0; ai < 2; ++ai)
#pragma unroll
            for (int m = 0; m < 4; ++m) { const int r = ai * HALF + wr * 64 + m * 16 + fr;
                if (r < u.cnt) { const int ent = u.gather[r]; const int tok = ent >> 1, k = ent & 1; const float w = tokw[ent];
                    bf16* rowp = CB + ((size_t)k * NTOK + tok) * D + col0;
#pragma unroll
                    for (int bj = 0; bj < 2; ++bj) { const f32x4 v0 = acc[ai][bj][m][0] * w, v1 = acc[ai][bj][m][1] * w;
                        v4u o; o.x = cvt_pk_bf16(v0[0], v0[1]); o.y = cvt_pk_bf16(v0[2], v0[3]); o.z = cvt_pk_bf16(v1[0], v1[1]); o.w = cvt_pk_bf16(v1[2], v1[3]);
                        *(v4u*)(rowp + bj * HALF) = o; } } }
    }
};
}
#define XB_TMO      128
#define XB_XCNT(j)  (256  + 64 * (j))
#define XB_XSUB(j)  (1280 + 64 * (j))
#define XB_XGEN(j)  (2304 + 64 * (j))
#define XB_TOP      3328
#define XB_TOPGEN   3392
#define XCD_BAR_WORDS 3456
#define XB_SPIN_CAP (1u << 18)
__device__ __forceinline__ unsigned xb_ld(unsigned* p)              { return __hip_atomic_load(p, __ATOMIC_RELAXED, __HIP_MEMORY_SCOPE_AGENT); }
__device__ __forceinline__ unsigned xb_add(unsigned* p, unsigned v) { return __hip_atomic_fetch_add(p, v, __ATOMIC_RELAXED, __HIP_MEMORY_SCOPE_AGENT); }
__device__ __forceinline__ unsigned xb_xcc_id() { return (unsigned)__builtin_amdgcn_s_getreg((3 << 11) | 20) & 0xFu; }
#define XB_SPIN(cond, bar) do { unsigned _sp = 0; while (cond) { __builtin_amdgcn_s_sleep(1); \
    if ((++_sp & 255u) == 0u) { if (xb_ld(&(bar)[XB_TMO])) break; if (_sp > XB_SPIN_CAP) { atomicAdd(&(bar)[XB_TMO], 1u); break; } } } } while (0)
struct XcdBarrier { unsigned* bar; unsigned x; volatile LAS unsigned* st; };
__device__ __forceinline__ XcdBarrier xcd_barrier_post(unsigned* bar, volatile LAS unsigned* st) {
    XcdBarrier b; b.bar = bar; b.x = xb_xcc_id(); b.st = st;
    if (threadIdx.x == 0) (void)xb_add(&bar[XB_XCNT(b.x)], 1u);
    return b;
}
__device__ __forceinline__ void xcd_barrier_complete(unsigned* bar, unsigned x, unsigned& nloc, unsigned& nx) {
    const unsigned G = gridDim.x * gridDim.y * gridDim.z;
    unsigned sum, cnt, mine, sp = 0u;
    for (;;) {
        sum = 0u; cnt = 0u; mine = 0u;
#pragma unroll
        for (unsigned j = 0; j < 16; ++j) { const unsigned c = xb_ld(&bar[XB_XCNT(j)]); sum += c; cnt += (c > 0u) ? 1u : 0u; mine = (j == x) ? c : mine; }
        if (sum == G) break;
        __builtin_amdgcn_s_sleep(1);
        if ((++sp & 255u) == 0u) { if (xb_ld(&bar[XB_TMO])) break; if (sp > XB_SPIN_CAP) { atomicAdd(&bar[XB_TMO], 1u); break; } }
    }
    nloc = mine > 0u ? mine : 1u; nx = cnt > 0u ? cnt : 1u;
}
__device__ __forceinline__ void xcd_barrier(const XcdBarrier& b) {
    asm volatile("s_waitcnt vmcnt(0)" ::: "memory");
    __syncthreads();
    if (threadIdx.x == 0) {
        unsigned* bar = b.bar;
        __builtin_amdgcn_s_waitcnt(0);
        unsigned nloc = b.st[0], nx = b.st[1];
        if (nloc == 0u) { xcd_barrier_complete(bar, b.x, nloc, nx); b.st[0] = nloc; b.st[1] = nx; }
        const unsigned old = xb_add(&bar[XB_XSUB(b.x)], 1u);
        const unsigned gen = old / nloc;
        if (old + 1u == (gen + 1u) * nloc) {
            __builtin_amdgcn_fence(__ATOMIC_RELEASE, "agent");
            asm volatile("s_waitcnt vmcnt(0)" ::: "memory");
            const unsigned og = xb_add(&bar[XB_TOP], 1u);
            const unsigned tg = og / nx;
            if (og + 1u == (tg + 1u) * nx) xb_add(&bar[XB_TOPGEN], 1u);
            else XB_SPIN(xb_ld(&bar[XB_TOPGEN]) == tg, bar);
            __builtin_amdgcn_fence(__ATOMIC_ACQUIRE, "agent");
            xb_add(&bar[XB_XGEN(b.x)], 1u);
            asm volatile("s_waitcnt vmcnt(0)" ::: "memory");
        } else {
            XB_SPIN(xb_ld(&bar[XB_XGEN(b.x)]) == gen, bar);
            __builtin_amdgcn_fence(__ATOMIC_ACQUIRE, "agent");
            asm volatile("s_waitcnt vmcnt(0)" ::: "memory");
        }
    }
    __syncthreads();
}

constexpr int NWAVES = 8;
constexpr size_t MiB = 1u << 20;
constexpr size_t WS_CTL = 0, CTL_ZERO_BYTES = 1 * MiB;
constexpr size_t WS_WIN = 2 * MiB, WS_WOUT = 8 * MiB, WS_S5IN = 10 * MiB, WS_GLU = 12 * MiB, WS_S5OUT = 16 * MiB, WS_PG = 18 * MiB, WS_MQ = 26 * MiB;
constexpr size_t WS_WGU = 40 * MiB, WS_WD = 104 * MiB;
constexpr size_t WS_XB = 136 * MiB, WS_H = 200 * MiB, WS_MASK = 376 * MiB, WS_O = 384 * MiB, WS_F1 = 448 * MiB, WS_END = 512 * MiB;
constexpr int CW_TMO = 0, CW_CODE = 1, CW_CNT = 2048  , CW_BAR = 4096;
constexpr size_t WS_TOKPOS = 768 * 1024  ;
constexpr size_t WS_TOKW = 512 * 1024  , WS_LIST = 38 * MiB  ;
constexpr size_t WS_HMID = 200 * MiB  , WS_CB = 268 * MiB  ;
constexpr int RING_OFF = 0, RING_BYTES = 131072, LDS_BYTES = 147456, LDSCTL_OFF = LDS_BYTES - 512, MISC_OFF = LDSCTL_OFF + 320;

struct Frame {
    LAS unsigned char* lds; volatile LAS unsigned* MISC; gu32* ctl;
    int tid, lane, wave, vcu, G;
};
struct Args { const float* in[30]; float* out; unsigned char* ws; int ph_lo, ph_hi, li, pad; };

__device__ __forceinline__ void tr_item(const float* __restrict__ W, int ldw, bf16* WT, int ldt, int k0, int c0, int nc, int r0, LAS float* scr, int lane) {
    f32x4 v[8];
#pragma unroll
    for (int i = 0; i < 8; ++i) { const int idx = lane + 64 * i, kk = idx >> 3, c4 = (idx & 7) * 4; v[i] = (c4 < nc) ? *(const GAS f32x4*)(W + (size_t)(k0 + kk) * ldw + c0 + c4) : (f32x4){0.f, 0.f, 0.f, 0.f}; }
#pragma unroll
    for (int i = 0; i < 8; ++i) { const int idx = lane + 64 * i, kk = idx >> 3, c4 = (idx & 7) * 4; LAS float* s = scr + kk * 33 + c4; s[0] = v[i].x; s[1] = v[i].y; s[2] = v[i].z; s[3] = v[i].w; }
    LDS_WAIT(); asm volatile("" ::: "memory");
    const int c = lane & 7;
#pragma unroll
    for (int j = 0; j < 4; ++j) { const int n = (lane >> 3) + 8 * j; const LAS float* s = scr + (8 * c) * 33 + n;
        v4u o; o.x = pk2(s[0 * 33], s[1 * 33]); o.y = pk2(s[2 * 33], s[3 * 33]); o.z = pk2(s[4 * 33], s[5 * 33]); o.w = pk2(s[6 * 33], s[7 * 33]);
        if (n < nc) *(GAS v4u*)(WT + (size_t)(r0 + n) * ldt + k0 + 8 * c) = o; }
    LDS_WAIT(); asm volatile("" ::: "memory");
}

struct TrDesc { const float* W; int ldw; bf16* WT; int ldt, k0, c0, nc, r0; };
__device__ __forceinline__ void tr_load(const TrDesc& d, f32x4 (&v)[8], int lane) {
#pragma unroll
    for (int i = 0; i < 8; ++i) { const int idx = lane + 64 * i, kk = idx >> 3, c4 = (idx & 7) * 4; v[i] = (c4 < d.nc) ? __builtin_nontemporal_load((const GAS f32x4*)(d.W + (size_t)(d.k0 + kk) * d.ldw + d.c0 + c4)) : (f32x4){0.f, 0.f, 0.f, 0.f}; }
}
__device__ __forceinline__ void tr_store(const TrDesc& d, const f32x4 (&v)[8], LAS float* scr, int lane) {
#pragma unroll
    for (int i = 0; i < 8; ++i) { const int idx = lane + 64 * i, kk = idx >> 3, c4 = (idx & 7) * 4; LAS float* s = scr + kk * 33 + c4; s[0] = v[i].x; s[1] = v[i].y; s[2] = v[i].z; s[3] = v[i].w; }
    LDS_WAIT(); asm volatile("" ::: "memory");
    const int c = lane & 7;
#pragma unroll
    for (int j = 0; j < 4; ++j) { const int n = (lane >> 3) + 8 * j; const LAS float* s = scr + (8 * c) * 33 + n;
        v4u o; o.x = pk2(s[0 * 33], s[1 * 33]); o.y = pk2(s[2 * 33], s[3 * 33]); o.z = pk2(s[4 * 33], s[5 * 33]); o.w = pk2(s[6 * 33], s[7 * 33]);
        if (n < d.nc) *(GAS v4u*)(d.WT + (size_t)(d.r0 + n) * d.ldt + d.k0 + 8 * c) = o; }
    LDS_WAIT(); asm volatile("" ::: "memory");
}
__device__ __forceinline__ int tr_seg_items(int K, int ncols) { return (K / 64) * ((ncols + 31) / 32); }
__device__ __forceinline__ void tr_seg(const float* W, int ldw, int K, int c0, int ncols, bf16* WT, int ldt, int r0, int it, LAS float* scr, int lane) {
    const int nblk = (ncols + 31) / 32, kb = it / nblk, nb = it % nblk; const int rem = ncols - nb * 32;
    tr_item(W, ldw, WT, ldt, kb * 64, c0 + nb * 32, rem < 32 ? rem : 32, r0 + nb * 32, scr, lane);
}
constexpr size_t WS_UPD = WS_F1, WS_DEC = WS_LIST;
constexpr size_t OUT_SPREV = 16 * MiB, OUT_OI = 48 * MiB;
constexpr int GP = 72;
#define MFMA32(a, b, c) __builtin_amdgcn_mfma_f32_32x32x16_bf16((a), (b), (c), 0, 0, 0)
__device__ __forceinline__ int crow(int reg, int h) { return (reg & 3) + 8 * (reg >> 2) + 4 * h; }
__device__ __forceinline__ f32x16 mma_tile64(const LAS bf16* A, const LAS bf16* Bt, int lane) {
    const int r = lane & 31, h = lane >> 5; f32x16 acc;
#pragma unroll
    for (int i = 0; i < 16; ++i) acc[i] = 0.f;
#pragma unroll
    for (int kk = 0; kk < 4; ++kk) { const bf16x8 a = *(const LAS bf16x8*)(A + r * GP + kk * 16 + 8 * h), b = *(const LAS bf16x8*)(Bt + r * GP + kk * 16 + 8 * h); acc = MFMA32(a, b, acc); }
    return acc;
}
constexpr int GLA1_HALF = 71168;
__device__ __forceinline__ void gla1_pair(Frame& F, const Args& a, int unit0) {
    const int hw = F.wave >> 2, wl = F.wave & 3, lt = F.tid & 255, lane = F.lane, unit = unit0 + hw;
    const int b = unit >> 7, n = (unit >> 2) & 31, h = unit & 3;
    const size_t tok0 = (size_t)b * SEQ + n * 64;
    const bf16* H = (const bf16*)(a.ws + WS_H);
    LAS unsigned char* L = F.lds + RING_OFF + hw * GLA1_HALF;
    LAS float* CUM = (LAS float*)L;
    LAS bf16* P = (LAS bf16*)L;
    LAS bf16* QD = (LAS bf16*)(L + 16640);
    LAS bf16* KI = (LAS bf16*)(L + 25856);
    LAS bf16* KET = (LAS bf16*)(L + 35072);
    LAS bf16* VT = (LAS bf16*)(L + 44288);
    LAS float* GW = (LAS float*)(L + 62720);
    LAS float* GB = (LAS float*)(L + 66816);
    LAS float* BG = (LAS float*)(L + 67072);
    const float* gw2 = a.in[3]; const float* gb = a.in[4];
#pragma unroll
    for (int k = 0; k < 4; ++k) { const int i = lt + 256 * k; GW[i] = gw2[(i >> 6) * 256 + h * 64 + (i & 63)]; BG[i] = bf2f(H[(tok0 + (i >> 4)) * HP + HC_BG + (i & 15)]); }
    if (lt < 64) GB[lt] = gb[h * 64 + lt];
    v4u qv[2], kv[2], vv[4];
#pragma unroll
    for (int k = 0; k < 2; ++k) { const int idx = lt + 256 * k, t = idx >> 3, d8 = (idx & 7) * 8; qv[k] = *(const GAS v4u*)(H + (tok0 + t) * HP + HC_BQ + h * 64 + d8); kv[k] = *(const GAS v4u*)(H + (tok0 + t) * HP + HC_BK + h * 64 + d8); }
#pragma unroll
    for (int k = 0; k < 4; ++k) { const int idx = lt + 256 * k, j = idx & 63, e8 = (idx >> 6) * 8; vv[k] = *(const GAS v4u*)(H + (tok0 + j) * HP + HC_BV + h * 128 + e8); }
    __syncthreads();
#pragma unroll 4
    for (int k = 0; k < 16; ++k) { const int idx = lt + 256 * k, t = idx >> 6, d = idx & 63; float z = GB[d];
#pragma unroll
        for (int r = 0; r < 16; ++r) z = fmaf(BG[t * 16 + r], GW[r * 64 + d], z);
        const float ls = -(fmaxf(-z, 0.f) + __logf(1.f + __expf(-fabsf(z)))); CUM[t * 65 + d] = ls * (1.f / 16.f); }
    __syncthreads();
    LAS float* OFF = GW;
    { const int seg = lt >> 6, d = lt & 63; float run = 0.f;
#pragma unroll
      for (int k = 0; k < 16; ++k) { const int t = 16 * seg + k; run += CUM[t * 65 + d]; CUM[t * 65 + d] = run; } }
    __syncthreads();
    { const int seg = lt >> 6, d = lt & 63; float off = 0.f;
#pragma unroll
      for (int s2 = 0; s2 < 3; ++s2) if (s2 < seg) off += CUM[(16 * s2 + 15) * 65 + d];
      OFF[seg * 64 + d] = off; }
    __syncthreads();
    bf16* QG = (bf16*)a.out;
#pragma unroll
    for (int k = 0; k < 2; ++k) { const int idx = lt + 256 * k, t = idx >> 3, d8 = (idx & 7) * 8; unsigned qo[4], ko[4]; const unsigned qw[4] = {qv[k].x, qv[k].y, qv[k].z, qv[k].w}, kw[4] = {kv[k].x, kv[k].y, kv[k].z, kv[k].w};
#pragma unroll
        for (int p2 = 0; p2 < 4; ++p2) { float qd[2], ki[2];
#pragma unroll
            for (int s = 0; s < 2; ++s) { const int d = d8 + 2 * p2 + s; const float c = CUM[t * 65 + d] + OFF[(t >> 4) * 64 + d], last = CUM[63 * 65 + d] + OFF[3 * 64 + d];
                const float q = (s ? __uint_as_float(qw[p2] & 0xffff0000u) : __uint_as_float(qw[p2] << 16)) * 0.125f, kk = s ? __uint_as_float(kw[p2] & 0xffff0000u) : __uint_as_float(kw[p2] << 16);
                qd[s] = q * __expf(c); ki[s] = kk * __expf(-c); KET[d * GP + t] = (bf16)f2bf(kk * __expf(last - c)); }
            qo[p2] = cvt2bf(qd[0], qd[1]); ko[p2] = cvt2bf(ki[0], ki[1]); }
        const v4u qq = (v4u){qo[0], qo[1], qo[2], qo[3]}; *(LAS v4u*)(QD + t * GP + d8) = qq; *(GAS v4u*)(QG + (tok0 + t) * 256 + h * 64 + d8) = qq; *(LAS v4u*)(KI + t * GP + d8) = (v4u){ko[0], ko[1], ko[2], ko[3]}; }
    if (lt < 64) ((float*)(a.ws + WS_DEC))[unit * 64 + lt] = __expf(CUM[63 * 65 + lt] + OFF[3 * 64 + lt]);
#pragma unroll
    for (int k = 0; k < 4; ++k) { const int idx = lt + 256 * k, j = idx & 63, e8 = (idx >> 6) * 8; const v4u v = vv[k];
        VT[(e8 + 0) * GP + j] = (bf16)(v.x & 0xffff); VT[(e8 + 1) * GP + j] = (bf16)(v.x >> 16); VT[(e8 + 2) * GP + j] = (bf16)(v.y & 0xffff); VT[(e8 + 3) * GP + j] = (bf16)(v.y >> 16);
        VT[(e8 + 4) * GP + j] = (bf16)(v.z & 0xffff); VT[(e8 + 5) * GP + j] = (bf16)(v.z >> 16); VT[(e8 + 6) * GP + j] = (bf16)(v.w & 0xffff); VT[(e8 + 7) * GP + j] = (bf16)(v.w >> 16); }
    __syncthreads();
    { const int ti = wl >> 1, tj = wl & 1, nn = lane & 31, hh = lane >> 5;
        if (tj <= ti) { const f32x16 c = mma_tile64(QD + 32 * ti * GP, KI + 32 * tj * GP, lane);
#pragma unroll
            for (int i = 0; i < 16; ++i) { const int qi = 32 * ti + crow(i, hh), kj = 32 * tj + nn; P[qi * GP + kj] = (bf16)f2bf(kj <= qi ? c[i] : 0.f); } }
        else {
#pragma unroll
            for (int i = 0; i < 16; ++i) P[(32 * ti + crow(i, hh)) * GP + 32 * tj + nn] = (bf16)0; } }
    __syncthreads();
    bf16* oi = (bf16*)((unsigned char*)a.out + OUT_OI); bf16* up = (bf16*)(a.ws + WS_UPD) + (size_t)unit * 8192;
#pragma unroll
    for (int k = 0; k < 2; ++k) { const int tile = wl * 2 + k, nn = lane & 31, hh = lane >> 5;
      { const int ti = tile >> 2, te = tile & 3;
        const f32x16 c = mma_tile64(P + 32 * ti * GP, VT + 32 * te * GP, lane);
#pragma unroll
        for (int i = 0; i < 16; ++i) oi[(tok0 + 32 * ti + crow(i, hh)) * 512 + h * 128 + 32 * te + nn] = (bf16)f2bf(c[i]); }
      { const int te = tile >> 1, td = tile & 1;
        const f32x16 c = mma_tile64(VT + 32 * te * GP, KET + 32 * td * GP, lane);
#pragma unroll
        for (int i = 0; i < 16; ++i) up[(32 * te + crow(i, hh)) * 64 + 32 * td + nn] = (bf16)f2bf(c[i]); } }
    __syncthreads();
}
__device__ __forceinline__ void gla2_scan(Frame& F, const Args& a) {
    const bf16* UPD = (const bf16*)(a.ws + WS_UPD); const float* DEC = (const float*)(a.ws + WS_DEC); bf16* SP = (bf16*)((unsigned char*)a.out + OUT_SPREV);
    for (int x = F.vcu * (NWAVES * 64) + F.tid; x < BATCH * 4 * 128 * 16; x += F.G * NWAVES * 64) {
        const int d4 = (x & 15) * 4, e = (x >> 4) & 127, bh = x >> 11, b = bh >> 2, h = bh & 3; f32x4 S = (f32x4){0.f, 0.f, 0.f, 0.f};
        for (int n0 = 0; n0 < 32; n0 += 8) { v2u u[8]; f32x4 dc[8];
#pragma unroll
            for (int k = 0; k < 8; ++k) { const int unit = b * 128 + (n0 + k) * 4 + h; u[k] = *(const GAS v2u*)(UPD + (size_t)unit * 8192 + e * 64 + d4); dc[k] = *(const GAS f32x4*)(DEC + unit * 64 + d4); }
#pragma unroll
            for (int k = 0; k < 8; ++k) { const int unit = b * 128 + (n0 + k) * 4 + h; v2u o; o.x = pk2(S.x, S.y); o.y = pk2(S.z, S.w); *(GAS v2u*)(SP + (size_t)unit * 8192 + e * 64 + d4) = o; const f32x4 uf = (f32x4){__uint_as_float(u[k].x << 16), __uint_as_float(u[k].x & 0xffff0000u), __uint_as_float(u[k].y << 16), __uint_as_float(u[k].y & 0xffff0000u)}; S = dc[k] * S + uf; } } }
}
constexpr int GLA3_HALF = 61440;
__device__ __forceinline__ void gla3_pair(Frame& F, const Args& a, int unit0) {
    const int hw = F.wave >> 2, wl = F.wave & 3, lt = F.tid & 255, lane = F.lane, unit = unit0 + hw;
    const int b = unit >> 7, n = (unit >> 2) & 31, h = unit & 3;
    const size_t tok0 = (size_t)b * SEQ + n * 64;
    const bf16* H = (const bf16*)(a.ws + WS_H); const bf16* SP = (const bf16*)((const unsigned char*)a.out + OUT_SPREV) + (size_t)unit * 8192; const bf16* oi = (const bf16*)((const unsigned char*)a.out + OUT_OI);
    LAS unsigned char* L = F.lds + RING_OFF + hw * GLA3_HALF;
    LAS bf16* QD = (LAS bf16*)L;
    LAS bf16* ST = (LAS bf16*)(L + 9216);
    LAS float* OF = (LAS float*)(L + 27648);
    const int nn = lane & 31, hh = lane >> 5;
    v4u qreg[2], sreg[4]; bf16 oiv[2][16]; unsigned short brv[16][2];
#pragma unroll
    for (int k = 0; k < 2; ++k) { const int idx = lt + 256 * k, t = idx >> 3, d8 = (idx & 7) * 8; qreg[k] = *(const GAS v4u*)((const bf16*)a.out + (tok0 + t) * 256 + h * 64 + d8); }
#pragma unroll
    for (int k = 0; k < 4; ++k) { const int idx = lt + 256 * k, e = idx >> 3, d8 = (idx & 7) * 8; sreg[k] = *(const GAS v4u*)(SP + e * 64 + d8); }
#pragma unroll
    for (int k = 0; k < 2; ++k) { const int tile = wl * 2 + k, ti = tile >> 2, te = tile & 3;
#pragma unroll
        for (int i = 0; i < 16; ++i) oiv[k][i] = oi[(tok0 + 32 * ti + crow(i, hh)) * 512 + h * 128 + 32 * te + nn]; }
#pragma unroll
    for (int rr = 0; rr < 16; ++rr) { const bf16* br = H + (tok0 + wl * 16 + rr) * HP + HC_BR + h * 128; brv[rr][0] = br[lane]; brv[rr][1] = br[lane + 64]; }
    const float* ng = a.in[5]; const float ng0 = ng[h * 128 + lane], ng1 = ng[h * 128 + lane + 64];
#pragma unroll
    for (int k = 0; k < 2; ++k) { const int idx = lt + 256 * k, t = idx >> 3, d8 = (idx & 7) * 8; *(LAS v4u*)(QD + t * GP + d8) = qreg[k]; }
#pragma unroll
    for (int k = 0; k < 4; ++k) { const int idx = lt + 256 * k, e = idx >> 3, d8 = (idx & 7) * 8; *(LAS v4u*)(ST + e * GP + d8) = sreg[k]; }
    __syncthreads();
#pragma unroll
    for (int k = 0; k < 2; ++k) { const int tile = wl * 2 + k, ti = tile >> 2, te = tile & 3;
      const f32x16 c = mma_tile64(QD + 32 * ti * GP, ST + 32 * te * GP, lane);
#pragma unroll
      for (int i = 0; i < 16; ++i) { const int r = 32 * ti + crow(i, hh), e = 32 * te + nn; OF[r * 132 + e] = c[i] + bf2f(oiv[k][i]); } }
    __syncthreads();
    bf16* O = (bf16*)(a.ws + WS_O);
#pragma unroll
    for (int rr = 0; rr < 16; ++rr) { const int r = wl * 16 + rr; const float x0 = OF[r * 132 + lane], x1 = OF[r * 132 + lane + 64];
        const float mean = wsum(x0 + x1) * (1.f / 128.f), d0 = x0 - mean, d1 = x1 - mean, var = wsum(d0 * d0 + d1 * d1) * (1.f / 128.f), rs = __builtin_amdgcn_rsqf(var + LN_EPS);
        const float r0 = bf2f(brv[rr][0]), r1 = bf2f(brv[rr][1]);
        bf16* o = O + (tok0 + r) * D + 512 + h * 128;
        o[lane] = (bf16)f2bf(d0 * rs * ng0 * (r0 * __builtin_amdgcn_rcpf(1.f + __expf(-r0)))); o[lane + 64] = (bf16)f2bf(d1 * rs * ng1 * (r1 * __builtin_amdgcn_rcpf(1.f + __expf(-r1)))); }
    __syncthreads();
}
constexpr int SCP = 2048 + 16;
__device__ __forceinline__ unsigned fkey(float f) { const unsigned u = __float_as_uint(f); return (u & 0x80000000u) ? ~u : (u | 0x80000000u); }
__device__ __forceinline__ int wave_sum_dpp(int x) {
    x += __builtin_amdgcn_update_dpp(0, x, 0xB1, 0xF, 0xF, true);
    x += __builtin_amdgcn_update_dpp(0, x, 0x4E, 0xF, 0xF, true);
    x += __builtin_amdgcn_update_dpp(0, x, 0x141, 0xF, 0xF, true);
    x += __builtin_amdgcn_update_dpp(0, x, 0x140, 0xF, 0xF, true);
    x += __builtin_amdgcn_update_dpp(0, x, 0x142, 0xA, 0xF, false);
    x += __builtin_amdgcn_update_dpp(0, x, 0x143, 0xC, 0xF, false);
    return __builtin_amdgcn_readlane(x, 63);
}
#define CNT4(OP, a0, a1, a2, a3, k0, k1, k2, k3, c) do { unsigned long long _m0, _m1, _m2, _m3; \
    asm volatile("v_cmp_" OP "_u32_e64 %4, %8, %12\n\tv_cmp_" OP "_u32_e64 %5, %9, %12\n\tv_cmp_" OP "_u32_e64 %6, %10, %12\n\tv_cmp_" OP "_u32_e64 %7, %11, %12\n\t" \
                 "v_addc_co_u32_e64 %0, %4, 0, %0, %4\n\tv_addc_co_u32_e64 %1, %5, 0, %1, %5\n\tv_addc_co_u32_e64 %2, %6, 0, %2, %6\n\tv_addc_co_u32_e64 %3, %7, 0, %3, %7" \
                 : "+v"(a0), "+v"(a1), "+v"(a2), "+v"(a3), "=&s"(_m0), "=&s"(_m1), "=&s"(_m2), "=&s"(_m3) : "v"(k0), "v"(k1), "v"(k2), "v"(k3), "v"(c)); } while (0)
template <int NCH> __device__ __forceinline__ unsigned topk_search(const unsigned (&key)[32], bool& exact) {
    unsigned K = 0u; exact = false;
#pragma unroll 1
    for (int bit = 31; bit >= 0; --bit) { const unsigned cand = K | (1u << bit); int a0 = 0, a1 = 0, a2 = 0, a3 = 0;
#pragma unroll
        for (int c = 0; c < NCH; ++c) CNT4("ge", a0, a1, a2, a3, key[4 * c], key[4 * c + 1], key[4 * c + 2], key[4 * c + 3], cand);
        const int cnt = wave_sum_dpp((a0 + a1) + (a2 + a3));
        if (cnt >= 256) { K = cand; if (cnt == 256) { exact = true; break; } } }
    return K;
}
template <int NCH> __device__ __forceinline__ int count_gt(const unsigned (&key)[32], unsigned K) { int a0 = 0, a1 = 0, a2 = 0, a3 = 0;
#pragma unroll
    for (int c = 0; c < NCH; ++c) CNT4("gt", a0, a1, a2, a3, key[4 * c], key[4 * c + 1], key[4 * c + 2], key[4 * c + 3], K);
    return wave_sum_dpp((a0 + a1) + (a2 + a3)); }
struct Dsa1Ops { bf16x8 af[4][2]; float wq[4][4]; };
__device__ __forceinline__ void dsa1_load(Frame& F, const Args& a, int b, int qt, Dsa1Ops& o) {
    const int lane = F.lane, fr = lane & 15, fq = lane >> 4, t0 = qt * 16;
    const bf16* H = (const bf16*)(a.ws + WS_H) + (size_t)b * SEQ * HP;
#pragma unroll
    for (int qg = 0; qg < 4; ++qg) {
#pragma unroll
        for (int kk = 0; kk < 2; ++kk) o.af[qg][kk] = *(const GAS bf16x8*)(H + (size_t)(t0 + qg * 4 + (fr >> 2)) * HP + HC_IQ + (fr & 3) * 64 + kk * 32 + fq * 8);
        const v2u wv = *(const GAS v2u*)(H + (size_t)(t0 + qg * 4 + fq) * HP + HC_IW);
        o.wq[qg][0] = __uint_as_float(wv.x << 16); o.wq[qg][1] = __uint_as_float(wv.x & 0xffff0000u); o.wq[qg][2] = __uint_as_float(wv.y << 16); o.wq[qg][3] = __uint_as_float(wv.y & 0xffff0000u); }
}
__device__ __forceinline__ void dsa1_unit(Frame& F, const Args& a, int b, int qt, Dsa1Ops& cur, int nb, int nqt) {
    const int lane = F.lane, w = F.wave, fr = lane & 15, fq = lane >> 4, t0 = qt * 16;
    const bf16* H = (const bf16*)(a.ws + WS_H) + (size_t)b * SEQ * HP;
    LAS float* SC = (LAS float*)(F.lds + RING_OFF);
    const int nkb = qt + 1, nmine = (nkb - w + 7) >> 3;
    STAMP_T0(210, _t210);
    LAS unsigned* SK = (LAS unsigned*)SC;
    bf16x8 bA[4][2], bB[4][2];
#define DSA1_LOADB(dst, i0) do { _Pragma("unroll") for (int u = 0; u < 4; ++u) if ((i0) + u < nmine) { const int kb = w + 8 * ((i0) + u); \
        _Pragma("unroll") for (int kk = 0; kk < 2; ++kk) dst[u][kk] = *(const GAS bf16x8*)(H + (size_t)(kb * 16 + fr) * HP + HC_IK + kk * 32 + fq * 8); } } while (0)
#define DSA1_MMAB(src, i0) do { _Pragma("unroll") for (int u = 0; u < 4; ++u) if ((i0) + u < nmine) { const int kb = w + 8 * ((i0) + u), s = kb * 16 + fr; f32x4 cq[4]; \
        _Pragma("unroll") for (int qg = 0; qg < 4; ++qg) { cq[qg] = __builtin_amdgcn_mfma_f32_16x16x32_bf16(cur.af[qg][0], src[u][0], (f32x4){0.f, 0.f, 0.f, 0.f}, 0, 0, 0); \
            cq[qg] = __builtin_amdgcn_mfma_f32_16x16x32_bf16(cur.af[qg][1], src[u][1], cq[qg], 0, 0, 0); } \
        _Pragma("unroll") for (int qg = 0; qg < 4; ++qg) { float r[4], sc; \
            _Pragma("unroll") for (int i = 0; i < 4; ++i) { const int ci = __float_as_int(cq[qg][i]); r[i] = __int_as_float(ci > 0 ? ci : 0); } \
            asm("v_mul_f32 %0, %1, %2" : "=v"(sc) : "v"(cur.wq[qg][0]), "v"(r[0])); asm("v_fmac_f32 %0, %1, %2" : "+v"(sc) : "v"(cur.wq[qg][1]), "v"(r[1])); \
            asm("v_fmac_f32 %0, %1, %2" : "+v"(sc) : "v"(cur.wq[qg][2]), "v"(r[2])); asm("v_fmac_f32 %0, %1, %2" : "+v"(sc) : "v"(cur.wq[qg][3]), "v"(r[3])); \
            const int ui = __float_as_int(sc); SK[(qg * 4 + fq) * SCP + s] = (unsigned)(ui ^ ((ui >> 31) | (int)0x80000000)); } } } while (0)
    DSA1_LOADB(bA, 0);
#pragma unroll 1
    for (int i0 = 0; i0 < nmine; i0 += 8) {
        DSA1_LOADB(bB, i0 + 4); DSA1_MMAB(bA, i0);
        DSA1_LOADB(bA, i0 + 8); DSA1_MMAB(bB, i0 + 4);
    }
#undef DSA1_LOADB
#undef DSA1_MMAB
    __syncthreads();
    STAMP_END_PUB(210, _t210, F.ctl, 37, (float)(STAMP_SCALE)); STAMP_T0(211, _t211);
    if (nb >= 0) dsa1_load(F, a, nb, nqt, cur);
    unsigned long long* MASK = (unsigned long long*)(a.ws + WS_MASK);
    for (int _rp = 0; _rp < (PROBE == 23 ? 2 : 1); ++_rp)
#pragma unroll 1
    for (int rr = 0; rr < 2; ++rr) { const int r = w + 8 * rr, t = t0 + r, jmax = t >> 6, nch = (jmax >> 2) + 1;
        STAMP_T0(212, _t212);
        unsigned key[32];
#pragma unroll
        for (int c = 0; c < 8; ++c) {
            if (c < nch) {
#pragma unroll
                for (int jj = 0; jj < 4; ++jj) { const int s = (c * 4 + jj) * 64 + lane; const unsigned kv = SK[r * SCP + s]; key[c * 4 + jj] = (s <= t) ? kv : 0u; } }
            else {
#pragma unroll
                for (int jj = 0; jj < 4; ++jj) key[c * 4 + jj] = 0u; } }
        STAMP_END_PUB(212, _t212, F.ctl, 37, (float)(STAMP_SCALE));
        unsigned long long mine = 0ull;
        if (t < 256) {
#pragma unroll
            for (int j = 0; j < 4; ++j) { const unsigned long long bm = __ballot(j * 64 + lane <= t); if (lane == j) mine = bm; }
        } else {
            unsigned K; bool exact; int cgt = 0;
            STAMP_T0(213, _t213);
            switch (nch) {
                case 1: K = topk_search<1>(key, exact); if (!exact) cgt = count_gt<1>(key, K); break;
                case 2: K = topk_search<2>(key, exact); if (!exact) cgt = count_gt<2>(key, K); break;
                case 3: K = topk_search<3>(key, exact); if (!exact) cgt = count_gt<3>(key, K); break;
                case 4: K = topk_search<4>(key, exact); if (!exact) cgt = count_gt<4>(key, K); break;
                case 5: K = topk_search<5>(key, exact); if (!exact) cgt = count_gt<5>(key, K); break;
                case 6: K = topk_search<6>(key, exact); if (!exact) cgt = count_gt<6>(key, K); break;
                case 7: K = topk_search<7>(key, exact); if (!exact) cgt = count_gt<7>(key, K); break;
                default: K = topk_search<8>(key, exact); if (!exact) cgt = count_gt<8>(key, K); break;
            }
            STAMP_END_PUB(213, _t213, F.ctl, 37, (float)(STAMP_SCALE)); STAMP_T0(214, _t214);
            const int quota = 256 - cgt; int taken = 0; unsigned mlo = 0u, mhi = 0u;
#pragma unroll
            for (int j = 0; j < 32; ++j) if (j <= jmax) {
                unsigned long long bm;
                if (exact) bm = __ballot(key[j] >= K);
                else { const unsigned long long eq = __ballot(key[j] == K); const int pre = __builtin_amdgcn_mbcnt_hi((unsigned)(eq >> 32), __builtin_amdgcn_mbcnt_lo((unsigned)eq, 0u));
                       bm = __ballot(key[j] > K || (key[j] == K && taken + pre < quota)); taken += __builtin_popcountll(eq); }
                asm volatile("v_writelane_b32 %0, %2, %4\n\tv_writelane_b32 %1, %3, %4" : "+v"(mlo), "+v"(mhi) : "s"((unsigned)bm), "s"((unsigned)(bm >> 32)), "n"(j)); }
            mine = ((unsigned long long)mhi << 32) | mlo;
            STAMP_END_PUB(214, _t214, F.ctl, 37, (float)(STAMP_SCALE));
        }
        if (lane < 32) MASK[((size_t)b * SEQ + t) * 32 + lane] = mine; }
    STAMP_END_PUB(211, _t211, F.ctl, 37, (float)(STAMP_SCALE));
    __syncthreads();
}

constexpr float LOG2E = 1.4426950408889634f, SCL2 = 0.125f * 1.4426950408889634f;
__device__ __forceinline__ bf16x8 pack_step(const f32x16& x, int s) {
    v4u p;
    asm volatile("v_cvt_pk_bf16_f32 %0, %4, %5\n\tv_cvt_pk_bf16_f32 %1, %6, %7\n\tv_cvt_pk_bf16_f32 %2, %8, %9\n\tv_cvt_pk_bf16_f32 %3, %10, %11\n\ts_nop 1"
                 : "=&v"(p[0]), "=&v"(p[1]), "=&v"(p[2]), "=&v"(p[3])
                 : "v"(x[8 * s]), "v"(x[8 * s + 1]), "v"(x[8 * s + 2]), "v"(x[8 * s + 3]), "v"(x[8 * s + 4]), "v"(x[8 * s + 5]), "v"(x[8 * s + 6]), "v"(x[8 * s + 7]));
    return __builtin_bit_cast(bf16x8, p);
}
__device__ __forceinline__ void dsa2_unit(Frame& F, const Args& a, int b, int g, int qb) {
    const int tid = F.tid, lane = F.lane, w = F.wave, n = lane & 31, h = lane >> 5, hl = w >> 1, hh = g * 4 + hl, t0 = qb * 64, tq0 = t0 + 32 * (w & 1);
    const bf16* H = (const bf16*)(a.ws + WS_H) + (size_t)b * SEQ * HP;
    const unsigned long long* MW = (const unsigned long long*)(a.ws + WS_MASK) + ((size_t)b * SEQ + tq0 + n) * 32;
    LAS unsigned char* L = F.lds + RING_OFF;
    LAS float* BT = (LAS float*)(L + 92160);
    LAS bf16* OS = (LAS bf16*)(L + 94208 + w * 4608);
    const float* relb = a.in[1];
    BT[tid] = relb[T5B[tid & 127] * 8 + g * 4 + (tid >> 7)] * LOG2E;
    const float B31 = relb[31 * 8 + hh] * LOG2E;
    bf16x8 Qf[4];
#pragma unroll
    for (int kk = 0; kk < 4; ++kk) Qf[kk] = *(const GAS bf16x8*)(H + (size_t)(tq0 + n) * HP + HC_AQ + hh * 64 + kk * 16 + 8 * h);
    f32x16 O[2];
#pragma unroll
    for (int i = 0; i < 16; ++i) { O[0][i] = 0.f; O[1][i] = 0.f; }
    float m = -1e30f, lsum = 0.f;
    const int krow = tid >> 3, kc8 = (tid & 7) * 8, vrow = tid & 63, vc8 = (tid >> 6) * 8, nt = qb + 1;
    v4u kreg, vreg;
#define DSA_LOADT(kt) do { kreg = *(const GAS v4u*)(H + (size_t)((kt) * 64 + krow) * HP + HC_AK + g * 64 + kc8); vreg = *(const GAS v4u*)(H + (size_t)((kt) * 64 + vrow) * HP + HC_AV + g * 64 + vc8); } while (0)
#define DSA_WRITET(bu) do { LAS bf16* _ks = (LAS bf16*)(L + (bu) * 18432); LAS bf16* _vt = (LAS bf16*)(L + (bu) * 18432 + 9216); *(LAS v4u*)(_ks + krow * GP + kc8) = kreg; \
        _vt[(vc8 + 0) * GP + vrow] = (bf16)(vreg.x & 0xffff); _vt[(vc8 + 1) * GP + vrow] = (bf16)(vreg.x >> 16); _vt[(vc8 + 2) * GP + vrow] = (bf16)(vreg.y & 0xffff); _vt[(vc8 + 3) * GP + vrow] = (bf16)(vreg.y >> 16); \
        _vt[(vc8 + 4) * GP + vrow] = (bf16)(vreg.z & 0xffff); _vt[(vc8 + 5) * GP + vrow] = (bf16)(vreg.z >> 16); _vt[(vc8 + 6) * GP + vrow] = (bf16)(vreg.w & 0xffff); _vt[(vc8 + 7) * GP + vrow] = (bf16)(vreg.w >> 16); } while (0)
#define DSA_QK(Sd, bu) do { const LAS bf16* _ks = (const LAS bf16*)(L + (bu) * 18432); _Pragma("unroll") for (int sb = 0; sb < 2; ++sb) { _Pragma("unroll") for (int i = 0; i < 16; ++i) Sd[sb][i] = 0.f; \
        _Pragma("unroll") for (int kk = 0; kk < 4; ++kk) { const bf16x8 ka = *(const LAS bf16x8*)(_ks + (32 * sb + n) * GP + kk * 16 + 8 * h); Sd[sb] = MFMA32(ka, Qf[kk], Sd[sb]); } } } while (0)
    DSA_LOADT(0); DSA_WRITET(0);
    if (nt > 1) { DSA_LOADT(1); DSA_WRITET(1); }
    if (nt > 2) { DSA_LOADT(2); DSA_WRITET(2); }
    if (nt > 3) DSA_LOADT(3);
    unsigned long long mw = MW[0];
    __syncthreads();
#define DSA_MASK(p, wsh, pos) do { int _t; asm volatile("v_bfe_i32 %1, %2, %3, 1\n\tv_and_b32 %0, %0, %1" : "+v"(p), "=&v"(_t) : "v"(wsh), "n"(pos)); } while (0)
#define DSA_TILE(Sc, Sn, kt, BAR) do { STAMP_BEGIN(1); STAMP_BEGIN(2); \
        const int s1 = slot == 4 ? 0 : slot + 1, s3 = slot >= 2 ? slot - 2 : slot + 3; \
        if ((kt) + 3 < nt) DSA_WRITET(s3); \
        if ((kt) + 4 < nt) DSA_LOADT((kt) + 4); \
        const unsigned long long mwn = ((kt) + 1 < nt) ? MW[(kt) + 1] : 0ull; \
        if ((kt) + 1 < nt) DSA_QK(Sn, s1); \
        STAMP_END(2); STAMP_BEGIN(3); \
        const LAS bf16* VT = (const LAS bf16*)(L + slot * 18432 + 9216); \
        const unsigned wsh0 = (unsigned)mw >> (4 * h), wsh1 = (unsigned)(mw >> 32) >> (4 * h); \
        float mx = -1e30f; \
        if ((kt) < qb - 2) {     \
            _Pragma("unroll") for (int sb = 0; sb < 2; ++sb) _Pragma("unroll") for (int i = 0; i < 16; ++i) { Sc[sb][i] = fmaf(Sc[sb][i], SCL2, B31); mx = fmaxf(mx, Sc[sb][i]); } \
        } else { const int dbase = tq0 + n - (kt) * 64 - 4 * h; \
            _Pragma("unroll") for (int sb = 0; sb < 2; ++sb) _Pragma("unroll") for (int i = 0; i < 16; ++i) { int dist = dbase - (32 * sb + (i & 3) + 8 * (i >> 2)); dist = dist < 0 ? 0 : (dist > 127 ? 127 : dist); \
                Sc[sb][i] = fmaf(Sc[sb][i], SCL2, BT[hl * 128 + dist]); mx = fmaxf(mx, Sc[sb][i]); } } \
        mx = xhalf_max(mx); \
        const float mn = fmaxf(m, mx); \
        if (__any(mn > m)) { const float al = __builtin_amdgcn_exp2f(m - mn); _Pragma("unroll") for (int i = 0; i < 16; ++i) { O[0][i] *= al; O[1][i] *= al; } lsum *= al; } \
        m = mn; \
        _Pragma("unroll") for (int i = 0; i < 16; ++i) { float p0 = __builtin_amdgcn_exp2f(Sc[0][i] - m), p1 = __builtin_amdgcn_exp2f(Sc[1][i] - m); \
            DSA_MASK(p0, wsh0, (i & 3) + 8 * (i >> 2)); DSA_MASK(p1, wsh1, (i & 3) + 8 * (i >> 2)); Sc[0][i] = p0; Sc[1][i] = p1; lsum += p0 + p1; } \
        STAMP_END(3); STAMP_BEGIN(4); \
        _Pragma("unroll") for (int sb = 0; sb < 2; ++sb) _Pragma("unroll") for (int s = 0; s < 2; ++s) { const bf16x8 pf = pack_step(Sc[sb], s); \
            _Pragma("unroll") for (int db = 0; db < 2; ++db) { const LAS bf16* vp = VT + (32 * db + n) * GP + 32 * sb + 16 * s + 4 * h; \
                const bf16x4 lo = *(const LAS bf16x4*)vp, hi = *(const LAS bf16x4*)(vp + 8); \
                const bf16x8 vf = __builtin_shufflevector(lo, hi, 0, 1, 2, 3, 4, 5, 6, 7); O[db] = MFMA32(vf, pf, O[db]); } } \
        mw = mwn; slot = s1; STAMP_END(4); STAMP_BEGIN(5); \
        if (BAR) { asm volatile("s_waitcnt lgkmcnt(0)" ::: "memory"); __builtin_amdgcn_s_barrier(); asm volatile("" ::: "memory"); } STAMP_END(5); STAMP_END(1); } while (0)
    STAMP_DECL;
    f32x16 SA[2], SB[2];
    DSA_QK(SA, 0);
    int slot = 0;
#pragma unroll 1
    for (int kt = 0; kt < nt; kt += 2) {
        DSA_TILE(SA, SB, kt, false);
        if (kt + 1 < nt) DSA_TILE(SB, SA, kt + 1, true);
    }
#undef DSA_TILE
#undef DSA_MASK
    STAMP_PUBLISH(F.ctl, 37, 1.0f / 100000.f);
#undef DSA_LOADT
#undef DSA_WRITET
#undef DSA_QK
    const float lt = xhalf_sum(lsum), inv = 1.f / lt;
#pragma unroll
    for (int db = 0; db < 2; ++db)
#pragma unroll
        for (int i = 0; i < 16; ++i) OS[n * GP + 32 * db + crow(i, h)] = (bf16)f2bf(O[db][i] * inv);
    asm volatile("s_waitcnt lgkmcnt(0)" ::: "memory");
    bf16* Og = (bf16*)(a.ws + WS_O) + ((size_t)b * SEQ + tq0) * D + hh * 64;
#pragma unroll
    for (int k = 0; k < 4; ++k) { const int idx = lane + 64 * k, row = idx >> 3, c8 = (idx & 7) * 8; *(GAS v4u*)(Og + (size_t)row * D + c8) = *(const LAS v4u*)(OS + row * GP + c8); }
    __syncthreads();
}
#define CONV_MOE 1
__device__ __forceinline__ void s5_build_group(Frame& F, const Args& a, int g, int part, LAS unsigned char* base) {
    LAS f32x2* AP = (LAS f32x2*)base;
    LAS f32x2* BB = (LAS f32x2*)(base + 8704);
    LAS f32x2* CC = (LAS f32x2*)(base + 8704 + 8192);
    LAS float* KT = (LAS float*)(base + 8704 + 16384);
    const float* lam_re = a.in[8]; const float* lam_im = a.in[9]; const float* log_dt = a.in[10];
    const float* b_re = a.in[11]; const float* b_im = a.in[12]; const float* c_re = a.in[13]; const float* c_im = a.in[14]; const float* dsk = a.in[15];
    const int tid = F.tid;
    if (tid < 64) { const int p = tid;
        const float lr = fminf(lam_re[g * 64 + p], -1e-4f), li = lam_im[g * 64 + p], dt = expf(log_dt[g]);
        const float mag = expf(lr * dt), are = mag * cosf(li * dt), aim = mag * sinf(li * dt);
        const float den = lr * lr + li * li, nr = are - 1.f, cre = (nr * lr + aim * li) / den, cim = (aim * lr - nr * li) / den;
        float pr = 1.f, pi = 0.f;
        for (int m = 0; m <= 16; ++m) { AP[m * 64 + p] = (f32x2){pr, pi}; const float t = pr * are - pi * aim; pi = pr * aim + pi * are; pr = t; }
        for (int c = 0; c < 16; ++c) { const float br = b_re[(g * 64 + p) * 16 + c], bi = b_im[(g * 64 + p) * 16 + c]; BB[p * 16 + c] = (f32x2){cre * br - cim * bi, cre * bi + cim * br}; }
    }
    for (int e = tid; e < 1024; e += NWAVES * 64) CC[e] = (f32x2){c_re[g * 1024 + e], c_im[g * 1024 + e]};
    __syncthreads();
    { const int m = tid >> 5, c = (tid >> 1) & 15, hc = tid & 1;
      if (m <= 4 * part + 3) { float acc[8];
#pragma unroll
          for (int q = 0; q < 8; ++q) acc[q] = 0.f;
          for (int p = 0; p < 64; ++p) { const f32x2 cc = CC[c * 64 + p], ap = AP[m * 64 + p]; const float tr = cc.x * ap.x - cc.y * ap.y, ti = cc.x * ap.y + cc.y * ap.x;
#pragma unroll
              for (int q = 0; q < 8; ++q) { const f32x2 bb = BB[p * 16 + 8 * hc + q]; acc[q] = fmaf(tr, bb.x, fmaf(-ti, bb.y, acc[q])); } }
#pragma unroll
          for (int q = 0; q < 8; ++q) KT[(m << 8) + (c << 4) + 8 * hc + q] = acc[q]; } }
    __syncthreads();
    bf16* MQ = (bf16*)(a.ws + WS_MQ) + (size_t)g * 256 * 384; bf16* PG = (bf16*)(a.ws + WS_PG) + (size_t)g * 256 * 256;
    for (int v = tid; v < 64 * 48; v += NWAVES * 64) { const int row = 64 * part + v / 48, cv = v % 48, j = row >> 4, c = row & 15, col0 = cv * 8; float val[8];
        if (col0 < 256) { const int i = col0 >> 4, c20 = col0 & 15;
#pragma unroll
            for (int q = 0; q < 8; ++q) { float t = (i <= j) ? KT[((j - i) << 8) + (c << 4) + c20 + q] : 0.f; if (i == j && c == c20 + q) t += dsk[g * 16 + c]; val[q] = t; } }
        else { const int p0 = (col0 - 256) & 63; const bool im = (col0 - 256) >= 64;
#pragma unroll
            for (int q = 0; q < 8; ++q) { const f32x2 cc = CC[c * 64 + p0 + q], ap = AP[(j + 1) * 64 + p0 + q]; val[q] = im ? -(cc.x * ap.y + cc.y * ap.x) : (cc.x * ap.x - cc.y * ap.y); } }
        v4u o; o.x = pk2(val[0], val[1]); o.y = pk2(val[2], val[3]); o.z = pk2(val[4], val[5]); o.w = pk2(val[6], val[7]);
        *(GAS v4u*)(MQ + (size_t)row * 384 + col0) = o; }
    for (int v = tid; v < 64 * 32; v += NWAVES * 64) { const int row = 64 * part + (v >> 5), col0 = (v & 31) * 8, i = col0 >> 4, c20 = col0 & 15; float val[8];
        if (row < 128) { const int p = row & 63; const bool im = row >= 64; const f32x2 ap = AP[(15 - i) * 64 + p];
#pragma unroll
            for (int q = 0; q < 8; ++q) { const f32x2 bb = BB[p * 16 + c20 + q]; val[q] = im ? (ap.x * bb.y + ap.y * bb.x) : (ap.x * bb.x - ap.y * bb.y); } }
        else {
#pragma unroll
            for (int q = 0; q < 8; ++q) val[q] = 0.f; }
        v4u o; o.x = pk2(val[0], val[1]); o.y = pk2(val[2], val[3]); o.z = pk2(val[4], val[5]); o.w = pk2(val[6], val[7]);
        *(GAS v4u*)(PG + (size_t)row * 256 + col0) = o; }
    __syncthreads();
}
__device__ __forceinline__ void s5_scan_local(Frame& F, const Args& a) {
    const float* lam_re = a.in[8]; const float* lam_im = a.in[9]; const float* log_dt = a.in[10];
    bf16* UA = (bf16*)(a.ws + WS_H); const float* Z = (const float*)(a.ws + WS_H + 96 * MiB);
    const int p = F.lane, nun = (512 - F.vcu + F.G - 1) / F.G;
    for (int q = F.wave; q < 2 * nun; q += NWAVES) { const int L = (q >> 1) * F.G + F.vcu, g = L >> 3, b = 2 * (L & 7) + (q & 1);
        const float lr = fminf(lam_re[g * 64 + p], -1e-4f), li = lam_im[g * 64 + p], dt = expf(log_dt[g]);
        const float mag = expf(lr * dt); float ar = mag * cosf(li * dt), ai = mag * sinf(li * dt);
#pragma unroll
        for (int k = 0; k < 4; ++k) { const float t = ar * ar - ai * ai; ai = 2.f * ar * ai; ar = t; }
        float sr = 0.f, si = 0.f;
        const float* zp = Z + ((size_t)(g * 2048 + b * 128)) * 128 + p; bf16* up = UA + ((size_t)(g * 2048 + b * 128)) * 384 + 256 + p;
        for (int n0 = 0; n0 < 128; n0 += 16) { float zr[16], zi[16];
#pragma unroll
            for (int k = 0; k < 16; ++k) { zr[k] = zp[(size_t)(n0 + k) * 128]; zi[k] = zp[(size_t)(n0 + k) * 128 + 64]; }
#pragma unroll
            for (int k = 0; k < 16; ++k) { up[(size_t)(n0 + k) * 384] = (bf16)f2bf(sr); up[(size_t)(n0 + k) * 384 + 64] = (bf16)f2bf(si);
                const float t = ar * sr - ai * si + zr[k]; si = ar * si + ai * sr + zi[k]; sr = t; } } }
}
template <int COMB, bool ROUTE, bool F32OUT>
__device__ __forceinline__ void ln_phase(Frame& F, const bf16* src, const bf16* cb, const float* gamma, const float* beta, float* dst, bf16* dstb,
                                         const float* rc, const float* rbc, const float* rf, const float* rbf, unsigned* cnt, int* list, float* tokw, int* tokpos = nullptr) {
    const int gw = F.vcu * NWAVES + F.wave, NGW = F.G * NWAVES, lane = F.lane;
    f32x4 gv[4], bv[4];
#pragma unroll
    for (int j = 0; j < 4; ++j) { gv[j] = ((const GAS f32x4*)gamma)[lane + 64 * j]; bv[j] = ((const GAS f32x4*)beta)[lane + 64 * j]; }
    volatile LAS unsigned* RT = (volatile LAS unsigned*)(F.lds + RING_OFF);
    int lrow = F.wave * 16;
    f32x4 rcv[16];
    LAS f32x4* RF = (LAS f32x4*)(F.lds + RING_OFF + 4096);
    if (ROUTE) { if (F.tid < 16) RT[F.tid] = 0u;
#pragma unroll
        for (int j = 0; j < 4; ++j)
#pragma unroll
            for (int q = 0; q < 4; ++q) rcv[j * 4 + q] = *(const GAS f32x4*)(rc + (size_t)(256 * j + 4 * lane + q) * 4);
        for (int i = F.tid; i < 4096; i += NWAVES * 64) RF[i] = ((const GAS f32x4*)rf)[i];
        if (F.tid < 16) RT[320 + F.tid] = __float_as_uint(rbf[F.tid]);
        __syncthreads(); }
    float rbcv[4] = {0.f, 0.f, 0.f, 0.f};
    if (ROUTE) {
#pragma unroll
        for (int g = 0; g < 4; ++g) rbcv[g] = rbc[g]; }
    int cs0 = 0, cs1 = 0, ns0 = 0, ns1 = 0; float cw0 = 0.f, cw1 = 0.f, nw0 = 0.f, nw1 = 0.f;
#define LN_INFO(r, s0, s1, w0, w1) do { const int _p0 = list[(r) * 2], _p1 = list[(r) * 2 + 1]; s0 = (int)RT[_p0 >> 20] * 256 + (_p0 & 0xfffff); s1 = (int)RT[_p1 >> 20] * 256 + (_p1 & 0xfffff); w0 = tokw[(r) * 2]; w1 = tokw[(r) * 2 + 1]; } while (0)
    if (COMB == 1) { if (F.tid < 16) RT[16 + F.tid] = (__hip_atomic_load(cnt + 64 * F.tid, RLX_AGENT) + 255u) >> 8;
        __syncthreads();
        if (F.tid < 16) { unsigned acc = 0; for (int e = 0; e < F.tid; ++e) acc += RT[16 + e]; RT[F.tid] = acc; }
        __syncthreads(); LN_INFO(gw, cs0, cs1, cw0, cw1); if (gw + NGW < NTOK) LN_INFO(gw + NGW, ns0, ns1, nw0, nw1); }
    v2u nx[4], na[4], nb[4];
    { const GAS v2u* xr = (const GAS v2u*)(src + (size_t)gw * D) + lane;
#pragma unroll
      for (int j = 0; j < 4; ++j) nx[j] = xr[64 * j];
      if (COMB == 1) { const GAS v2u* c0 = (const GAS v2u*)(cb + (size_t)cs0 * D) + lane; const GAS v2u* c1 = (const GAS v2u*)(cb + (size_t)cs1 * D) + lane;
#pragma unroll
          for (int j = 0; j < 4; ++j) { na[j] = c0[64 * j]; nb[j] = c1[64 * j]; } }
      if (COMB == 2) { const GAS v2u* c0 = (const GAS v2u*)(cb + (size_t)gw * D) + lane;
#pragma unroll
          for (int j = 0; j < 4; ++j) na[j] = c0[64 * j]; } }
    for (int row = gw; row < NTOK; row += NGW) {
        f32x4 v[4]; float s = 0.f;
#pragma unroll
        for (int j = 0; j < 4; ++j) { v[j].x = __uint_as_float(nx[j].x << 16); v[j].y = __uint_as_float(nx[j].x & 0xffff0000u); v[j].z = __uint_as_float(nx[j].y << 16); v[j].w = __uint_as_float(nx[j].y & 0xffff0000u); }
        if (COMB == 2) {
#pragma unroll
            for (int j = 0; j < 4; ++j) { const v2u a = na[j];
                v[j].x = fmaf(__uint_as_float(a.x << 16), ALPHA, v[j].x); v[j].y = fmaf(__uint_as_float(a.x & 0xffff0000u), ALPHA, v[j].y);
                v[j].z = fmaf(__uint_as_float(a.y << 16), ALPHA, v[j].z); v[j].w = fmaf(__uint_as_float(a.y & 0xffff0000u), ALPHA, v[j].w); } }
        if (COMB == 1) {
#pragma unroll
            for (int j = 0; j < 4; ++j) { const v2u a = na[j], b = nb[j];
                v[j].x = fmaf(v[j].x, ALPHA, fmaf(__uint_as_float(a.x << 16), cw0, __uint_as_float(b.x << 16) * cw1)); v[j].y = fmaf(v[j].y, ALPHA, fmaf(__uint_as_float(a.x & 0xffff0000u), cw0, __uint_as_float(b.x & 0xffff0000u) * cw1));
                v[j].z = fmaf(v[j].z, ALPHA, fmaf(__uint_as_float(a.y << 16), cw0, __uint_as_float(b.y << 16) * cw1)); v[j].w = fmaf(v[j].w, ALPHA, fmaf(__uint_as_float(a.y & 0xffff0000u), cw0, __uint_as_float(b.y & 0xffff0000u) * cw1)); } }
        if (row + NGW < NTOK) { const int nr = row + NGW; const GAS v2u* xr = (const GAS v2u*)(src + (size_t)nr * D) + lane;
#pragma unroll
            for (int j = 0; j < 4; ++j) nx[j] = xr[64 * j];
            if (COMB == 1) { const GAS v2u* c0 = (const GAS v2u*)(cb + (size_t)ns0 * D) + lane; const GAS v2u* c1 = (const GAS v2u*)(cb + (size_t)ns1 * D) + lane;
#pragma unroll
                for (int j = 0; j < 4; ++j) { na[j] = c0[64 * j]; nb[j] = c1[64 * j]; }
                cw0 = nw0; cw1 = nw1; if (nr + NGW < NTOK) LN_INFO(nr + NGW, ns0, ns1, nw0, nw1); }
            if (COMB == 2) { const GAS v2u* c0 = (const GAS v2u*)(cb + (size_t)nr * D) + lane;
#pragma unroll
                for (int j = 0; j < 4; ++j) na[j] = c0[64 * j]; } }
#pragma unroll
        for (int j = 0; j < 4; ++j) s += (v[j].x + v[j].y) + (v[j].z + v[j].w);
        const float mean = wsum(s) * (1.f / D); float s2 = 0.f;
#pragma unroll
        for (int j = 0; j < 4; ++j) { v[j] = v[j] - mean; s2 += (v[j].x * v[j].x + v[j].y * v[j].y) + (v[j].z * v[j].z + v[j].w * v[j].w); }
        const float rstd = __builtin_amdgcn_rsqf(wsum(s2) * (1.f / D) + LN_EPS);
        GAS v2u* ob = (GAS v2u*)(dstb + (size_t)row * D) + lane;
#pragma unroll
        for (int j = 0; j < 4; ++j) { v[j] = v[j] * rstd * gv[j] + bv[j]; v2u w; w.x = cvt2bf(v[j].x, v[j].y); w.y = cvt2bf(v[j].z, v[j].w); if (dstb) ob[64 * j] = w;
            if (F32OUT) { f32x4 ov = v[j];
#ifdef STAMP
                ov = ov * (1.f + __uint_as_float(__hip_atomic_load((unsigned*)(F.ctl + CW_DIAG), RLX_AGENT)));
#endif
                __builtin_nontemporal_store(ov, &((GAS f32x4*)(dst + (size_t)row * D) + lane)[64 * j]); } }
        if (ROUTE) {
            float gl[4] = {0.f, 0.f, 0.f, 0.f};
#pragma unroll
            for (int j = 0; j < 4; ++j)
#pragma unroll
                for (int q = 0; q < 4; ++q) { const f32x4 r = rcv[j * 4 + q]; const float xv = v[j][q];
                    gl[0] = fmaf(xv, r.x, gl[0]); gl[1] = fmaf(xv, r.y, gl[1]); gl[2] = fmaf(xv, r.z, gl[2]); gl[3] = fmaf(xv, r.w, gl[3]); }
#pragma unroll
            for (int g = 0; g < 4; ++g) gl[g] = wsum(gl[g]) + rbcv[g];
            int gs = 0; float gm = gl[0];
#pragma unroll
            for (int g = 1; g < 4; ++g) if (gl[g] > gm) { gm = gl[g]; gs = g; }
            float se = 0.f;
#pragma unroll
            for (int g = 0; g < 4; ++g) se += __expf(gl[g] - gm);
            const float gwt = __builtin_amdgcn_rcpf(se);
            float fl[4] = {0.f, 0.f, 0.f, 0.f}; const LAS f32x4* rfg = RF + gs * D;
#pragma unroll
            for (int j = 0; j < 4; ++j)
#pragma unroll
                for (int q = 0; q < 4; ++q) { const f32x4 r = rfg[256 * j + 4 * lane + q]; const float xv = v[j][q];
                    fl[0] = fmaf(xv, r.x, fl[0]); fl[1] = fmaf(xv, r.y, fl[1]); fl[2] = fmaf(xv, r.z, fl[2]); fl[3] = fmaf(xv, r.w, fl[3]); }
#pragma unroll
            for (int e = 0; e < 4; ++e) fl[e] = wsum(fl[e]) + __uint_as_float(RT[320 + gs * 4 + e]);
            int i1 = 0; float v1 = fl[0];
#pragma unroll
            for (int e = 1; e < 4; ++e) if (fl[e] > v1) { v1 = fl[e]; i1 = e; }
            int i2 = -1; float v2 = -INFINITY;
#pragma unroll
            for (int e = 0; e < 4; ++e) if (e != i1 && fl[e] > v2) { v2 = fl[e]; i2 = e; }
            const float e2 = __expf(v2 - v1), w1 = gwt * __builtin_amdgcn_rcpf(1.f + e2), w2 = w1 * e2;
            if (lane == 0) { const int ea = gs * 4 + i1, eb = gs * 4 + i2;
                const unsigned pa = __hip_atomic_fetch_add((LAS unsigned*)RT + ea, 1u, __ATOMIC_RELAXED, __HIP_MEMORY_SCOPE_WORKGROUP), pb = __hip_atomic_fetch_add((LAS unsigned*)RT + eb, 1u, __ATOMIC_RELAXED, __HIP_MEMORY_SCOPE_WORKGROUP);
                RT[64 + lrow] = (unsigned)ea | ((unsigned)eb << 8) | (pa << 16); RT[64 + 128 + lrow] = pb; tokw[row * 2] = w1; tokw[row * 2 + 1] = w2; }
            ++lrow;
        }
    }
    if (ROUTE) {
        __syncthreads();
        if (F.tid < 16) RT[32 + F.tid] = __hip_atomic_fetch_add(cnt + 64 * F.tid, RT[F.tid], RLX_AGENT);
        __syncthreads();
        if (F.tid < 128) { const int lr = F.tid, rw = lr >> 4, it = lr & 15, row = F.vcu * NWAVES + rw + it * NGW;
            if (row < NTOK) { const unsigned e = RT[64 + lr], pb = RT[64 + 128 + lr]; const int ea = e & 255, eb = (e >> 8) & 255; const unsigned pa = e >> 16;
                const unsigned ga = RT[32 + ea] + pa, gb = RT[32 + eb] + pb; list[ea * NTOK + ga] = row * 2; list[eb * NTOK + gb] = row * 2 + 1;
                tokpos[row * 2] = (ea << 20) | (int)ga; tokpos[row * 2 + 1] = (eb << 20) | (int)gb; } }
        __syncthreads();
    }
}

__device__ __forceinline__ void moe_convert(const Args& a, int layer, int part  , int wk, int nw, LAS float* scr, int lane) {
    unsigned char* ws = a.ws;
    constexpr int PER = 64, NU = NEXP * 2 * 4 * PER, PERD = 256, ND = NEXP * PERD;
    auto desc = [&](int it) { TrDesc d;
        if (it < NU) { int j = it / PER; const int r = it % PER, pn = j & 3; j >>= 2; const int which = j & 1; j >>= 1; const int le = layer * NEXP + j, kb = r >> 2, nb = r & 3;
            d.W = a.in[27 + which] + (size_t)le * D * MOE_F; d.ldw = MOE_F; d.WT = (bf16*)(ws + WS_WGU) + (size_t)le * 1024 * D; d.ldt = D; d.k0 = kb * 64; d.c0 = pn * 128 + nb * 32; d.nc = 32; d.r0 = pn * 256 + which * 128 + nb * 32; }
        else { const int q = it - NU, le = layer * NEXP + q / PERD, r = q % PERD, kb = r >> 5, nb = r & 31;
            d.W = a.in[29] + (size_t)le * MOE_F * D; d.ldw = D; d.WT = (bf16*)(ws + WS_WD) + (size_t)le * D * MOE_F; d.ldt = MOE_F; d.k0 = kb * 64; d.c0 = nb * 32; d.nc = 32; d.r0 = nb * 32; }
        return d; };
    const int lo = part == 1 ? NU : 0, hi = part == 0 ? NU : NU + ND;
    f32x4 va[8], vb[8]; int it = lo + wk;
    if (it < hi) { TrDesc d0 = desc(it); tr_load(d0, va, lane); }
    for (; it < hi; it += 2 * nw) {
        const TrDesc d0 = desc(it); const bool h1 = it + nw < hi, h2 = it + 2 * nw < hi;
        if (h1) { const TrDesc d1 = desc(it + nw); tr_load(d1, vb, lane); }
        tr_store(d0, va, scr, lane);
        if (h2) { const TrDesc d2 = desc(it + 2 * nw); tr_load(d2, va, lane); }
        if (h1) { const TrDesc d1 = desc(it + nw); tr_store(d1, vb, scr, lane); }
    }
}
__device__ __forceinline__ void p0_prologue(Frame& F, const Args& a) {
    LAS float* scr = (LAS float*)(F.lds + RING_OFF + F.wave * 16384);
    const int gw = F.vcu * NWAVES + F.wave, NGW = F.G * NWAVES, lane = F.lane;
    unsigned char* ws = a.ws;
#pragma unroll 1
    for (int step = 0; step < 2; ++step) {
      if ((step == 0) == ((F.vcu & 1) == 1)) {
        { const float* x = a.in[0]; bf16* xb = (bf16*)(ws + WS_XB); const size_t n8 = (size_t)NTOK * D / 8, st = (size_t)NGW * 64;
          for (size_t i = (size_t)gw * 64 + lane; i < n8; i += 4 * st) { f32x4 v0[4], v1[4];
#pragma unroll
              for (int u = 0; u < 4; ++u) if (i + u * st < n8) { v0[u] = __builtin_nontemporal_load((const GAS f32x4*)(x + (i + u * st) * 8)); v1[u] = __builtin_nontemporal_load((const GAS f32x4*)(x + (i + u * st) * 8 + 4)); }
#pragma unroll
              for (int u = 0; u < 4; ++u) if (i + u * st < n8) { v4u o; o.x = pk2(v0[u].x, v0[u].y); o.y = pk2(v0[u].z, v0[u].w); o.z = pk2(v1[u].x, v1[u].y); o.w = pk2(v1[u].z, v1[u].w);
                  *(GAS v4u*)(xb + (i + u * st) * 8) = o; } } }
      } else {
        for (int u = F.vcu; u < 256; u += F.G) s5_build_group(F, a, u >> 2, u & 3, F.lds + RING_OFF);
        __syncthreads();
        { const float* W = a.in[2]; bf16* WT = (bf16*)(ws + WS_WIN);
          const int n0 = tr_seg_items(D, 1088), n1 = tr_seg_items(D, 4), n2 = tr_seg_items(D, 16), n3 = tr_seg_items(D, 1024), n4 = tr_seg_items(D, 512);
          for (int it = gw; it < n0; it += NGW) tr_seg(W, ABP, D, 0, 1088, WT, D, 0, it, scr, lane);
          for (int it = gw; it < n1; it += NGW) tr_seg(W, ABP, D, 1088, 4, WT, D, HC_IW, it, scr, lane);
          for (int it = gw; it < n2; it += NGW) tr_seg(W, ABP, D, 2116, 16, WT, D, HC_BG, it, scr, lane);
          for (int it = gw; it < n3; it += NGW) tr_seg(W, ABP, D, 1092, 1024, WT, D, HC_BQ, it, scr, lane);
          for (int it = gw; it < n4; it += NGW) tr_seg(W, ABP, D, 2132, 512, WT, D, HC_BR, it, scr, lane);
          for (int i = gw * 64 + lane; i < 172 * (D / 8); i += NGW * 64) { const int rr = i / (D / 8), cc = i % (D / 8); const int row = rr < 4 ? 1092 + rr : 1112 + (rr - 4);
              *(GAS v4u*)(WT + (size_t)row * D + cc * 8) = (v4u){0u, 0u, 0u, 0u}; } }
        { const int n = tr_seg_items(D, D);
          for (int it = gw; it < n; it += NGW) tr_seg(a.in[6], D, D, 0, D, (bf16*)(ws + WS_WOUT), D, 0, it, scr, lane);
          for (int it = gw; it < n; it += NGW) tr_seg(a.in[7], D, D, 0, D, (bf16*)(ws + WS_S5IN), D, 0, it, scr, lane);
          for (int it = gw; it < n; it += NGW) tr_seg(a.in[18], D, D, 0, D, (bf16*)(ws + WS_S5OUT), D, 0, it, scr, lane); }
        { const int n = 2 * 8 * tr_seg_items(D, 128);
          for (int it = gw; it < n; it += NGW) { const int per = tr_seg_items(D, 128), j = it / per, which = j & 1, pn = j >> 1;
              tr_seg(a.in[16 + which], D, D, pn * 128, 128, (bf16*)(ws + WS_GLU), D, pn * 256 + which * 128, it % per, scr, lane); } }
      }
      __syncthreads();
    }
    __syncthreads();
}


#define MOE_PHASES(L, PU, PD, PL, LG, LB) \
    if (IN(PU)) { \
        pg8::Gemm g{(const bf16*)(ws + WS_XB), (const bf16*)(ws + WS_WGU) + (size_t)(L) * NEXP * 1024 * D, D, D, D}; \
        pg8::MoeOrder S; S.list = (const int*)(ws + WS_LIST); S.G = F.G; S.c = F.vcu;     _Pragma("unroll") for (int _e = 0; _e < NEXP; ++_e) S.cnt[_e] = __builtin_amdgcn_readfirstlane((int)__hip_atomic_load((unsigned*)(F.ctl + CW_CNT + 1024 * (L)) + 64 * _e, RLX_AGENT)); \
        pg8::EpiGated<1> E{(bf16*)(ws + WS_HMID), MOE_F}; \
        STAMP_T0(70 + (L) * 100, _t70); \
        RP(PU) pg8::gemm_phase<pg8::EpiGated<1>, pg8::MoeOrder, true, PU>(F.lds + RING_OFF, g, S, E, F.ctl); \
        STAMP_END_PUB(70 + (L) * 100, _t70, F.ctl, 37, (float)(STAMP_SCALE)); STAMP_T0(71, _t71); \
        if ((L) == 0) { int _T = 0; _Pragma("unroll") for (int _e = 0; _e < NEXP; ++_e) _T += (S.cnt[_e] + 255) >> 8; const int _n5 = 4 * _T - 4 * F.G;     \
            const bool _all = _n5 < 0 || _n5 >= F.G; const int _wk = _all ? F.vcu * NWAVES + F.wave : (F.vcu - _n5) * NWAVES + F.wave, _nw = _all ? F.G * NWAVES : (F.G - _n5) * NWAVES; \
            if (_all || F.vcu >= _n5) { LAS float* _scr = (LAS float*)(F.lds + RING_OFF + F.wave * 16384); moe_convert(args, 0, 1, _wk, _nw, _scr, F.lane); } } \
        STAMP_END_PUB(71, _t71, F.ctl, 37, (float)(STAMP_SCALE)); \
        if (BOTH(PU)) GRID_BAR(); } \
    if (IN(PD)) { \
        pg8::Gemm g{(const bf16*)(ws + WS_HMID), (const bf16*)(ws + WS_WD) + (size_t)(L) * NEXP * D * MOE_F, MOE_F, MOE_F, MOE_F}; \
        pg8::MoeOrder S; S.list = (const int*)(ws + WS_LIST); S.G = F.G; S.c = F.vcu;     _Pragma("unroll") for (int _e = 0; _e < NEXP; ++_e) S.cnt[_e] = __builtin_amdgcn_readfirstlane((int)__hip_atomic_load((unsigned*)(F.ctl + CW_CNT + 1024 * (L)) + 64 * _e, RLX_AGENT)); \
        pg8::EpiStoreBf16 E{(bf16*)(ws + WS_CB), D};     \
        STAMP_T0(72 + (L) * 100, _t72); \
        RP(PD) pg8::gemm_phase<pg8::EpiStoreBf16, pg8::MoeOrder, false, PD>(F.lds + RING_OFF, g, S, E, F.ctl); \
        STAMP_END_PUB(72 + (L) * 100, _t72, F.ctl, 37, (float)(STAMP_SCALE)); \
        if ((L) == 0) { int _T = 0; _Pragma("unroll") for (int _e = 0; _e < NEXP; ++_e) _T += (S.cnt[_e] + 255) >> 8; const int _n5 = 4 * _T - 4 * F.G;     \
            const bool _all = _n5 < 0 || _n5 >= F.G; const int _wk = _all ? F.vcu * NWAVES + F.wave : (F.vcu - _n5) * NWAVES + F.wave, _nw = _all ? F.G * NWAVES : (F.G - _n5) * NWAVES; \
            if (_all || F.vcu >= _n5) moe_convert(args, 1, 2, _wk, _nw, (LAS float*)(F.lds + RING_OFF + F.wave * 16384), F.lane); } \
        if (BOTH(PD)) GRID_BAR(); } \
    if (IN(PL)) { \
        if ((L) == 0) ln_phase<1, false, false>(F, (const bf16*)(ws + WS_XB), (const bf16*)(ws + WS_CB), LG, LB, nullptr, (bf16*)(ws + WS_XB), nullptr, nullptr, nullptr, nullptr, (unsigned*)(F.ctl + CW_CNT + 1024 * (L)), (int*)(ws + WS_TOKPOS), (float*)(ws + WS_TOKW)); \
        else ln_phase<1, false, true>(F, (const bf16*)(ws + WS_XB), (const bf16*)(ws + WS_CB), LG, LB, args.out, nullptr, nullptr, nullptr, nullptr, nullptr, (unsigned*)(F.ctl + CW_CNT + 1024 * (L)), (int*)(ws + WS_TOKPOS), (float*)(ws + WS_TOKW)); \
        if (BOTH(PL)) GRID_BAR(); }

__global__ void __launch_bounds__(NWAVES * 64, 2) mk_fwd(Args args) {
    extern __shared__ __attribute__((aligned(16))) unsigned char lds[];
    Frame F;
    F.lds = (LAS unsigned char*)lds; F.MISC = (volatile LAS unsigned*)(F.lds + MISC_OFF);
    F.tid = threadIdx.x; F.lane = F.tid & 63; F.wave = __builtin_amdgcn_readfirstlane(F.tid >> 6);
    F.G = gridDim.x; { const int bx = blockIdx.x; F.vcu = (F.G % 8 == 0) ? (bx % 8) * (F.G / 8) + bx / 8 : bx; }
    unsigned char* ws = args.ws;
    F.ctl = (gu32*)(ws + WS_CTL);
    for (int u = F.tid; u < (LDS_BYTES - LDSCTL_OFF) / 4; u += NWAVES * 64) ((LAS unsigned*)(F.lds + LDSCTL_OFF))[u] = 0u;
    __syncthreads();
    XcdBarrier bar = xcd_barrier_post((unsigned*)(F.ctl + CW_BAR) + args.li * XCD_BAR_WORDS, F.MISC + 8);
    const int lo = args.ph_lo, hi = args.ph_hi;
#define IN(k) (lo <= (k) && (k) < hi)
#define BOTH(k) (IN(k) && IN((k) + 1))
#ifdef STAMP
    int _bi = 0;
#define STAMP_BAR() do { if (STAMP >= 1000 && blockIdx.x == 37 && threadIdx.x == 0) { const unsigned _now = (unsigned)__builtin_amdgcn_s_memtime(); \
        if (_bi == STAMP - 1000) __hip_atomic_store((unsigned*)(F.ctl + CW_DIAG), __float_as_uint((float)(_now - F.MISC[20]) * (float)(STAMP_SCALE)), RLX_AGENT); \
        if (_bi + 1 == STAMP - 1000) F.MISC[20] = _now; } ++_bi; } while (0)
#define GRID_BAR() do { xcd_barrier(bar); STAMP_BAR(); } while (0)
    if (STAMP == 1000 && blockIdx.x == 37 && threadIdx.x == 0) F.MISC[20] = (unsigned)__builtin_amdgcn_s_memtime();
#else
#define GRID_BAR() xcd_barrier(bar)
#endif
#define RP(k) for (int _rp = 0; _rp < ((PROBE == (k)) ? 2 : 1); ++_rp)
    if (IN(0)) { RP(0) p0_prologue(F, args); if (BOTH(0)) GRID_BAR(); }
    if (IN(1)) {
        pg8::Gemm g{(const bf16*)(ws + WS_XB), (const bf16*)(ws + WS_WIN), D, D, D}; pg8::StaticOrder S; S.init(NTOK, HP, F.G, (int)blockIdx.x);
        pg8::EpiStoreBf16 E{(bf16*)(ws + WS_H), HP};
        RP(1) pg8::gemm_phase<pg8::EpiStoreBf16, pg8::StaticOrder, false, 1>(F.lds + RING_OFF, g, S, E, F.ctl);
        { const int units = (NTOK / 256) * (HP / 256), rem = units % F.G;
          if ((int)blockIdx.x >= rem) moe_convert(args, 0, 0, ((int)blockIdx.x - rem) * NWAVES + F.wave, (F.G - rem) * NWAVES, (LAS float*)(F.lds + RING_OFF + F.wave * 16384), F.lane); }
        if (BOTH(1)) GRID_BAR();
    }


    if (IN(2)) {
        STAMP_DECL; STAMP_BEGIN(200);
        RP(20) { Dsa1Ops ops; { const int x = F.vcu; if (x < 2048) dsa1_load(F, args, x >> 7, x & 127, ops); }
          for (int k = 0, x = F.vcu; x < 2048; ++k, x += F.G) { const int b = x >> 7, qb = x & 127, xn = x + F.G;
              const int nb = xn < 2048 ? (xn >> 7) : -1, nq = xn & 127; dsa1_unit(F, args, b, (k & 1) ? 127 - qb : qb, ops, nb, ((k + 1) & 1) ? 127 - nq : nq); } }
        STAMP_END(200); STAMP_BEGIN(201);
        RP(21) for (int k = 0; k < 4; ++k) { const int u = (F.G == 256) ? ((F.vcu >> 5) << 7) + (k << 5) + (F.vcu & 31) : F.vcu + k * F.G;
            if (u < 1024) gla1_pair(F, args, 2 * u); }
        STAMP_END(201); STAMP_PUBLISH(F.ctl, 37, (float)(STAMP_SCALE));
        if (BOTH(2)) GRID_BAR(); }
    if (IN(3)) {
        RP(30) gla2_scan(F, args);
        RP(31) for (int v = F.vcu; v < 256; v += F.G) { const int bg = v >> 3, s = v & 7;
#pragma unroll 1
            for (int k = 0; k < 4; ++k) { const int qb = k == 0 ? s : (k == 1 ? 15 - s : (k == 2 ? 16 + s : 31 - s)); dsa2_unit(F, args, bg >> 1, bg & 1, qb); } }
        if (BOTH(3)) GRID_BAR(); }
    if (IN(4)) { RP(4) for (int k = 0; k < 4; ++k) { const int u = (F.G == 256) ? ((F.vcu >> 5) << 7) + (k << 5) + (F.vcu & 31) : F.vcu + k * F.G; if (u < 1024) gla3_pair(F, args, 2 * u); } if (BOTH(4)) GRID_BAR(); }
    if (IN(5)) {
        pg8::Gemm g{(const bf16*)(ws + WS_O), (const bf16*)(ws + WS_WOUT), D, D, D}; pg8::StaticOrder S; S.init(NTOK, D, F.G, (int)blockIdx.x);
        pg8::EpiStoreBf16 E{(bf16*)(ws + WS_H), D};
        RP(5) pg8::gemm_phase<pg8::EpiStoreBf16, pg8::StaticOrder, false, 5>(F.lds + RING_OFF, g, S, E, F.ctl);
        if (BOTH(5)) GRID_BAR();
    }
    if (IN(6)) {
        ln_phase<2, true, false>(F, (const bf16*)(ws + WS_H), (const bf16*)(ws + WS_XB), args.in[19], args.in[20], nullptr, (bf16*)(ws + WS_XB), args.in[23], args.in[24], args.in[25], args.in[26],
                          (unsigned*)(F.ctl + CW_CNT), (int*)(ws + WS_LIST), (float*)(ws + WS_TOKW), (int*)(ws + WS_TOKPOS));
        if (BOTH(6)) GRID_BAR(); }
    MOE_PHASES(0, 7, 8, 9, args.in[21], args.in[22])
    if (IN(10)) {
        pg8::Gemm g{(const bf16*)(ws + WS_XB), (const bf16*)(ws + WS_S5IN), D, D, D}; pg8::StaticOrder S; S.init(NTOK, D, F.G, (int)blockIdx.x);
        pg8::EpiS5U E{(bf16*)(ws + WS_H)};
        RP(10) pg8::gemm_phase<pg8::EpiS5U, pg8::StaticOrder, false>(F.lds + RING_OFF, g, S, E);
        if (BOTH(10)) GRID_BAR();
    }
    if (IN(11)) {
        STAMP_T0(110, _t110);
        { pg8::Gemm g{(const bf16*)(ws + WS_H), (const bf16*)(ws + WS_PG), 384, 256, 256}; pg8::S5Order S{F.G, F.vcu};
          pg8::EpiS5Z E{(float*)(ws + WS_H + 96 * MiB)};
          pg8::gemm_phase<pg8::EpiS5Z, pg8::S5Order, false, 11>(F.lds + RING_OFF, g, S, E, F.ctl); }
        VM_WAIT(); __syncthreads();
        STAMP_END_PUB(110, _t110, F.ctl, 37, (float)(STAMP_SCALE)); STAMP_T0(111, _t111);
        s5_scan_local(F, args);
        VM_WAIT(); __syncthreads();
        STAMP_END_PUB(111, _t111, F.ctl, 37, (float)(STAMP_SCALE)); STAMP_T0(112, _t112);
        { pg8::Gemm g{(const bf16*)(ws + WS_H), (const bf16*)(ws + WS_MQ), 384, 384, 384}; pg8::S5Order S{F.G, F.vcu};
          pg8::EpiS5Y E{(bf16*)(ws + WS_O)};
          pg8::gemm_phase<pg8::EpiS5Y, pg8::S5Order, false, 13>(F.lds + RING_OFF, g, S, E, F.ctl); }
        STAMP_END_PUB(112, _t112, F.ctl, 37, (float)(STAMP_SCALE));
        if (IN(14)) GRID_BAR();
    }
    if (IN(14)) {
        pg8::Gemm g{(const bf16*)(ws + WS_O), (const bf16*)(ws + WS_GLU), D, D, D}; pg8::StaticOrder S; S.init(NTOK, 2 * D, F.G, (int)blockIdx.x);
        pg8::EpiGated<0> E{(bf16*)(ws + WS_F1), D};
        RP(14) pg8::gemm_phase<pg8::EpiGated<0>, pg8::StaticOrder, false, 14, true>(F.lds + RING_OFF, g, S, E, F.ctl);
        if (BOTH(14)) GRID_BAR();
    }
    if (IN(15)) {
        pg8::Gemm g{(const bf16*)(ws + WS_F1), (const bf16*)(ws + WS_S5OUT), D, D, D}; pg8::StaticOrder S; S.init(NTOK, D, F.G, (int)blockIdx.x);
        pg8::EpiStoreBf16 E{(bf16*)(ws + WS_H), D};
        pg8::gemm_phase<pg8::EpiStoreBf16, pg8::StaticOrder, false>(F.lds + RING_OFF, g, S, E);
        if (BOTH(15)) GRID_BAR();
    }
    if (IN(16)) {
        ln_phase<2, true, false>(F, (const bf16*)(ws + WS_H), (const bf16*)(ws + WS_XB), args.in[19] + D, args.in[20] + D, nullptr, (bf16*)(ws + WS_XB), args.in[23] + D * 4, args.in[24] + 4, args.in[25] + 4 * D * 4, args.in[26] + 16,
                          (unsigned*)(F.ctl + CW_CNT + 1024), (int*)(ws + WS_LIST), (float*)(ws + WS_TOKW), (int*)(ws + WS_TOKPOS));
        if (BOTH(16)) GRID_BAR(); }
    MOE_PHASES(1, 17, 18, 19, args.in[21] + D, args.in[22] + D)
#ifdef STAMP
    STAMP_BAR();
#endif
#undef IN
#undef BOTH
}
static int g_grid = 0;
extern "C" void kernel_launch(void* const* d_in, const int* in_sizes, int n_in, void* d_out, int out_size, void* d_ws, size_t ws_size, hipStream_t stream) {
    if (g_grid == 0) {
        if (n_in != 30 || out_size != NTOK * D || ws_size < WS_END) { fprintf(stderr, "kernel_launch: unexpected problem (n_in %d out %d ws %zu)\n", n_in, out_size, ws_size); g_grid = -1; return; }
        int dev = 0, cus = 0, per_cu = 0;
        if (hipGetDevice(&dev) != hipSuccess || hipDeviceGetAttribute(&cus, hipDeviceAttributeMultiprocessorCount, dev) != hipSuccess) { g_grid = -1; return; }
        if (hipFuncSetAttribute((const void*)mk_fwd, hipFuncAttributeMaxDynamicSharedMemorySize, LDS_BYTES) != hipSuccess) { fprintf(stderr, "kernel_launch: hipFuncSetAttribute failed\n"); g_grid = -1; return; }
        if (hipOccupancyMaxActiveBlocksPerMultiprocessor(&per_cu, (const void*)mk_fwd, NWAVES * 64, LDS_BYTES) != hipSuccess || per_cu < 1) fprintf(stderr, "kernel_launch: occupancy query says %d\n", per_cu);
        (void)hipGetLastError();
        if (cus < 256) { fprintf(stderr, "kernel_launch: built for a 256-CU MI355X (one workgroup per CU); found %d CUs\n", cus); g_grid = -1; return; }
        g_grid = 256;
    }
    if (g_grid < 0) return;
    (void)hipMemsetAsync((char*)d_ws + WS_CTL, 0, CTL_ZERO_BYTES, stream);
    Args a{};
    for (int i = 0; i < 30; ++i) a.in[i] = (const float*)d_in[i];
    a.out = (float*)d_out; a.ws = (unsigned char*)d_ws; a.ph_lo = 0; a.ph_hi = 20; a.li = 0; a.pad = 0;
    hipLaunchKernelGGL(mk_fwd, dim3(g_grid), dim3(NWAVES * 64), LDS_BYTES, stream, a);
}
```
